# Optimizing an MI355X kernel written in HIP

```python
import math
import jax, jax.numpy as jnp
from jax import lax
import numpy as np

D_MODEL = 1024
BATCH = 4
SEQ = 4096
DEPTH = 1

CHUNK = 64
CONV_W = 4
EPS = 1e-6

DN_HEADS = 4
DN_DK = 128
DN_DV = 128
DN_QK = DN_HEADS * DN_DK
DN_V = DN_HEADS * DN_DV
DN_CONV_CH = 2 * DN_QK + DN_V

ML_HEADS = 4
ML_DK = 64
ML_DV = 128
ML_QK = ML_HEADS * ML_DK
ML_V = ML_HEADS * ML_DV

D_MIX = DN_V + ML_V

OFF_DN_QKV = 0
OFF_DN_Z = OFF_DN_QKV + DN_CONV_CH
OFF_DN_B = OFF_DN_Z + DN_V
OFF_DN_A = OFF_DN_B + DN_HEADS
OFF_ML_QK = OFF_DN_A + DN_HEADS
OFF_ML_V = OFF_ML_QK + 2 * ML_QK
OFF_ML_O = OFF_ML_V + ML_V
OFF_ML_I = OFF_ML_O + ML_V
OFF_ML_F = OFF_ML_I + ML_HEADS
D_IN = OFF_ML_F + ML_HEADS

N_EXPERTS = 32
TOP_K = 4
D_FF = D_MODEL
SWIGLU_LIMIT = 7.0
SWIGLU_ALPHA = 1.702
MOE_BLOCK = 256

kernel_name = 'hymba_gdn_mlstm_moe_adaln_block'


def rms_norm(x, w):
    xf = x.astype(jnp.float32)
    y = xf * lax.rsqrt(jnp.mean(xf * xf, axis=-1, keepdims=True) + EPS)
    return (y * w.astype(jnp.float32)).astype(x.dtype)


def modulate(h, shift, scale):
    return h * (1.0 + scale) + shift


def l2_normalize(u):
    return u * lax.rsqrt(jnp.sum(u * u, axis=-1, keepdims=True) + EPS)


def causal_conv_silu(u, w):
    S = u.shape[1]
    up = jnp.pad(u, ((0, 0), (CONV_W - 1, 0), (0, 0)))
    y = sum(up[:, j:j + S] * w[j] for j in range(CONV_W))
    return jax.nn.silu(y)


def to_chunks(u, n_heads):
    B, S, W = u.shape
    return u.reshape(B, S // CHUNK, CHUNK, n_heads, W // n_heads).transpose(0, 3, 1, 2, 4)


def gate_chunks(u):
    B, S, H = u.shape
    return u.reshape(B, S // CHUNK, CHUNK, H).transpose(0, 3, 1, 2)


def from_chunks(u):
    B, H, NC, C, d = u.shape
    return u.transpose(0, 2, 3, 1, 4).reshape(B, NC * C, H, d)


def gated_deltanet(proj, conv_w, a_log, dt_bias, norm_w):
    B, S, _ = proj.shape
    qkv = causal_conv_silu(proj[..., OFF_DN_QKV:OFF_DN_Z], conv_w)
    q = l2_normalize(to_chunks(qkv[..., :DN_QK], DN_HEADS)) * (DN_DK ** -0.5)
    k = l2_normalize(to_chunks(qkv[..., DN_QK:2 * DN_QK], DN_HEADS))
    v = to_chunks(qkv[..., 2 * DN_QK:], DN_HEADS)
    beta = gate_chunks(jax.nn.sigmoid(proj[..., OFF_DN_B:OFF_DN_A]))
    g = gate_chunks(-jnp.exp(a_log) * jax.nn.softplus(proj[..., OFF_DN_A:OFF_ML_QK] + dt_bias))
    G = jnp.cumsum(g, axis=-1)
    incl = jnp.tril(jnp.ones((CHUNK, CHUNK), bool))
    strict = jnp.tril(jnp.ones((CHUNK, CHUNK), bool), k=-1)
    decay = jnp.exp(jnp.where(incl, G[..., :, None] - G[..., None, :], -jnp.inf))
    kk = jnp.einsum('bhncd,bhnsd->bhncs', k, k)
    lower = jnp.where(strict, beta[..., :, None] * kk * decay, 0.0)
    unit_lower = jnp.eye(CHUNK, dtype=lower.dtype) + lower
    rhs = jnp.concatenate([v * beta[..., None], k * (beta * jnp.exp(G))[..., None]], axis=-1)
    sol = lax.linalg.triangular_solve(unit_lower, rhs, left_side=True, lower=True,
                                      unit_diagonal=True)
    w_val, k_cum = sol[..., :DN_DV], sol[..., DN_DV:]
    qk = jnp.einsum('bhncd,bhnsd->bhncs', q, k) * decay
    G_last = G[..., -1:]
    q_dec = q * jnp.exp(G)[..., None]
    k_dec = k * jnp.exp(G_last - G)[..., None]
    s_dec = jnp.exp(G_last[..., 0])

    def step(state, xs):
        w_c, kc_c, qk_c, q_c, k_c, sd_c = xs
        v_new = w_c - jnp.einsum('bhcd,bhde->bhce', kc_c, state)
        o = jnp.einsum('bhcd,bhde->bhce', q_c, state) + jnp.einsum('bhcs,bhse->bhce', qk_c, v_new)
        state = sd_c[..., None, None] * state + jnp.einsum('bhsd,bhse->bhde', k_c, v_new)
        return state, o

    xs = tuple(jnp.moveaxis(t, 2, 0) for t in (w_val, k_cum, qk, q_dec, k_dec, s_dec))
    state0 = jnp.zeros((B, DN_HEADS, DN_DK, DN_DV), jnp.float32)
    _, o = lax.scan(step, state0, xs)
    o = from_chunks(jnp.moveaxis(o, 0, 2))
    z = proj[..., OFF_DN_Z:OFF_DN_B].reshape(B, S, DN_HEADS, DN_DV)
    o = rms_norm(o, norm_w) * jax.nn.silu(z)
    return o.reshape(B, S, DN_V)


def mlstm(proj, conv_w, i_bias, f_bias, norm_w):
    B, S, _ = proj.shape
    qk_in = causal_conv_silu(proj[..., OFF_ML_QK:OFF_ML_V], conv_w)
    q = to_chunks(qk_in[..., :ML_QK], ML_HEADS) * (ML_DK ** -0.5)
    k = to_chunks(qk_in[..., ML_QK:], ML_HEADS)
    v = to_chunks(proj[..., OFF_ML_V:OFF_ML_O], ML_HEADS)
    i_pre = gate_chunks(proj[..., OFF_ML_I:OFF_ML_F] + i_bias)
    log_f = gate_chunks(jax.nn.log_sigmoid(proj[..., OFF_ML_F:D_IN] + f_bias))
    b = jnp.cumsum(log_f, axis=-1)
    incl = jnp.tril(jnp.ones((CHUNK, CHUNK), bool))
    d_mat = jnp.where(incl, b[..., :, None] - b[..., None, :] + i_pre[..., None, :], -jnp.inf)
    m_intra = jnp.max(d_mat, axis=-1)
    b_last = b[..., -1]
    g_end = b_last[..., None] - b + i_pre
    g_end_max = jnp.max(g_end, axis=-1)
    qk = jnp.einsum('bhncd,bhnsd->bhncs', q, k)

    def step(carry, xs):
        c_s, n_s, m_s = carry
        q_c, k_c, v_c, qk_c, d_c, mi_c, b_c, bl_c, ge_c, gm_c = xs
        m_t = jnp.maximum(b_c + m_s[..., None], mi_c)
        inter = jnp.exp(b_c + m_s[..., None] - m_t)
        p = jnp.exp(d_c - m_t[..., None]) * qk_c
        num = (inter[..., None] * jnp.einsum('bhcd,bhde->bhce', q_c, c_s)
               + jnp.einsum('bhcs,bhse->bhce', p, v_c))
        den = inter * jnp.einsum('bhcd,bhd->bhc', q_c, n_s) + jnp.sum(p, axis=-1)
        h = num / jnp.maximum(jnp.abs(den), jnp.exp(-m_t))[..., None]
        m_new = jnp.maximum(bl_c + m_s, gm_c)
        keep = jnp.exp(bl_c + m_s - m_new)
        kw = k_c * jnp.exp(ge_c - m_new[..., None])[..., None]
        c_s = keep[..., None, None] * c_s + jnp.einsum('bhsd,bhse->bhde', kw, v_c)
        n_s = keep[..., None] * n_s + jnp.sum(kw, axis=-2)
        return (c_s, n_s, m_new), h

    xs = tuple(jnp.moveaxis(t, 2, 0) for t in
               (q, k, v, qk, d_mat, m_intra, b, b_last, g_end, g_end_max))
    carry0 = (jnp.zeros((B, ML_HEADS, ML_DK, ML_DV), jnp.float32),
              jnp.zeros((B, ML_HEADS, ML_DK), jnp.float32),
              jnp.zeros((B, ML_HEADS), jnp.float32))
    _, h = lax.scan(step, carry0, xs)
    h = from_chunks(jnp.moveaxis(h, 0, 2))
    h = rms_norm(h, norm_w.reshape(ML_HEADS, ML_DV))
    o_gate = jax.nn.sigmoid(proj[..., OFF_ML_O:OFF_ML_I]).reshape(B, S, ML_HEADS, ML_DV)
    return (h * o_gate).reshape(B, S, ML_V)


def moe(h, w_router, b_router, w_gate_up, b_gate_up, w_down, b_down):
    B, S, D = h.shape
    T = B * S
    xf = h.reshape(T, D)
    logits = (xf @ w_router + b_router).astype(jnp.float32)
    top_logit, top_idx = lax.top_k(logits, TOP_K)
    top_w = jax.nn.softmax(top_logit, axis=-1)
    n_assign = T * TOP_K
    n_blocks = n_assign // MOE_BLOCK + N_EXPERTS
    e_flat = top_idx.reshape(-1)
    order = jnp.argsort(e_flat)
    sorted_e = e_flat[order]
    sorted_tok = (order // TOP_K).astype(jnp.int32)
    sorted_w = top_w.reshape(-1)[order]
    counts = jnp.bincount(e_flat, length=N_EXPERTS)
    padded = (counts + MOE_BLOCK - 1) // MOE_BLOCK * MOE_BLOCK
    start = jnp.cumsum(counts) - counts
    pad_end = jnp.cumsum(padded)
    pad_start = pad_end - padded
    dest = pad_start[sorted_e] + jnp.arange(n_assign, dtype=jnp.int32) - start[sorted_e]
    slot_tok = jnp.full((n_blocks * MOE_BLOCK,), T, jnp.int32).at[dest].set(sorted_tok)
    slot_w = jnp.zeros((n_blocks * MOE_BLOCK,), jnp.float32).at[dest].set(sorted_w)
    block_e = jnp.minimum(
        jnp.searchsorted(pad_end, jnp.arange(n_blocks, dtype=pad_end.dtype) * MOE_BLOCK, side='right'),
        N_EXPERTS - 1)
    x_pad = jnp.concatenate([xf, jnp.zeros((1, D), xf.dtype)], axis=0)

    def expert_block(args):
        tok, e = args
        xb = x_pad[tok]
        gu = xb @ w_gate_up[e] + b_gate_up[e]
        gate = jnp.minimum(gu[:, :D_FF], SWIGLU_LIMIT)
        up = jnp.clip(gu[:, D_FF:], -SWIGLU_LIMIT, SWIGLU_LIMIT)
        act = (up + 1.0) * gate * jax.nn.sigmoid(SWIGLU_ALPHA * gate)
        return act @ w_down[e] + b_down[e]

    y = lax.map(expert_block, (slot_tok.reshape(n_blocks, MOE_BLOCK), block_e))
    y = y.reshape(-1, D) * slot_w[:, None].astype(y.dtype)
    out = jnp.zeros((T + 1, D), y.dtype).at[slot_tok].add(y)[:T]
    return out.reshape(B, S, D).astype(h.dtype)


def setup_inputs(seed: int = 0) -> dict:
    key = jax.random.key(seed)
    ks = jax.random.split(key, 26)
    f32 = jnp.float32

    def nrm(k, shape, scale):
        return scale * jax.random.normal(k, shape, f32)

    x = nrm(ks[0], (BATCH, SEQ, D_MODEL), 1.0)
    c = nrm(ks[1], (BATCH, D_MODEL), 1.0)
    w_ada = nrm(ks[2], (DEPTH, D_MODEL, 6 * D_MODEL), D_MODEL ** -0.5)
    b_ada = nrm(ks[3], (DEPTH, 6 * D_MODEL), 0.02)
    norm_mix = 1.0 + nrm(ks[4], (DEPTH, D_MODEL), 0.02)
    w_in = nrm(ks[5], (DEPTH, D_MODEL, D_IN), D_MODEL ** -0.5)
    dn_conv = nrm(ks[6], (DEPTH, CONV_W, DN_CONV_CH), CONV_W ** -0.5)
    dn_a_log = jnp.log(jax.random.uniform(ks[7], (DEPTH, DN_HEADS), f32, 1.0, 16.0))
    dt = jnp.exp(jax.random.uniform(ks[8], (DEPTH, DN_HEADS), f32, math.log(1e-3), math.log(1e-1)))
    dn_dt_bias = dt + jnp.log(-jnp.expm1(-dt))
    dn_norm = 1.0 + nrm(ks[9], (DEPTH, DN_DV), 0.02)
    ml_conv = nrm(ks[10], (DEPTH, CONV_W, 2 * ML_QK), CONV_W ** -0.5)
    ml_i_bias = nrm(ks[11], (DEPTH, ML_HEADS), 0.1)
    ml_f_bias = jnp.linspace(3.0, 6.0, ML_HEADS, dtype=f32) + nrm(ks[12], (DEPTH, ML_HEADS), 0.1)
    ml_norm = 1.0 + nrm(ks[13], (DEPTH, ML_V), 0.02)
    w_out = nrm(ks[14], (DEPTH, D_MIX, D_MODEL), D_MIX ** -0.5)
    norm_ffn = 1.0 + nrm(ks[15], (DEPTH, D_MODEL), 0.02)
    w_router = nrm(ks[16], (DEPTH, D_MODEL, N_EXPERTS), D_MODEL ** -0.5)
    b_router = nrm(ks[17], (DEPTH, N_EXPERTS), 0.01)
    w_gate_up = nrm(ks[18], (DEPTH, N_EXPERTS, D_MODEL, 2 * D_FF), D_MODEL ** -0.5)
    b_gate_up = nrm(ks[19], (DEPTH, N_EXPERTS, 2 * D_FF), 0.02)
    w_down = nrm(ks[20], (DEPTH, N_EXPERTS, D_FF, D_MODEL), D_FF ** -0.5)
    b_down = nrm(ks[21], (DEPTH, N_EXPERTS, D_MODEL), 0.02)
    w_ada_final = nrm(ks[22], (D_MODEL, 2 * D_MODEL), D_MODEL ** -0.5)
    b_ada_final = nrm(ks[23], (2 * D_MODEL,), 0.02)
    norm_final = 1.0 + nrm(ks[24], (D_MODEL,), 0.02)
    return {'x': x, 'c': c, 'w_ada': w_ada, 'b_ada': b_ada, 'norm_mix': norm_mix,
            'w_in': w_in, 'dn_conv': dn_conv, 'dn_a_log': dn_a_log, 'dn_dt_bias': dn_dt_bias,
            'dn_norm': dn_norm, 'ml_conv': ml_conv, 'ml_i_bias': ml_i_bias,
            'ml_f_bias': ml_f_bias, 'ml_norm': ml_norm, 'w_out': w_out, 'norm_ffn': norm_ffn,
            'w_router': w_router, 'b_router': b_router, 'w_gate_up': w_gate_up,
            'b_gate_up': b_gate_up, 'w_down': w_down, 'b_down': b_down,
            'w_ada_final': w_ada_final, 'b_ada_final': b_ada_final, 'norm_final': norm_final}


def reference(x, c, w_ada, b_ada, norm_mix, w_in, dn_conv, dn_a_log, dn_dt_bias, dn_norm,
              ml_conv, ml_i_bias, ml_f_bias, ml_norm, w_out, norm_ffn, w_router, b_router,
              w_gate_up, b_gate_up, w_down, b_down, w_ada_final, b_ada_final, norm_final):
    cond = jax.nn.silu(c)
    for l in range(DEPTH):
        mod = (cond @ w_ada[l] + b_ada[l])[:, None, :]
        sh1, sc1, g1, sh2, sc2, g2 = jnp.split(mod, 6, axis=-1)
        h = modulate(rms_norm(x, norm_mix[l]), sh1, sc1)
        proj = (h @ w_in[l]).astype(jnp.float32)
        y_a = gated_deltanet(proj, dn_conv[l], dn_a_log[l], dn_dt_bias[l], dn_norm[l])
        y_b = mlstm(proj, ml_conv[l], ml_i_bias[l], ml_f_bias[l], ml_norm[l])
        mix = jnp.concatenate([y_a, y_b], axis=-1).astype(x.dtype) @ w_out[l]
        x = x + g1 * mix
        h = modulate(rms_norm(x, norm_ffn[l]), sh2, sc2)
        x = x + g2 * moe(h, w_router[l], b_router[l], w_gate_up[l], b_gate_up[l],
                         w_down[l], b_down[l])
    sh_f, sc_f = jnp.split((cond @ w_ada_final + b_ada_final)[:, None, :], 2, axis=-1)
    return modulate(rms_norm(x, norm_final), sh_f, sc_f)
```

```cpp
#include <hip/hip_runtime.h>
#include <cstdio>
#include <cstdint>

#ifndef MK_ONE_LAUNCH
#define MK_ONE_LAUNCH 0
#endif

namespace pg8 {
#define PG8_LAS __attribute__((address_space(3)))
typedef unsigned short bf16_t;
typedef short bf16x8 __attribute__((ext_vector_type(8)));
typedef float f32x4 __attribute__((ext_vector_type(4)));
typedef unsigned u32x4 __attribute__((ext_vector_type(4)));
constexpr int BM = 256, BK = 64, HALF = 128, HTB = HALF * BK * 2, STAGE_BYTES = 8 * HTB, NXCD = 8, WGM = 8;

__host__ __device__ __forceinline__ int lds_byte(int r, int c) { const int st = (r >> 4) * 2 + (c >> 5), rr = r & 15, cc = c & 31, ob = rr * 64 + cc * 2; return st * 1024 + (ob ^ (((ob >> 9) & 1) << 5)); }
__host__ __device__ __forceinline__ void stage_rc(int b, int& R, int& C) { const int st = b / 1024, sb = b % 1024, swz = sb ^ (((sb >> 9) & 1) << 5); R = (st >> 1) * 16 + swz / 64; C = (st & 1) * 32 + (swz % 64) / 2; }
__host__ __device__ __forceinline__ int perm32(int rho) { const int n = rho >> 4, i = rho & 15; return 8 * (i >> 2) + 4 * n + (i & 3); }

struct Unit { int pm, pn, e; };
struct Gemm { const bf16_t* A; int K; };

struct DenseOrder {
    int nM, nN, nwg, G, c, K; const bf16_t* Bt;
    __device__ void init(int M, int N, int K_, const bf16_t* Bt_, int G_, int c_) { nM = M / BM; nN = N / BM; nwg = nM * nN; G = G_; c = c_; K = K_; Bt = Bt_; }
    __device__ bool next(int i, Unit& u) const {
        const long L = (long)i * G + c; if (L >= nwg) return false;
        int wgid = (int)L; { const int q = nwg / NXCD, r = nwg % NXCD, xcd = wgid % NXCD, off = wgid / NXCD; wgid = (xcd < r ? xcd * (q + 1) : r * (q + 1) + (xcd - r) * q) + off; }
        const int nig = WGM * nN, gid = wgid / nig, fm = gid * WGM, gsz = (nM - fm) < WGM ? (nM - fm) : WGM;
        u.pm = fm + ((wgid % nig) % gsz); u.pn = (wgid % nig) / gsz; u.e = 0; return true;
    }
    __device__ __forceinline__ void a_voff(const Unit& u, const int (&R)[2], const int (&C)[2], unsigned (&vo)[2][2]) const {
#pragma unroll
        for (int h = 0; h < 2; ++h)
#pragma unroll
            for (int i = 0; i < 2; ++i) vo[h][i] = (unsigned)((u.pm * BM + h * HALF + R[i]) * K + C[i]) * 2u;
    }
    __device__ __forceinline__ const char* b_ptr(const Unit& u) const { return (const char*)Bt + (size_t)u.pn * BM * K * 2; }
};

__device__ __forceinline__ unsigned cvt_pk_bf16(float lo, float hi) { unsigned r; asm volatile("v_cvt_pk_bf16_f32 %0, %1, %2" : "=v"(r) : "v"(lo), "v"(hi)); return r; }

template <class Epi, class Sched, bool ALIGN_EPI = false, bool SP2 = false>
__device__ __forceinline__ void gemm_phase(PG8_LAS unsigned char* lds, const Gemm g, const Sched& S, const Epi& E) {
    const int tid = threadIdx.x, wid = __builtin_amdgcn_readfirstlane(tid >> 6), lane = tid & 63, wr = wid >> 2, wc = wid & 3, fr = lane & 15, fq = lane >> 4;
    const int K = g.K, nt = K / BK;
    int RA[2], CA[2]; unsigned voffB[2];
#pragma unroll
    for (int i = 0; i < 2; ++i) { int R, C; stage_rc(tid * 16 + i * 8192, R, C); const int Rb = Epi::PERM ? ((R & ~31) + perm32(R & 31)) : R;
        RA[i] = R; CA[i] = C; voffB[i] = (unsigned)(Rb * K + C) * 2u; }
    const size_t kstep = (size_t)(BK * 2);
    const size_t hstep = (size_t)HALF * K * 2;
    const unsigned ldsw = (unsigned)wid * 1024u;
    const int aoff = lds_byte(wr * 64 + fr, fq * 8), boff = lds_byte(wc * 32 + fr, fq * 8);
#define PG8_SA(b, h) (((b) * 2 + (h)) * HTB)
#define PG8_SB(b, h) ((4 + (b) * 2 + (h)) * HTB)
#define PG8_STAGE(bufoff, gbase, voff) do { _Pragma("unroll") for (int _i = 0; _i < 2; ++_i) \
        __builtin_amdgcn_global_load_lds((const unsigned*)((const char*)(gbase) + (voff)[_i]), (PG8_LAS unsigned*)(lds + (bufoff) + ldsw + _i * 8192), 16, 0, 0); } while (0)
#define PG8_LDA(dst, b, h) do { _Pragma("unroll") for (int m = 0; m < 4; ++m) _Pragma("unroll") for (int k = 0; k < 2; ++k) dst[m][k] = *(const PG8_LAS bf16x8*)(lds + PG8_SA(b, h) + aoff + m * 2048 + k * 1024); } while (0)
#define PG8_LDB(dst, b, h) do { _Pragma("unroll") for (int n = 0; n < 2; ++n) _Pragma("unroll") for (int k = 0; k < 2; ++k) dst[n][k] = *(const PG8_LAS bf16x8*)(lds + PG8_SB(b, h) + boff + n * 2048 + k * 1024); } while (0)
#define PG8_MMA(ai, bj, At, Bt) do { __builtin_amdgcn_s_setprio(1); _Pragma("unroll") for (int m = 0; m < 4; ++m) _Pragma("unroll") for (int n = 0; n < 2; ++n) _Pragma("unroll") for (int k = 0; k < 2; ++k) \
        acc[ai][bj][m][n] = __builtin_amdgcn_mfma_f32_16x16x32_bf16(Bt[n][k], At[m][k], acc[ai][bj][m][n], 0, 0, 0); __builtin_amdgcn_s_setprio(0); } while (0)
#define PG8_WAIT_V(n) asm volatile("s_waitcnt vmcnt(" #n ")" ::: "memory")
#define PG8_WAIT_L(n) asm volatile("s_waitcnt lgkmcnt(" #n ")" ::: "memory")
#define PG8_BAR __builtin_amdgcn_s_barrier()
#define PG8_SCHED __builtin_amdgcn_sched_barrier(0)
    Unit cur, nxt; int ui = 0;
    if (!S.next(0, cur)) return;
    f32x4 acc[2][2][4][2];
#pragma unroll
    for (int a = 0; a < 2; ++a)
#pragma unroll
        for (int b = 0; b < 2; ++b)
#pragma unroll
            for (int m = 0; m < 4; ++m)
#pragma unroll
                for (int n = 0; n < 2; ++n) acc[a][b][m][n] = (f32x4){0.f, 0.f, 0.f, 0.f};
    bf16x8 At[4][2], B0[2][2], B1[2][2];
    unsigned cvo[2][2], nvo[2][2];
    S.a_voff(cur, RA, CA, cvo);
    const char* const Ab = (const char*)g.A;
    const char* cB = S.b_ptr(cur);
    if constexpr (SP2) {
        PG8_STAGE(PG8_SB(0, 0), cB, voffB); PG8_STAGE(PG8_SB(0, 1), cB + hstep, voffB); PG8_STAGE(PG8_SA(0, 0), Ab, cvo[0]); PG8_STAGE(PG8_SA(0, 1), Ab, cvo[1]);
        if (wr == 1) PG8_BAR;
        PG8_WAIT_V(2); PG8_BAR;
        PG8_STAGE(PG8_SB(1, 0), cB + kstep, voffB); PG8_STAGE(PG8_SA(1, 0), Ab + kstep, cvo[0]); PG8_STAGE(PG8_SB(1, 1), cB + hstep + kstep, voffB);
        PG8_WAIT_V(6); PG8_BAR;
    } else {
        PG8_STAGE(PG8_SB(0, 0), cB, voffB); PG8_STAGE(PG8_SA(0, 0), Ab, cvo[0]); PG8_STAGE(PG8_SB(0, 1), cB + hstep, voffB); PG8_STAGE(PG8_SA(0, 1), Ab, cvo[1]);
        if (wr == 1) PG8_BAR;
        PG8_WAIT_V(4); PG8_BAR;
        PG8_STAGE(PG8_SB(1, 0), cB + kstep, voffB); PG8_STAGE(PG8_SA(1, 0), Ab + kstep, cvo[0]); PG8_STAGE(PG8_SB(1, 1), cB + hstep + kstep, voffB);
        PG8_WAIT_V(6); PG8_BAR;
    }
    for (;;) {
        const bool has_next = S.next(ui + 1, nxt);
        const char* nB = cB;
        if (has_next) { nB = S.b_ptr(nxt); S.a_voff(nxt, RA, CA, nvo); }
        else { nvo[0][0] = cvo[0][0]; nvo[0][1] = cvo[0][1]; nvo[1][0] = cvo[1][0]; nvo[1][1] = cvo[1][1]; }
        for (int t = 0; t < nt; t += 2) {
            const bool last = (t == nt - 2);
            const char* a1 = Ab + (size_t)(t + 1) * kstep;
            const char* a2 = last ? Ab : Ab + (size_t)(t + 2) * kstep; const char* b2 = last ? nB : cB + (size_t)(t + 2) * kstep;
            const char* a3 = a2 + kstep; const char* b3 = b2 + kstep;
            unsigned v2[2][2];
            v2[0][0] = last ? nvo[0][0] : cvo[0][0]; v2[0][1] = last ? nvo[0][1] : cvo[0][1]; v2[1][0] = last ? nvo[1][0] : cvo[1][0]; v2[1][1] = last ? nvo[1][1] : cvo[1][1];
            if constexpr (SP2) {
            PG8_LDB(B0, 0, 0); PG8_LDB(B1, 0, 1); PG8_SCHED; PG8_LDA(At, 0, 0); PG8_STAGE(PG8_SA(1, 1), a1, cvo[1]);
            PG8_WAIT_V(8); PG8_WAIT_L(0); PG8_BAR; PG8_MMA(0, 0, At, B0); PG8_MMA(0, 1, At, B1); PG8_BAR; PG8_SCHED;
            PG8_LDA(At, 0, 1); PG8_STAGE(PG8_SB(0, 0), b2, voffB); PG8_STAGE(PG8_SB(0, 1), b2 + hstep, voffB); PG8_STAGE(PG8_SA(0, 0), a2, v2[0]);
            PG8_WAIT_V(8); PG8_WAIT_L(0); PG8_BAR; PG8_MMA(1, 0, At, B0); PG8_MMA(1, 1, At, B1); PG8_BAR; PG8_SCHED;
            PG8_LDB(B0, 1, 0); PG8_LDB(B1, 1, 1); PG8_SCHED; PG8_LDA(At, 1, 0); PG8_STAGE(PG8_SA(0, 1), a2, v2[1]);
            PG8_WAIT_V(8); PG8_WAIT_L(0); PG8_BAR; PG8_MMA(0, 0, At, B0); PG8_MMA(0, 1, At, B1); PG8_BAR; PG8_SCHED;
            PG8_LDA(At, 1, 1); PG8_STAGE(PG8_SB(1, 0), b3, voffB); PG8_STAGE(PG8_SB(1, 1), b3 + hstep, voffB); PG8_STAGE(PG8_SA(1, 0), a3, v2[0]);
            PG8_WAIT_V(8); PG8_WAIT_L(0); PG8_BAR; PG8_MMA(1, 0, At, B0); PG8_MMA(1, 1, At, B1); PG8_BAR; PG8_SCHED;
            } else {
            PG8_LDB(B0, 0, 0); PG8_SCHED; PG8_LDA(At, 0, 0); PG8_STAGE(PG8_SA(1, 1), a1, cvo[1]);
            PG8_WAIT_L(8); PG8_BAR; PG8_WAIT_L(0); PG8_MMA(0, 0, At, B0); PG8_BAR; PG8_SCHED;
            PG8_LDB(B1, 0, 1); PG8_STAGE(PG8_SB(0, 0), b2, voffB);
            PG8_BAR; PG8_WAIT_L(0); PG8_MMA(0, 1, At, B1); PG8_BAR;
            PG8_LDA(At, 0, 1); PG8_STAGE(PG8_SA(0, 0), a2, v2[0]);
            PG8_BAR; PG8_WAIT_L(0); PG8_MMA(1, 0, At, B0); PG8_BAR; PG8_SCHED;
            PG8_STAGE(PG8_SB(0, 1), b2 + hstep, voffB);
            PG8_WAIT_V(6); PG8_BAR; PG8_MMA(1, 1, At, B1); PG8_BAR;
            PG8_LDB(B0, 1, 0); PG8_SCHED; PG8_LDA(At, 1, 0); PG8_STAGE(PG8_SA(0, 1), a2, v2[1]);
            PG8_WAIT_L(8); PG8_BAR; PG8_WAIT_L(0); PG8_MMA(0, 0, At, B0); PG8_BAR; PG8_SCHED;
            PG8_LDB(B1, 1, 1); PG8_STAGE(PG8_SB(1, 0), b3, voffB);
            PG8_BAR; PG8_WAIT_L(0); PG8_MMA(0, 1, At, B1); PG8_BAR;
            PG8_LDA(At, 1, 1); PG8_STAGE(PG8_SA(1, 0), a3, v2[0]);
            PG8_BAR; PG8_WAIT_L(0); PG8_MMA(1, 0, At, B0); PG8_BAR; PG8_SCHED;
            PG8_STAGE(PG8_SB(1, 1), b3 + hstep, voffB);
            PG8_WAIT_V(6); PG8_BAR; PG8_MMA(1, 1, At, B1); PG8_BAR;
            }
        }
        if constexpr (ALIGN_EPI) { if (wr == 0) PG8_BAR; }
        E(acc, cur, wr, wc, fr, fq);
        if (!has_next) break;
#pragma unroll
        for (int a = 0; a < 2; ++a)
#pragma unroll
            for (int b = 0; b < 2; ++b)
#pragma unroll
                for (int m = 0; m < 4; ++m)
#pragma unroll
                    for (int n = 0; n < 2; ++n) acc[a][b][m][n] = (f32x4){0.f, 0.f, 0.f, 0.f};
        cur = nxt; cB = nB; ++ui;
        cvo[0][0] = nvo[0][0]; cvo[0][1] = nvo[0][1]; cvo[1][0] = nvo[1][0]; cvo[1][1] = nvo[1][1];
        if constexpr (ALIGN_EPI) { if (wr == 1) PG8_BAR; }
    }
    PG8_WAIT_V(0);
    if constexpr (!ALIGN_EPI) { if (wr == 0) PG8_BAR; }
    PG8_BAR;
#undef PG8_SA
#undef PG8_SB
#undef PG8_STAGE
#undef PG8_LDA
#undef PG8_LDB
#undef PG8_MMA
#undef PG8_WAIT_V
#undef PG8_WAIT_L
#undef PG8_BAR
#undef PG8_SCHED
}
}

constexpr int NWAVES = 8, NTHR = 512;
constexpr int T = 16384, D = 1024, SEQ = 4096, NB = 4;
constexpr int DIN = 3600, NMAIN = 3584;
constexpr int NE = 32, TOPK = 4, ECAP = 16384, MAXMT = 288;
constexpr float EPS = 1e-6f;
constexpr int MC_DNQ = 0, MC_DNK = 512, MC_DNV = 1024, MC_DNZ = 1536, MC_MLQ = 2048, MC_MLK = 2304, MC_MLV = 2560, MC_MLO = 3072;

constexpr size_t MiB = 1u << 20;
constexpr size_t WS_CTL = 0, CTL_ZERO_BYTES = 1 * MiB;
constexpr size_t WS_MOD = 1 * MiB;
constexpr size_t WS_MODF = WS_MOD + 128 * 1024;
constexpr size_t WS_WRT = WS_MOD + 256 * 1024;
constexpr size_t WS_WGT = WS_MOD + 384 * 1024;
constexpr size_t WS_BTIN = 2 * MiB;
constexpr size_t WS_BTOUT = 9 * MiB;
constexpr size_t WS_G16 = 11 * MiB;
constexpr size_t WS_TOKE = 12 * MiB;
constexpr size_t WS_TOKR = WS_TOKE + 256 * 1024;
constexpr size_t WS_TOKW = WS_TOKE + 512 * 1024;
constexpr size_t WS_SLOTTOK = 13 * MiB;
constexpr size_t WS_H = 16 * MiB;
constexpr size_t WS_MIX = 48 * MiB;
constexpr size_t WS_X1 = 80 * MiB;
constexpr size_t WS_BTGU = 144 * MiB;
constexpr size_t WS_BTDN = 272 * MiB;
constexpr size_t WS_PROJ = 336 * MiB;
constexpr size_t WS_RAW = 448 * MiB;
constexpr size_t WS_ACT = 336 * MiB;
constexpr size_t WS_Y = 480 * MiB;
constexpr size_t WS_END = 624 * MiB;
constexpr int CW_BAR = 4096;
constexpr int CW_CNT = 1024;

constexpr int RING_BYTES = 131072;
constexpr int LDSCTL_OFF = RING_BYTES;
constexpr int L_MISC = LDSCTL_OFF;
constexpr int L_CNT = LDSCTL_OFF + 256;
constexpr int L_TST = LDSCTL_OFF + 384;
constexpr int L_TILEE = LDSCTL_OFF + 576;
constexpr int L_EXTRA = LDSCTL_OFF + 2048;
constexpr int LDS_BYTES = 147456;

#define LAS __attribute__((address_space(3)))
typedef unsigned short bf16;
typedef unsigned v4u __attribute__((ext_vector_type(4)));
typedef unsigned v2u __attribute__((ext_vector_type(2)));
typedef float f32x4 __attribute__((ext_vector_type(4)));
#define LDS_WAIT() asm volatile("s_waitcnt lgkmcnt(0)" ::: "memory")
__device__ __forceinline__ unsigned f2bf(float f) { unsigned u = __builtin_bit_cast(unsigned, f); return (u + 0x7fffu + ((u >> 16) & 1u)) >> 16; }
__device__ __forceinline__ unsigned pk2(float lo, float hi) { return f2bf(lo) | (f2bf(hi) << 16); }
__device__ __forceinline__ float bf2f(unsigned short b) { return __builtin_bit_cast(float, ((unsigned)b) << 16); }
__device__ __forceinline__ float sigmoidf_(float x) { return 1.0f / (1.0f + __expf(-x)); }
__device__ __forceinline__ float siluf_(float x) { return x / (1.0f + __expf(-x)); }
__device__ __forceinline__ float softplusf_(float x) { return x > 20.f ? x : log1pf(__expf(x)); }
__device__ __forceinline__ float logsigmoidf_(float x) { return x < 0.f ? x - log1pf(__expf(x)) : -log1pf(__expf(-x)); }

#define XB_TMO      128
#define XB_XCNT(j)  (256  + 64 * (j))
#define XB_XSUB(j)  (1280 + 64 * (j))
#define XB_XGEN(j)  (2304 + 64 * (j))
#define XB_TOP      3328
#define XB_TOPGEN   3392
#define XCD_BAR_WORDS 3456
#define XB_SPIN_CAP (1u << 18)
__device__ __forceinline__ unsigned xb_ld(unsigned* p)              { return __hip_atomic_load(p, __ATOMIC_RELAXED, __HIP_MEMORY_SCOPE_AGENT); }
__device__ __forceinline__ unsigned xb_add(unsigned* p, unsigned v) { return __hip_atomic_fetch_add(p, v, __ATOMIC_RELAXED, __HIP_MEMORY_SCOPE_AGENT); }
__device__ __forceinline__ unsigned xb_xcc_id() { return (unsigned)__builtin_amdgcn_s_getreg((3 << 11) | 20) & 0xFu; }
#define XB_SPIN(cond, bar) do { unsigned _sp = 0; while (cond) { __builtin_amdgcn_s_sleep(1); \
    if ((++_sp & 255u) == 0u) { if (xb_ld(&(bar)[XB_TMO])) break; if (_sp > XB_SPIN_CAP) { atomicAdd(&(bar)[XB_TMO], 1u); break; } } } } while (0)
struct XcdBarrier { unsigned* bar; unsigned x; volatile LAS unsigned* st; };
__device__ __forceinline__ XcdBarrier xcd_barrier_post(unsigned* bar, volatile LAS unsigned* st) {
    XcdBarrier b; b.bar = bar; b.x = xb_xcc_id(); b.st = st;
    if (threadIdx.x == 0) (void)xb_add(&bar[XB_XCNT(b.x)], 1u);
    return b;
}
__device__ __forceinline__ void xcd_barrier_complete(unsigned* bar, unsigned x, unsigned& nloc, unsigned& nx) {
    const unsigned G = gridDim.x * gridDim.y * gridDim.z;
    unsigned sum, cnt, mine, sp = 0u;
    for (;;) {
        sum = 0u; cnt = 0u; mine = 0u;
#pragma unroll
        for (unsigned j = 0; j < 16; ++j) { const unsigned c = xb_ld(&bar[XB_XCNT(j)]); sum += c; cnt += (c > 0u) ? 1u : 0u; mine = (j == x) ? c : mine; }
        if (sum == G) break;
        __builtin_amdgcn_s_sleep(1);
        if ((++sp & 255u) == 0u) { if (xb_ld(&bar[XB_TMO])) break; if (sp > XB_SPIN_CAP) { atomicAdd(&bar[XB_TMO], 1u); break; } }
    }
    nloc = mine > 0u ? mine : 1u; nx = cnt > 0u ? cnt : 1u;
}
__device__ __forceinline__ void xcd_barrier(const XcdBarrier& b) {
    asm volatile("s_waitcnt vmcnt(0)" ::: "memory");
    __syncthreads();
    if (threadIdx.x == 0) {
        unsigned* bar = b.bar;
        __builtin_amdgcn_s_waitcnt(0);
        unsigned nloc = b.st[0], nx = b.st[1];
        if (nloc == 0u) { xcd_barrier_complete(bar, b.x, nloc, nx); b.st[0] = nloc; b.st[1] = nx; }
        const unsigned old = xb_add(&bar[XB_XSUB(b.x)], 1u);
        const unsigned gen = old / nloc;
        if (old + 1u == (gen + 1u) * nloc) {
            __builtin_amdgcn_fence(__ATOMIC_RELEASE, "agent");
            asm volatile("s_waitcnt vmcnt(0)" ::: "memory");
            const unsigned og = xb_add(&bar[XB_TOP], 1u);
            const unsigned tg = og / nx;
            if (og + 1u == (tg + 1u) * nx) xb_add(&bar[XB_TOPGEN], 1u);
            else XB_SPIN(xb_ld(&bar[XB_TOPGEN]) == tg, bar);
            __builtin_amdgcn_fence(__ATOMIC_ACQUIRE, "agent");
            xb_add(&bar[XB_XGEN(b.x)], 1u);
            asm volatile("s_waitcnt vmcnt(0)" ::: "memory");
        } else {
            XB_SPIN(xb_ld(&bar[XB_XGEN(b.x)]) == gen, bar);
            __builtin_amdgcn_fence(__ATOMIC_ACQUIRE, "agent");
            asm volatile("s_waitcnt vmcnt(0)" ::: "memory");
        }
    }
    __syncthreads();
}

struct Args { const float* in[25]; float* out; unsigned char* ws; int ph_lo, ph_hi; };
struct Frame {
    LAS unsigned char* lds; unsigned char* ws; const float* in[25]; float* out;
    int tid, lane, wave, vb, G;
};
enum { I_X = 0, I_C, I_WADA, I_BADA, I_NMIX, I_WIN, I_DNCONV, I_DNALOG, I_DNDT, I_DNNORM, I_MLCONV, I_MLIB, I_MLFB, I_MLNORM, I_WOUT, I_NFFN, I_WR, I_BR, I_WGU, I_BGU, I_WDN, I_BDN, I_WADAF, I_BADAF, I_NFIN };

__device__ __forceinline__ float wave_sum(float v) {
#pragma unroll
    for (int o = 1; o < 64; o <<= 1) v += __shfl_xor(v, o);
    return v;
}

__device__ __forceinline__ void transpose_item(const float* W, int ldw, int K, bf16* WT, int k0, int src_n0, int dst_n0, LAS float* scr, int lane) {
#pragma unroll 8
    for (int i = 0; i < 32; ++i) { const int kk = 2 * i + (lane >> 5); scr[kk * 33 + (lane & 31)] = W[(size_t)(k0 + kk) * ldw + src_n0 + (lane & 31)]; }
    LDS_WAIT(); asm volatile("" ::: "memory");
    const int c = lane & 7;
#pragma unroll
    for (int j = 0; j < 4; ++j) { const int n = (lane >> 3) + 8 * j; const LAS float* s = scr + (8 * c) * 33 + n;
        v4u o; o.x = pk2(s[0 * 33], s[1 * 33]); o.y = pk2(s[2 * 33], s[3 * 33]); o.z = pk2(s[4 * 33], s[5 * 33]); o.w = pk2(s[6 * 33], s[7 * 33]);
        *(v4u*)(WT + (size_t)(dst_n0 + n) * K + k0 + 8 * c) = o; }
    LDS_WAIT(); asm volatile("" ::: "memory");
}
__device__ __forceinline__ void p0_prologue(Frame& F) {
    {
        LAS float* cond = (LAS float*)F.lds;
        LAS float* part = (LAS float*)(F.lds + 16384);
        const float* c = F.in[I_C];
        for (int i = F.tid; i < NB * D; i += NTHR) cond[i] = siluf_(c[i]);
        __syncthreads();
        for (int cb = F.vb; cb < 256; cb += F.G) {
            const int j0 = cb * 32; const bool fin = j0 >= 6144;
            const float* W = fin ? F.in[I_WADAF] : F.in[I_WADA]; const int ld = fin ? 2048 : 6144; const int jc = fin ? j0 - 6144 : j0;
            const float* bias = fin ? F.in[I_BADAF] : F.in[I_BADA];
            float* out = fin ? (float*)(F.ws + WS_MODF) : (float*)(F.ws + WS_MOD);
            const int s = F.tid >> 5, jj = F.tid & 31;
            float a0 = 0.f, a1 = 0.f, a2 = 0.f, a3 = 0.f;
            for (int k = s * 64; k < s * 64 + 64; ++k) { const float w = W[(size_t)k * ld + jc + jj]; a0 += cond[k] * w; a1 += cond[1024 + k] * w; a2 += cond[2048 + k] * w; a3 += cond[3072 + k] * w; }
            part[(s * 4 + 0) * 32 + jj] = a0; part[(s * 4 + 1) * 32 + jj] = a1; part[(s * 4 + 2) * 32 + jj] = a2; part[(s * 4 + 3) * 32 + jj] = a3;
            __syncthreads();
            if (F.tid < 128) { const int b = F.tid >> 5, j = F.tid & 31; float sum = 0.f;
                for (int q = 0; q < 16; ++q) sum += part[(q * 4 + b) * 32 + j];
                out[b * ld + jc + j] = sum + bias[jc + j]; }
            __syncthreads();
        }
    }
    {
        const int gt = F.vb * NTHR + F.tid, NGT = F.G * NTHR;
        float* wrT = (float*)(F.ws + WS_WRT); const float* wr = F.in[I_WR];
        for (int i = gt; i < NE * D; i += NGT) { const int e = i >> 10, k = i & 1023; wrT[i] = wr[k * NE + e]; }
        float* wgT = (float*)(F.ws + WS_WGT); const float* win = F.in[I_WIN];
        for (int i = gt; i < 16 * D; i += NGT) { const int g = i >> 10, k = i & 1023; const int col = g < 8 ? 2048 + g : 3592 + (g - 8); wgT[i] = win[(size_t)k * DIN + col]; }
    }
    {
        LAS float* scr = (LAS float*)(F.lds + F.wave * 16384);
        const int gw = F.vb * NWAVES + F.wave, NGW = F.G * NWAVES;
        constexpr int I_IN = 16 * (NMAIN / 32), I_OUT = 16 * 32, I_GU1 = 16 * 64, I_DN1 = 16 * 32;
        constexpr int NITEMS = I_IN + I_OUT + NE * I_GU1 + NE * I_DN1;
        for (int it = gw; it < NITEMS; it += NGW) {
            int r = it;
            if (r < I_IN) { const int nblk = NMAIN / 32, kb = r / nblk, nb = r % nblk; const int dn0 = nb * 32, sn0 = dn0 < 2048 ? dn0 : dn0 + 8;
                transpose_item(F.in[I_WIN], DIN, D, (bf16*)(F.ws + WS_BTIN), kb * 64, sn0, dn0, scr, F.lane); continue; }
            r -= I_IN;
            if (r < I_OUT) { const int kb = r / 32, nb = r % 32; transpose_item(F.in[I_WOUT], D, D, (bf16*)(F.ws + WS_BTOUT), kb * 64, nb * 32, nb * 32, scr, F.lane); continue; }
            r -= I_OUT;
            if (r < NE * I_GU1) { const int e = r / I_GU1, q = r % I_GU1, kb = q / 64, nb = q % 64; const int dn0 = nb * 32;
                const int sn0 = ((dn0 & 255) >> 7) * 1024 + (dn0 >> 8) * 128 + (dn0 & 127);
                transpose_item(F.in[I_WGU] + (size_t)e * D * 2048, 2048, D, (bf16*)(F.ws + WS_BTGU) + (size_t)e * 2048 * D, kb * 64, sn0, dn0, scr, F.lane); continue; }
            r -= NE * I_GU1;
            { const int e = r / I_DN1, q = r % I_DN1, kb = q / 32, nb = q % 32;
                transpose_item(F.in[I_WDN] + (size_t)e * D * D, D, D, (bf16*)(F.ws + WS_BTDN) + (size_t)e * D * D, kb * 64, nb * 32, nb * 32, scr, F.lane); }
        }
    }
}

#define MR_STEP(n, bit) { const bool hi = (lane & (bit)) != 0; _Pragma("unroll") for (int i = 0; i < (n) / 2; ++i) { const float send = hi ? v[i] : v[i + (n) / 2]; const float keep = hi ? v[i + (n) / 2] : v[i]; v[i] = keep + __shfl_xor(send, (bit)); } }
template <int N> __device__ __forceinline__ float multi_reduce(float (&v)[N], int lane) {
    float r;
    if constexpr (N == 32) { MR_STEP(32, 32) MR_STEP(16, 16) MR_STEP(8, 8) MR_STEP(4, 4) MR_STEP(2, 2) r = v[0]; r += __shfl_xor(r, 1); }
    else { MR_STEP(16, 32) MR_STEP(8, 16) MR_STEP(4, 8) MR_STEP(2, 4) r = v[0]; r += __shfl_xor(r, 2); r += __shfl_xor(r, 1); }
    return r;
}

__device__ __forceinline__ void p1_norm1(Frame& F) {
    LAS float* wg = (LAS float*)F.lds;
    { const float* src = (const float*)(F.ws + WS_WGT); for (int i = F.tid; i < 16 * D / 4; i += NTHR) ((LAS f32x4*)wg)[i] = ((const f32x4*)src)[i]; }
    __syncthreads();
    const float* x = F.in[I_X]; const float* nw = F.in[I_NMIX]; const float* mod = (const float*)(F.ws + WS_MOD);
    bf16* h1 = (bf16*)(F.ws + WS_H); float* g16 = (float*)(F.ws + WS_G16);
    const int gw = F.vb * NWAVES + F.wave, NGW = F.G * NWAVES;
    for (int row = gw; row < T; row += NGW) {
        const int b = row / SEQ;
        const f32x4* xr = (const f32x4*)(x + (size_t)row * D) + F.lane;
        f32x4 v[4]; float ss = 0.f;
#pragma unroll
        for (int j = 0; j < 4; ++j) { v[j] = xr[64 * j]; ss += (v[j].x * v[j].x + v[j].y * v[j].y) + (v[j].z * v[j].z + v[j].w * v[j].w); }
        const float rstd = rsqrtf(wave_sum(ss) * (1.f / D) + EPS);
        const float* sh = mod + b * 6144; const float* sc = sh + 1024;
#pragma unroll
        for (int j = 0; j < 4; ++j) { const int k = 256 * j + F.lane * 4;
            const f32x4 w = *(const f32x4*)(nw + k), s1 = *(const f32x4*)(sc + k), s0 = *(const f32x4*)(sh + k);
            v[j] = (v[j] * rstd * w) * (1.0f + s1) + s0; }
        v2u* o8 = (v2u*)(h1 + (size_t)row * D) + F.lane;
#pragma unroll
        for (int j = 0; j < 4; ++j) { v2u o; o.x = pk2(v[j].x, v[j].y); o.y = pk2(v[j].z, v[j].w); o8[64 * j] = o; }
        float acc[16];
#pragma unroll
        for (int g = 0; g < 16; ++g) { float a = 0.f;
#pragma unroll
            for (int j = 0; j < 4; ++j) { const f32x4 w = *(const LAS f32x4*)(wg + g * 1024 + 256 * j + F.lane * 4); a += (v[j].x * w.x + v[j].y * w.y) + (v[j].z * w.z + v[j].w * w.w); }
            acc[g] = a; if (g & 1) asm volatile("" ::: "memory"); }
        const float r = multi_reduce<16>(acc, F.lane);
        if ((F.lane & 3) == 0) g16[(size_t)row * 16 + (F.lane >> 2)] = r;
    }
}

struct EpiProj {
    static constexpr bool PERM = true;
    bf16* O; int ldc;
    __device__ __forceinline__ void operator()(const pg8::f32x4 (&acc)[2][2][4][2], const pg8::Unit& u, int wr, int wc, int fr, int fq) const {
        const int row0 = u.pm * 256 + wr * 64 + fr, col0 = u.pn * 256 + wc * 32 + 8 * fq;
#pragma unroll
        for (int ai = 0; ai < 2; ++ai)
#pragma unroll
            for (int m = 0; m < 4; ++m) { bf16* rowp = O + (size_t)(row0 + ai * 128 + m * 16) * ldc + col0;
#pragma unroll
                for (int bj = 0; bj < 2; ++bj) { const pg8::f32x4 v0 = acc[ai][bj][m][0], v1 = acc[ai][bj][m][1];
                    v4u w; w.x = pg8::cvt_pk_bf16(v0[0], v0[1]); w.y = pg8::cvt_pk_bf16(v0[2], v0[3]); w.z = pg8::cvt_pk_bf16(v1[0], v1[1]); w.w = pg8::cvt_pk_bf16(v1[2], v1[3]);
                    *(v4u*)(rowp + bj * 128) = w; } }
    }
};
struct EpiRes {
    static constexpr bool PERM = false;
    const float* X; float* O; const float* mod;
    __device__ __forceinline__ void operator()(const pg8::f32x4 (&acc)[2][2][4][2], const pg8::Unit& u, int wr, int wc, int fr, int fq) const {
        const int row0 = u.pm * 256 + wr * 64 + fr, col0 = u.pn * 256 + wc * 32 + 4 * fq;
        const int b = (u.pm * 256) / SEQ; const float* g1 = mod + b * 6144 + 2048;
        pg8::f32x4 gv[2][2];
#pragma unroll
        for (int bj = 0; bj < 2; ++bj)
#pragma unroll
            for (int n = 0; n < 2; ++n) gv[bj][n] = *(const pg8::f32x4*)(g1 + col0 + bj * 128 + n * 16);
#pragma unroll
        for (int ai = 0; ai < 2; ++ai)
#pragma unroll
            for (int m = 0; m < 4; ++m) { const size_t off = (size_t)(row0 + ai * 128 + m * 16) * D + col0;
#pragma unroll
                for (int bj = 0; bj < 2; ++bj)
#pragma unroll
                    for (int n = 0; n < 2; ++n) { const pg8::f32x4 xv = *(const pg8::f32x4*)(X + off + bj * 128 + n * 16);
                        *(pg8::f32x4*)(O + off + bj * 128 + n * 16) = xv + gv[bj][n] * acc[ai][bj][m][n]; }
                asm volatile("" ::: "memory"); }
    }
};
struct EpiGU {
    static constexpr bool PERM = true;
    bf16* O; const float* bgu;
    __device__ __forceinline__ void operator()(const pg8::f32x4 (&acc)[2][2][4][2], const pg8::Unit& u, int wr, int wc, int fr, int fq) const {
        const int row0 = u.pm * 256 + wr * 64 + fr, cc = u.pn * 128 + wc * 32 + 8 * fq;
        const float* bg = bgu + (size_t)u.e * 2048 + cc; const float* bu = bg + 1024;
        pg8::f32x4 bgv[2], buv[2];
#pragma unroll
        for (int n = 0; n < 2; ++n) { bgv[n] = *(const pg8::f32x4*)(bg + 4 * n); buv[n] = *(const pg8::f32x4*)(bu + 4 * n); }
#pragma unroll
        for (int ai = 0; ai < 2; ++ai)
#pragma unroll
            for (int m = 0; m < 4; ++m) { bf16* rowp = O + (size_t)(row0 + ai * 128 + m * 16) * D + cc;
                float r[8];
#pragma unroll
                for (int n = 0; n < 2; ++n)
#pragma unroll
                    for (int j = 0; j < 4; ++j) { float gt = acc[ai][0][m][n][j] + bgv[n][j], up = acc[ai][1][m][n][j] + buv[n][j];
                        gt = fminf(gt, 7.0f); up = fminf(fmaxf(up, -7.0f), 7.0f);
                        r[n * 4 + j] = (up + 1.0f) * gt * sigmoidf_(1.702f * gt); }
                v4u w; w.x = pg8::cvt_pk_bf16(r[0], r[1]); w.y = pg8::cvt_pk_bf16(r[2], r[3]); w.z = pg8::cvt_pk_bf16(r[4], r[5]); w.w = pg8::cvt_pk_bf16(r[6], r[7]);
                *(v4u*)rowp = w; }
    }
};
struct EpiDown {
    static constexpr bool PERM = true;
    bf16* O; const float* bdn;
    __device__ __forceinline__ void operator()(const pg8::f32x4 (&acc)[2][2][4][2], const pg8::Unit& u, int wr, int wc, int fr, int fq) const {
        const int row0 = u.pm * 256 + wr * 64 + fr, col0 = u.pn * 256 + wc * 32 + 8 * fq;
        const float* bb = bdn + (size_t)u.e * D + col0;
        pg8::f32x4 bv[2][2];
#pragma unroll
        for (int bj = 0; bj < 2; ++bj)
#pragma unroll
            for (int n = 0; n < 2; ++n) bv[bj][n] = *(const pg8::f32x4*)(bb + bj * 128 + 4 * n);
#pragma unroll
        for (int ai = 0; ai < 2; ++ai)
#pragma unroll
            for (int m = 0; m < 4; ++m) { bf16* rowp = O + (size_t)(row0 + ai * 128 + m * 16) * D + col0;
#pragma unroll
                for (int bj = 0; bj < 2; ++bj) { const pg8::f32x4 v0 = acc[ai][bj][m][0] + bv[bj][0], v1 = acc[ai][bj][m][1] + bv[bj][1];
                    v4u w; w.x = pg8::cvt_pk_bf16(v0[0], v0[1]); w.y = pg8::cvt_pk_bf16(v0[2], v0[3]); w.z = pg8::cvt_pk_bf16(v1[0], v1[1]); w.w = pg8::cvt_pk_bf16(v1[2], v1[3]);
                    *(v4u*)(rowp + bj * 128) = w; } }
    }
};

template <int MB, int NBK, bool GATHER> struct GroupedOrder {
    int G, c, nmt, K; const LAS int* tileE; const LAS int* tst; const LAS int* cnt; const int* slot_tok; const bf16* Bt; size_t bexp;
    __device__ bool next(int i, pg8::Unit& u) const {
        const int nwg = nmt * NBK; const long L = (long)i * G + c; if (L >= nwg) return false;
        int U = (int)L; { const int q = nwg / 8, r = nwg % 8, xcd = U % 8, off = U / 8; U = (xcd < r ? xcd * (q + 1) : r * (q + 1) + (xcd - r) * q) + off; }
        const int nig = MB * NBK, gid = U / nig, fm = gid * MB, gsz = (nmt - fm) < MB ? (nmt - fm) : MB;
        u.pm = fm + ((U % nig) % gsz); u.pn = (U % nig) / gsz; u.e = tileE[u.pm]; return true;
    }
    __device__ __forceinline__ void a_voff(const pg8::Unit& u, const int (&R)[2], const int (&C)[2], unsigned (&vo)[2][2]) const {
        if (GATHER) {
            const int r0 = (u.pm - tst[u.e]) * 256, ce = cnt[u.e];
#pragma unroll
            for (int h = 0; h < 2; ++h)
#pragma unroll
                for (int i = 0; i < 2; ++i) { const int rk = r0 + h * 128 + R[i]; int tok = 0; if (rk < ce) tok = slot_tok[u.e * ECAP + rk];
                    vo[h][i] = (unsigned)(tok * K + C[i]) * 2u; }
        } else {
#pragma unroll
            for (int h = 0; h < 2; ++h)
#pragma unroll
                for (int i = 0; i < 2; ++i) vo[h][i] = (unsigned)((u.pm * 256 + h * 128 + R[i]) * K + C[i]) * 2u;
        }
    }
    __device__ __forceinline__ const char* b_ptr(const pg8::Unit& u) const { return (const char*)(Bt + (size_t)u.e * bexp + (size_t)u.pn * 256 * K); }
};

__device__ __forceinline__ int build_expert_tables(Frame& F) {
    LAS int* lc = (LAS int*)(F.lds + L_CNT); LAS int* lt = (LAS int*)(F.lds + L_TST); LAS int* le = (LAS int*)(F.lds + L_TILEE);
    const unsigned* gc = (const unsigned*)(F.ws + WS_CTL) + CW_CNT;
    __syncthreads();
    if (F.tid < 64) {
        int c = 0; if (F.lane < NE) { c = (int)__hip_atomic_load(gc + F.lane, __ATOMIC_RELAXED, __HIP_MEMORY_SCOPE_AGENT); if (c > ECAP) c = ECAP; }
        const int nt = (c + 255) >> 8; int incl = nt;
#pragma unroll
        for (int o = 1; o < 32; o <<= 1) { const int v = __shfl_up(incl, o); if (F.lane >= o) incl += v; }
        const int excl = incl - nt;
        if (F.lane < NE) { lc[F.lane] = c; lt[F.lane] = excl; for (int i = 0; i < nt; ++i) le[excl + i] = F.lane; }
        if (F.lane == NE - 1) lt[NE] = incl;
    }
    __syncthreads();
    return lt[NE];
}

__device__ __forceinline__ void p3_naive_dn(Frame& F, int bh) {
    const int b = bh >> 2, h = bh & 3;
    LAS float* qs_ = (LAS float*)F.lds;
    LAS float* ks_ = qs_ + 64 * 128;
    LAS float* vs_ = ks_ + 64 * 128;
    LAS float* qsc = vs_ + 64 * 128;
    LAS float* ksc = qsc + 64; LAS float* bet = ksc + 64; LAS float* ade = bet + 64;
    const bf16* proj = (const bf16*)(F.ws + WS_PROJ); const float* g16 = (const float*)(F.ws + WS_G16);
    const float* cw = F.in[I_DNCONV]; float* raw = (float*)(F.ws + WS_RAW);
    const float Aexp = __expf(F.in[I_DNALOG][h]), dtb = F.in[I_DNDT][h];
    const int e = F.tid >> 2, ds = F.tid & 3, d0 = ds * 32;
    float S[32];
#pragma unroll
    for (int i = 0; i < 32; ++i) S[i] = 0.f;
    for (int n = 0; n < 64; ++n) {
        __syncthreads();
        for (int idx = F.tid; idx < 64 * 384; idx += NTHR) {
            const int i = idx / 384, c = idx % 384, which = c >> 7, cc = c & 127, col = which * 512 + h * 128 + cc;
            const int t = n * 64 + i; float a = 0.f;
#pragma unroll
            for (int j = 0; j < 4; ++j) { const int tt = t - 3 + j; if (tt >= 0) a += bf2f(proj[(size_t)(b * SEQ + tt) * NMAIN + col]) * cw[j * 1536 + col]; }
            (which == 0 ? qs_ : which == 1 ? ks_ : vs_)[i * 128 + cc] = siluf_(a);
        }
        if (F.tid < 64) { const size_t row = (size_t)b * SEQ + n * 64 + F.tid;
            bet[F.tid] = sigmoidf_(g16[row * 16 + h]); ade[F.tid] = __expf(-Aexp * softplusf_(g16[row * 16 + 4 + h] + dtb)); }
        __syncthreads();
        if (F.tid < 128) { const int i = F.tid & 63, which = F.tid >> 6; const LAS float* p = (which ? ks_ : qs_) + i * 128; float ss = 0.f;
            for (int c = 0; c < 128; ++c) ss += p[c] * p[c];
            const float sc = rsqrtf(ss + EPS); if (which) ksc[i] = sc; else qsc[i] = sc * 0.08838834764831845f; }
        __syncthreads();
        for (int i = 0; i < 64; ++i) {
            const float kscale = ksc[i], qscale = qsc[i], be = bet[i], a = ade[i];
            const LAS float* kp = ks_ + i * 128 + d0; const LAS float* qp = qs_ + i * 128 + d0;
            float kv[32]; float p = 0.f;
#pragma unroll
            for (int d = 0; d < 32; ++d) { kv[d] = kp[d] * kscale; p += kv[d] * S[d]; }
            p += __shfl_xor(p, 1); p += __shfl_xor(p, 2);
            const float uu = be * (vs_[i * 128 + e] - a * p);
            float o = 0.f;
#pragma unroll
            for (int d = 0; d < 32; ++d) { S[d] = a * S[d] + kv[d] * uu; o += qp[d] * S[d]; }
            o *= qscale; o += __shfl_xor(o, 1); o += __shfl_xor(o, 2);
            if (ds == 0) raw[((size_t)b * SEQ + n * 64 + i) * D + h * 128 + e] = o;
        }
    }
}
__device__ __forceinline__ void p3_naive_ml(Frame& F, int bh) {
    const int b = bh >> 2, h = bh & 3;
    LAS float* qs_ = (LAS float*)F.lds;
    LAS float* ks_ = qs_ + 64 * 64;
    LAS float* vs_ = ks_ + 64 * 64;
    LAS float* ipr = vs_ + 64 * 128; LAS float* lgf = ipr + 64;
    const bf16* proj = (const bf16*)(F.ws + WS_PROJ); const float* g16 = (const float*)(F.ws + WS_G16);
    const float* cw = F.in[I_MLCONV]; float* raw = (float*)(F.ws + WS_RAW);
    const float ib = F.in[I_MLIB][h], fb = F.in[I_MLFB][h];
    const int e = F.tid >> 2, ds = F.tid & 3, d0 = ds * 16;
    float C[16], nn[16]; float m = 0.f;
#pragma unroll
    for (int i = 0; i < 16; ++i) { C[i] = 0.f; nn[i] = 0.f; }
    for (int n = 0; n < 64; ++n) {
        __syncthreads();
        for (int idx = F.tid; idx < 64 * 128; idx += NTHR) {
            const int i = idx >> 7, c = idx & 127, which = c >> 6, cc = c & 63, ch = which * 256 + h * 64 + cc;
            const int t = n * 64 + i; float a = 0.f;
#pragma unroll
            for (int j = 0; j < 4; ++j) { const int tt = t - 3 + j; if (tt >= 0) a += bf2f(proj[(size_t)(b * SEQ + tt) * NMAIN + MC_MLQ + ch]) * cw[j * 512 + ch]; }
            const float y = siluf_(a);
            if (which == 0) qs_[i * 64 + cc] = y * 0.125f; else ks_[i * 64 + cc] = y;
        }
        for (int idx = F.tid; idx < 64 * 128; idx += NTHR) { const int i = idx >> 7, c = idx & 127;
            vs_[idx] = bf2f(proj[(size_t)(b * SEQ + n * 64 + i) * NMAIN + MC_MLV + h * 128 + c]); }
        if (F.tid < 64) { const size_t row = (size_t)b * SEQ + n * 64 + F.tid;
            ipr[F.tid] = g16[row * 16 + 8 + h] + ib; lgf[F.tid] = logsigmoidf_(g16[row * 16 + 12 + h] + fb); }
        __syncthreads();
        for (int i = 0; i < 64; ++i) {
            const float lf = lgf[i], ip = ipr[i];
            const float mn = fmaxf(lf + m, ip), fp = __expf(lf + m - mn), iq = __expf(ip - mn); m = mn;
            const LAS float* kp = ks_ + i * 64 + d0; const LAS float* qp = qs_ + i * 64 + d0;
            const float vv = vs_[i * 128 + e] * iq;
            float num = 0.f, den = 0.f;
#pragma unroll
            for (int d = 0; d < 16; ++d) { const float kk = kp[d], qq = qp[d]; C[d] = fp * C[d] + kk * vv; nn[d] = fp * nn[d] + iq * kk; num += qq * C[d]; den += qq * nn[d]; }
            num += __shfl_xor(num, 1); num += __shfl_xor(num, 2); den += __shfl_xor(den, 1); den += __shfl_xor(den, 2);
            const float hh = num / fmaxf(fabsf(den), __expf(-m));
            if (ds == 0) raw[((size_t)b * SEQ + n * 64 + i) * D + 512 + h * 128 + e] = hh;
        }
    }
}

__device__ __forceinline__ void p4_mixnorm(Frame& F) {
    const float* raw = (const float*)(F.ws + WS_RAW); const bf16* proj = (const bf16*)(F.ws + WS_PROJ); bf16* mix = (bf16*)(F.ws + WS_MIX);
    const float* dnn = F.in[I_DNNORM]; const float* mln = F.in[I_MLNORM];
    const int gw = F.vb * NWAVES + F.wave, NGW = F.G * NWAVES;
    for (int row = gw; row < T; row += NGW) {
        const f32x4* rr = (const f32x4*)(raw + (size_t)row * D) + F.lane;
        v2u* o8 = (v2u*)(mix + (size_t)row * D) + F.lane;
#pragma unroll
        for (int j = 0; j < 4; ++j) {
            f32x4 v = rr[64 * j]; float ss = (v.x * v.x + v.y * v.y) + (v.z * v.z + v.w * v.w);
#pragma unroll
            for (int o = 1; o < 32; o <<= 1) ss += __shfl_xor(ss, o);
            const float rstd = rsqrtf(ss * (1.f / 128.f) + EPS);
            const int k = 256 * j + F.lane * 4;
            f32x4 w, gt;
            if (j < 2) { w = *(const f32x4*)(dnn + (k & 127)); const v2u z = *(const v2u*)(proj + (size_t)row * NMAIN + MC_DNZ + k);
                gt.x = siluf_(bf2f(z.x & 0xffff)); gt.y = siluf_(bf2f(z.x >> 16)); gt.z = siluf_(bf2f(z.y & 0xffff)); gt.w = siluf_(bf2f(z.y >> 16)); }
            else { w = *(const f32x4*)(mln + (k - 512)); const v2u z = *(const v2u*)(proj + (size_t)row * NMAIN + MC_MLO + (k - 512));
                gt.x = sigmoidf_(bf2f(z.x & 0xffff)); gt.y = sigmoidf_(bf2f(z.x >> 16)); gt.z = sigmoidf_(bf2f(z.y & 0xffff)); gt.w = sigmoidf_(bf2f(z.y >> 16)); }
            v = v * rstd * w * gt;
            v2u o; o.x = pk2(v.x, v.y); o.y = pk2(v.z, v.w); o8[64 * j] = o;
        }
    }
}

__device__ __forceinline__ void p6_router(Frame& F) {
    LAS float* wr = (LAS float*)F.lds;
    LAS float* lg = (LAS float*)(F.lds + L_EXTRA);
    { const float* src = (const float*)(F.ws + WS_WRT); for (int i = F.tid; i < NE * D / 4; i += NTHR) ((LAS f32x4*)wr)[i] = ((const f32x4*)src)[i]; }
    __syncthreads();
    const float* x1 = (const float*)(F.ws + WS_X1); const float* nw = F.in[I_NFFN]; const float* mod = (const float*)(F.ws + WS_MOD);
    bf16* h2 = (bf16*)(F.ws + WS_H); const float* br = F.in[I_BR];
    int* tok_e = (int*)(F.ws + WS_TOKE); int* tok_r = (int*)(F.ws + WS_TOKR); float* tok_w = (float*)(F.ws + WS_TOKW); int* slot_tok = (int*)(F.ws + WS_SLOTTOK);
    unsigned* gcnt = (unsigned*)(F.ws + WS_CTL) + CW_CNT;
    for (int blk = F.vb; blk < T / 64; blk += F.G) {
        for (int rr = 0; rr < 8; ++rr) {
            const int lr = F.wave * 8 + rr, row = blk * 64 + lr, b = row / SEQ;
            const f32x4* xr = (const f32x4*)(x1 + (size_t)row * D) + F.lane;
            f32x4 v[4]; float ss = 0.f;
#pragma unroll
            for (int j = 0; j < 4; ++j) { v[j] = xr[64 * j]; ss += (v[j].x * v[j].x + v[j].y * v[j].y) + (v[j].z * v[j].z + v[j].w * v[j].w); }
            const float rstd = rsqrtf(wave_sum(ss) * (1.f / D) + EPS);
            const float* sh = mod + b * 6144 + 3072; const float* sc = sh + 1024;
#pragma unroll
            for (int j = 0; j < 4; ++j) { const int k = 256 * j + F.lane * 4;
                const f32x4 w = *(const f32x4*)(nw + k), s1 = *(const f32x4*)(sc + k), s0 = *(const f32x4*)(sh + k);
                v[j] = (v[j] * rstd * w) * (1.0f + s1) + s0; }
            v2u* o8 = (v2u*)(h2 + (size_t)row * D) + F.lane;
#pragma unroll
            for (int j = 0; j < 4; ++j) { v2u o; o.x = pk2(v[j].x, v[j].y); o.y = pk2(v[j].z, v[j].w); o8[64 * j] = o; }
            float acc[32];
#pragma unroll
            for (int e = 0; e < 32; ++e) { float a = 0.f;
#pragma unroll
                for (int j = 0; j < 4; ++j) { const f32x4 w = *(const LAS f32x4*)(wr + e * 1024 + 256 * j + F.lane * 4); a += (v[j].x * w.x + v[j].y * w.y) + (v[j].z * w.z + v[j].w * w.w); }
                acc[e] = a; if (e & 1) asm volatile("" ::: "memory"); }
            const float r = multi_reduce<32>(acc, F.lane);
            if ((F.lane & 1) == 0) lg[lr * 33 + (F.lane >> 1)] = r + br[F.lane >> 1];
        }
        __syncthreads();
        if (F.wave == 0) {
            const int row = blk * 64 + F.lane;
            float l[32];
#pragma unroll
            for (int e = 0; e < 32; ++e) l[e] = lg[F.lane * 33 + e];
            int te[4]; float tl[4];
#pragma unroll
            for (int k = 0; k < 4; ++k) { float best = -3.0e38f; int bi = 0;
#pragma unroll
                for (int e = 0; e < 32; ++e) { if (l[e] > best) { best = l[e]; bi = e; } }
                te[k] = bi; tl[k] = best;
#pragma unroll
                for (int e = 0; e < 32; ++e) if (e == bi) l[e] = -3.0e38f; }
            float w0 = 1.f, w1 = __expf(tl[1] - tl[0]), w2 = __expf(tl[2] - tl[0]), w3 = __expf(tl[3] - tl[0]); const float inv = 1.f / (w0 + w1 + w2 + w3);
            w0 *= inv; w1 *= inv; w2 *= inv; w3 *= inv;
            int mycount = 0;
#pragma unroll
            for (int k = 0; k < 4; ++k) {
#pragma unroll 1
                for (int e = 0; e < 32; ++e) { const unsigned long long mk = __ballot(te[k] == e); if (F.lane == e) mycount += __popcll(mk); } }
            int base = 0; if (F.lane < 32) base = (int)__hip_atomic_fetch_add(gcnt + F.lane, (unsigned)mycount, __ATOMIC_RELAXED, __HIP_MEMORY_SCOPE_AGENT);
            int run = 0;
            int rk[4];
#pragma unroll
            for (int k = 0; k < 4; ++k) { rk[k] = 0;
#pragma unroll 1
                for (int e = 0; e < 32; ++e) { const unsigned long long mk = __ballot(te[k] == e);
                    const int be = __shfl(base, e), re = __shfl(run, e);
                    if (te[k] == e) rk[k] = be + re + __popcll(mk & ((1ull << F.lane) - 1ull));
                    if (F.lane == e) run += __popcll(mk); } }
            const float ww[4] = {w0, w1, w2, w3};
#pragma unroll
            for (int k = 0; k < 4; ++k) { tok_e[row * 4 + k] = te[k]; tok_r[row * 4 + k] = rk[k]; tok_w[row * 4 + k] = ww[k]; if (rk[k] < ECAP) slot_tok[te[k] * ECAP + rk[k]] = row; }
        }
        __syncthreads();
    }
}

__device__ __forceinline__ void p9_final(Frame& F) {
    build_expert_tables(F);
    const LAS int* tst = (const LAS int*)(F.lds + L_TST);
    const float* x1 = (const float*)(F.ws + WS_X1); const bf16* y = (const bf16*)(F.ws + WS_Y);
    const float* mod = (const float*)(F.ws + WS_MOD); const float* modf = (const float*)(F.ws + WS_MODF); const float* nf = F.in[I_NFIN];
    const int* tok_e = (const int*)(F.ws + WS_TOKE); const int* tok_r = (const int*)(F.ws + WS_TOKR); const float* tok_w = (const float*)(F.ws + WS_TOKW);
    const int gw = F.vb * NWAVES + F.wave, NGW = F.G * NWAVES;
    for (int row = gw; row < T; row += NGW) {
        const int b = row / SEQ;
        const f32x4* xr = (const f32x4*)(x1 + (size_t)row * D) + F.lane;
        f32x4 v[4], m[4];
#pragma unroll
        for (int j = 0; j < 4; ++j) { v[j] = xr[64 * j]; m[j] = (f32x4){0.f, 0.f, 0.f, 0.f}; }
#pragma unroll
        for (int k = 0; k < 4; ++k) { const int e = tok_e[row * 4 + k], r = tok_r[row * 4 + k]; const float w = tok_w[row * 4 + k];
            const size_t cs = (size_t)tst[e] * 256 + r;
            const v2u* yr = (const v2u*)(y + cs * D) + F.lane;
#pragma unroll
            for (int j = 0; j < 4; ++j) { const v2u z = yr[64 * j];
                m[j].x += w * bf2f(z.x & 0xffff); m[j].y += w * bf2f(z.x >> 16); m[j].z += w * bf2f(z.y & 0xffff); m[j].w += w * bf2f(z.y >> 16); } }
        const float* g2 = mod + b * 6144 + 5120; float ss = 0.f;
#pragma unroll
        for (int j = 0; j < 4; ++j) { const f32x4 g = *(const f32x4*)(g2 + 256 * j + F.lane * 4); v[j] = v[j] + g * m[j];
            ss += (v[j].x * v[j].x + v[j].y * v[j].y) + (v[j].z * v[j].z + v[j].w * v[j].w); }
        const float rstd = rsqrtf(wave_sum(ss) * (1.f / D) + EPS);
        const float* sh = modf + b * 2048; const float* sc = sh + 1024;
        f32x4* orow = (f32x4*)(F.out + (size_t)row * D) + F.lane;
#pragma unroll
        for (int j = 0; j < 4; ++j) { const int k = 256 * j + F.lane * 4;
            const f32x4 w = *(const f32x4*)(nf + k), s1 = *(const f32x4*)(sc + k), s0 = *(const f32x4*)(sh + k);
            orow[64 * j] = (v[j] * rstd * w) * (1.0f + s1) + s0; }
    }
}

constexpr int NPH = 10;
__global__ void __launch_bounds__(NTHR, 2) fwd(Args args) {
    extern __shared__ __attribute__((aligned(16))) unsigned char lds_raw[];
    Frame F;
    F.lds = (LAS unsigned char*)lds_raw; F.ws = args.ws; F.out = args.out;
#pragma unroll
    for (int i = 0; i < 25; ++i) F.in[i] = args.in[i];
    F.tid = threadIdx.x; F.lane = F.tid & 63; F.wave = __builtin_amdgcn_readfirstlane(F.tid >> 6);
    F.G = gridDim.x; F.vb = blockIdx.x;
    for (int u = F.tid; u < (LDS_BYTES - LDSCTL_OFF) / 4; u += NTHR) ((LAS unsigned*)(F.lds + LDSCTL_OFF))[u] = 0u;
    __syncthreads();
    unsigned* ctl = (unsigned*)(F.ws + WS_CTL);
    const int lo = args.ph_lo, hi = args.ph_hi;
    XcdBarrier bar; bar.bar = ctl + CW_BAR; bar.x = 0; bar.st = nullptr;
    if (hi - lo > 1) bar = xcd_barrier_post(ctl + CW_BAR, (volatile LAS unsigned*)(F.lds + L_MISC) + 8);
#ifndef PHMASK
#define PHMASK 0x3ff
#endif
#define IN(k) (((PHMASK >> (k)) & 1) && lo <= (k) && (k) < hi)
#define SEAM(k) do { if (IN(k) && IN((k) + 1)) xcd_barrier(bar); } while (0)

    if (IN(0)) { p0_prologue(F); } SEAM(0);
    if (IN(1)) { p1_norm1(F); } SEAM(1);
    if (IN(2)) {
        pg8::Gemm g{(const bf16*)(F.ws + WS_H), D}; pg8::DenseOrder S; S.init(T, NMAIN, D, (const bf16*)(F.ws + WS_BTIN), F.G, F.vb);
        EpiProj E{(bf16*)(F.ws + WS_PROJ), NMAIN};
        pg8::gemm_phase<EpiProj, pg8::DenseOrder, true, true>(F.lds, g, S, E);
    } SEAM(2);
    if (IN(3)) { if (F.vb < 16) p3_naive_dn(F, F.vb); else if (F.vb < 32) p3_naive_ml(F, F.vb - 16); } SEAM(3);
    if (IN(4)) { p4_mixnorm(F); } SEAM(4);
    if (IN(5)) {
        pg8::Gemm g{(const bf16*)(F.ws + WS_MIX), D}; pg8::DenseOrder S; S.init(T, D, D, (const bf16*)(F.ws + WS_BTOUT), F.G, F.vb);
        EpiRes E{F.in[I_X], (float*)(F.ws + WS_X1), (const float*)(F.ws + WS_MOD)};
        pg8::gemm_phase<EpiRes, pg8::DenseOrder, false, true>(F.lds, g, S, E);
    } SEAM(5);
    if (IN(6)) { p6_router(F); } SEAM(6);
    if (IN(7)) {
        const int nmt = build_expert_tables(F);
        GroupedOrder<4, 8, true> S; S.G = F.G; S.c = F.vb; S.nmt = nmt; S.K = D; S.tileE = (const LAS int*)(F.lds + L_TILEE); S.tst = (const LAS int*)(F.lds + L_TST); S.cnt = (const LAS int*)(F.lds + L_CNT);
        S.slot_tok = (const int*)(F.ws + WS_SLOTTOK); S.Bt = (const bf16*)(F.ws + WS_BTGU); S.bexp = (size_t)2048 * D;
        pg8::Gemm g{(const bf16*)(F.ws + WS_H), D};
        EpiGU E{(bf16*)(F.ws + WS_ACT), F.in[I_BGU]};
        pg8::gemm_phase<EpiGU, GroupedOrder<4, 8, true>, true, true>(F.lds, g, S, E);
    } SEAM(7);
    if (IN(8)) {
        const int nmt = build_expert_tables(F);
        GroupedOrder<8, 4, false> S; S.G = F.G; S.c = F.vb; S.nmt = nmt; S.K = D; S.tileE = (const LAS int*)(F.lds + L_TILEE); S.tst = (const LAS int*)(F.lds + L_TST); S.cnt = (const LAS int*)(F.lds + L_CNT);
        S.slot_tok = nullptr; S.Bt = (const bf16*)(F.ws + WS_BTDN); S.bexp = (size_t)D * D;
        pg8::Gemm g{(const bf16*)(F.ws + WS_ACT), D};
        EpiDown E{(bf16*)(F.ws + WS_Y), F.in[I_BDN]};
        pg8::gemm_phase<EpiDown, GroupedOrder<8, 4, false>, true, true>(F.lds, g, S, E);
    } SEAM(8);
    if (IN(9)) { p9_final(F); }
#undef IN
#undef SEAM
}

extern "C" void kernel_launch(void* const* d_in, const int* in_sizes, int n_in, void* d_out, int out_size, void* d_ws, size_t ws_size, hipStream_t stream) {
    static int grid = 0;
    if (grid == 0) {
        if (n_in != 25 || in_sizes[0] != T * D || out_size != T * D || ws_size < WS_END) { fprintf(stderr, "kernel_launch: unexpected shapes (n_in %d, ws %zu)\n", n_in, ws_size); grid = -1; return; }
        int dev = 0, cus = 0, per_cu = 0;
        if (hipGetDevice(&dev) != hipSuccess || hipDeviceGetAttribute(&cus, hipDeviceAttributeMultiprocessorCount, dev) != hipSuccess) { grid = -1; return; }
        if (hipFuncSetAttribute((const void*)fwd, hipFuncAttributeMaxDynamicSharedMemorySize, LDS_BYTES) != hipSuccess) { fprintf(stderr, "kernel_launch: hipFuncSetAttribute failed\n"); grid = -1; return; }
        if (hipOccupancyMaxActiveBlocksPerMultiprocessor(&per_cu, (const void*)fwd, NTHR, LDS_BYTES) != hipSuccess || per_cu < 1) { fprintf(stderr, "kernel_launch: occupancy query says %d\n", per_cu); }
        (void)hipGetLastError();
        grid = cus;
    }
    if (grid < 0) return;
    hipMemsetAsync((char*)d_ws + WS_CTL, 0, CTL_ZERO_BYTES, stream);
    Args a{};
    for (int i = 0; i < 25; ++i) a.in[i] = (const float*)d_in[i];
    a.out = (float*)d_out; a.ws = (unsigned char*)d_ws;
#if MK_ONE_LAUNCH
    a.ph_lo = 0; a.ph_hi = NPH;
    hipLaunchKernelGGL(fwd, dim3(grid), dim3(NTHR), LDS_BYTES, stream, a);
#else
    for (int p = 0; p < NPH; ++p) { a.ph_lo = p; a.ph_hi = p + 1; hipLaunchKernelGGL(fwd, dim3(grid), dim3(NTHR), LDS_BYTES, stream, a); }
#endif
}
```

```cpp
#include <hip/hip_runtime.h>
#include <cstdio>
#include <cstdint>

#ifndef MK_ONE_LAUNCH
#define MK_ONE_LAUNCH 1
#endif

namespace pg8 {
#define PG8_LAS __attribute__((address_space(3)))
typedef unsigned short bf16_t;
typedef short bf16x8 __attribute__((ext_vector_type(8)));
typedef float f32x4 __attribute__((ext_vector_type(4)));
typedef unsigned u32x4 __attribute__((ext_vector_type(4)));
constexpr int BM = 256, BK = 64, HALF = 128, HTB = HALF * BK * 2, STAGE_BYTES = 8 * HTB, NXCD = 8, WGM = 8;

__host__ __device__ __forceinline__ int lds_byte(int r, int c) { const int st = (r >> 4) * 2 + (c >> 5), rr = r & 15, cc = c & 31, ob = rr * 64 + cc * 2; return st * 1024 + (ob ^ (((ob >> 9) & 1) << 5)); }
__host__ __device__ __forceinline__ void stage_rc(int b, int& R, int& C) { const int st = b / 1024, sb = b % 1024, swz = sb ^ (((sb >> 9) & 1) << 5); R = (st >> 1) * 16 + swz / 64; C = (st & 1) * 32 + (swz % 64) / 2; }
__host__ __device__ __forceinline__ int perm32(int rho) { const int n = rho >> 4, i = rho & 15; return 8 * (i >> 2) + 4 * n + (i & 3); }

struct Unit { int pm, pn, e; };
struct Gemm { const bf16_t* A; int K; };

struct DenseOrder {
    int nM, nN, nwg, G, c, K; const bf16_t* Bt;
    __device__ void init(int M, int N, int K_, const bf16_t* Bt_, int G_, int c_) { nM = M / BM; nN = N / BM; nwg = nM * nN; G = G_; c = c_; K = K_; Bt = Bt_; }
    __device__ bool next(int i, Unit& u) const {
        const long L = (long)i * G + c; if (L >= nwg) return false;
        int wgid = (int)L; { const int q = nwg / NXCD, r = nwg % NXCD, xcd = wgid % NXCD, off = wgid / NXCD; wgid = (xcd < r ? xcd * (q + 1) : r * (q + 1) + (xcd - r) * q) + off; }
        const int nig = WGM * nN, gid = wgid / nig, fm = gid * WGM, gsz = (nM - fm) < WGM ? (nM - fm) : WGM;
        u.pm = fm + ((wgid % nig) % gsz); u.pn = (wgid % nig) / gsz; u.e = 0; return true;
    }
    __device__ __forceinline__ void a_voff(const Unit& u, const int (&R)[2], const int (&C)[2], unsigned (&vo)[2][2]) const {
#pragma unroll
        for (int h = 0; h < 2; ++h)
#pragma unroll
            for (int i = 0; i < 2; ++i) vo[h][i] = (unsigned)((u.pm * BM + h * HALF + R[i]) * K + C[i]) * 2u;
    }
    __device__ __forceinline__ const char* b_ptr(const Unit& u) const { return (const char*)Bt + (size_t)u.pn * BM * K * 2; }
};

__device__ __forceinline__ unsigned cvt_pk_bf16(float lo, float hi) { unsigned r; asm volatile("v_cvt_pk_bf16_f32 %0, %1, %2" : "=v"(r) : "v"(lo), "v"(hi)); return r; }

template <class Epi, class Sched, bool ALIGN_EPI = false, bool SP2 = false>
__device__ __forceinline__ void gemm_phase(PG8_LAS unsigned char* lds, const Gemm g, const Sched& S, const Epi& E) {
    const int tid = threadIdx.x, wid = __builtin_amdgcn_readfirstlane(tid >> 6), lane = tid & 63, wr = wid >> 2, wc = wid & 3, fr = lane & 15, fq = lane >> 4;
    const int K = g.K, nt = K / BK;
    int RA[2], CA[2]; unsigned voffB[2];
#pragma unroll
    for (int i = 0; i < 2; ++i) { int R, C; stage_rc(tid * 16 + i * 8192, R, C); const int Rb = Epi::PERM ? ((R & ~31) + perm32(R & 31)) : R;
        RA[i] = R; CA[i] = C; voffB[i] = (unsigned)(Rb * K + C) * 2u; }
    const size_t kstep = (size_t)(BK * 2);
    const size_t hstep = (size_t)HALF * K * 2;
    const unsigned ldsw = (unsigned)wid * 1024u;
    const int aoff = lds_byte(wr * 64 + fr, fq * 8), boff = lds_byte(wc * 32 + fr, fq * 8);
#define PG8_SA(b, h) (((b) * 2 + (h)) * HTB)
#define PG8_SB(b, h) ((4 + (b) * 2 + (h)) * HTB)
#define PG8_STAGE(bufoff, gbase, voff) do { _Pragma("unroll") for (int _i = 0; _i < 2; ++_i) \
        __builtin_amdgcn_global_load_lds((const unsigned*)((const char*)(gbase) + (voff)[_i]), (PG8_LAS unsigned*)(lds + (bufoff) + ldsw + _i * 8192), 16, 0, 0); } while (0)
#define PG8_LDA(dst, b, h) do { _Pragma("unroll") for (int m = 0; m < 4; ++m) _Pragma("unroll") for (int k = 0; k < 2; ++k) dst[m][k] = *(const PG8_LAS bf16x8*)(lds + PG8_SA(b, h) + aoff + m * 2048 + k * 1024); } while (0)
#define PG8_LDB(dst, b, h) do { _Pragma("unroll") for (int n = 0; n < 2; ++n) _Pragma("unroll") for (int k = 0; k < 2; ++k) dst[n][k] = *(const PG8_LAS bf16x8*)(lds + PG8_SB(b, h) + boff + n * 2048 + k * 1024); } while (0)
#define PG8_MMA(ai, bj, At, Bt) do { __builtin_amdgcn_s_setprio(1); _Pragma("unroll") for (int m = 0; m < 4; ++m) _Pragma("unroll") for (int n = 0; n < 2; ++n) _Pragma("unroll") for (int k = 0; k < 2; ++k) \
        acc[ai][bj][m][n] = __builtin_amdgcn_mfma_f32_16x16x32_bf16(Bt[n][k], At[m][k], acc[ai][bj][m][n], 0, 0, 0); __builtin_amdgcn_s_setprio(0); } while (0)
#define PG8_WAIT_V(n) asm volatile("s_waitcnt vmcnt(" #n ")" ::: "memory")
#define PG8_WAIT_L(n) asm volatile("s_waitcnt lgkmcnt(" #n ")" ::: "memory")
#define PG8_BAR __builtin_amdgcn_s_barrier()
#define PG8_SCHED __builtin_amdgcn_sched_barrier(0)
    Unit cur, nxt; int ui = 0;
    if (!S.next(0, cur)) return;
    f32x4 acc[2][2][4][2];
#pragma unroll
    for (int a = 0; a < 2; ++a)
#pragma unroll
        for (int b = 0; b < 2; ++b)
#pragma unroll
            for (int m = 0; m < 4; ++m)
#pragma unroll
                for (int n = 0; n < 2; ++n) acc[a][b][m][n] = (f32x4){0.f, 0.f, 0.f, 0.f};
    bf16x8 At[4][2], B0[2][2], B1[2][2];
    unsigned cvo[2][2], nvo[2][2];
    S.a_voff(cur, RA, CA, cvo);
    const char* const Ab = (const char*)g.A;
    const char* cB = S.b_ptr(cur);
    if constexpr (SP2) {
        PG8_STAGE(PG8_SB(0, 0), cB, voffB); PG8_STAGE(PG8_SB(0, 1), cB + hstep, voffB); PG8_STAGE(PG8_SA(0, 0), Ab, cvo[0]); PG8_STAGE(PG8_SA(0, 1), Ab, cvo[1]);
        if (wr == 1) PG8_BAR;
        PG8_WAIT_V(2); PG8_BAR;
        PG8_STAGE(PG8_SB(1, 0), cB + kstep, voffB); PG8_STAGE(PG8_SA(1, 0), Ab + kstep, cvo[0]); PG8_STAGE(PG8_SB(1, 1), cB + hstep + kstep, voffB);
        PG8_WAIT_V(6); PG8_BAR;
    } else {
        PG8_STAGE(PG8_SB(0, 0), cB, voffB); PG8_STAGE(PG8_SA(0, 0), Ab, cvo[0]); PG8_STAGE(PG8_SB(0, 1), cB + hstep, voffB); PG8_STAGE(PG8_SA(0, 1), Ab, cvo[1]);
        if (wr == 1) PG8_BAR;
        PG8_WAIT_V(4); PG8_BAR;
        PG8_STAGE(PG8_SB(1, 0), cB + kstep, voffB); PG8_STAGE(PG8_SA(1, 0), Ab + kstep, cvo[0]); PG8_STAGE(PG8_SB(1, 1), cB + hstep + kstep, voffB);
        PG8_WAIT_V(6); PG8_BAR;
    }
    for (;;) {
        const bool has_next = S.next(ui + 1, nxt);
        const char* nB = cB;
        if (has_next) { nB = S.b_ptr(nxt); S.a_voff(nxt, RA, CA, nvo); }
        else { nvo[0][0] = cvo[0][0]; nvo[0][1] = cvo[0][1]; nvo[1][0] = cvo[1][0]; nvo[1][1] = cvo[1][1]; }
        for (int t = 0; t < nt; t += 2) {
            const bool last = (t == nt - 2);
            const char* a1 = Ab + (size_t)(t + 1) * kstep;
            const char* a2 = last ? Ab : Ab + (size_t)(t + 2) * kstep; const char* b2 = last ? nB : cB + (size_t)(t + 2) * kstep;
            const char* a3 = a2 + kstep; const char* b3 = b2 + kstep;
            unsigned v2[2][2];
            v2[0][0] = last ? nvo[0][0] : cvo[0][0]; v2[0][1] = last ? nvo[0][1] : cvo[0][1]; v2[1][0] = last ? nvo[1][0] : cvo[1][0]; v2[1][1] = last ? nvo[1][1] : cvo[1][1];
            if constexpr (SP2) {
            PG8_LDB(B0, 0, 0); PG8_LDB(B1, 0, 1); PG8_SCHED; PG8_LDA(At, 0, 0); PG8_STAGE(PG8_SA(1, 1), a1, cvo[1]);
            PG8_WAIT_V(8); PG8_WAIT_L(0); PG8_BAR; PG8_MMA(0, 0, At, B0); PG8_MMA(0, 1, At, B1); PG8_BAR; PG8_SCHED;
            PG8_LDA(At, 0, 1); PG8_STAGE(PG8_SB(0, 0), b2, voffB); PG8_STAGE(PG8_SB(0, 1), b2 + hstep, voffB); PG8_STAGE(PG8_SA(0, 0), a2, v2[0]);
            PG8_WAIT_V(8); PG8_WAIT_L(0); PG8_BAR; PG8_MMA(1, 0, At, B0); PG8_MMA(1, 1, At, B1); PG8_BAR; PG8_SCHED;
            PG8_LDB(B0, 1, 0); PG8_LDB(B1, 1, 1); PG8_SCHED; PG8_LDA(At, 1, 0); PG8_STAGE(PG8_SA(0, 1), a2, v2[1]);
            PG8_WAIT_V(8); PG8_WAIT_L(0); PG8_BAR; PG8_MMA(0, 0, At, B0); PG8_MMA(0, 1, At, B1); PG8_BAR; PG8_SCHED;
            PG8_LDA(At, 1, 1); PG8_STAGE(PG8_SB(1, 0), b3, voffB); PG8_STAGE(PG8_SB(1, 1), b3 + hstep, voffB); PG8_STAGE(PG8_SA(1, 0), a3, v2[0]);
            PG8_WAIT_V(8); PG8_WAIT_L(0); PG8_BAR; PG8_MMA(1, 0, At, B0); PG8_MMA(1, 1, At, B1); PG8_BAR; PG8_SCHED;
            } else {
            PG8_LDB(B0, 0, 0); PG8_SCHED; PG8_LDA(At, 0, 0); PG8_STAGE(PG8_SA(1, 1), a1, cvo[1]);
            PG8_WAIT_L(8); PG8_BAR; PG8_WAIT_L(0); PG8_MMA(0, 0, At, B0); PG8_BAR; PG8_SCHED;
            PG8_LDB(B1, 0, 1); PG8_STAGE(PG8_SB(0, 0), b2, voffB);
            PG8_BAR; PG8_WAIT_L(0); PG8_MMA(0, 1, At, B1); PG8_BAR;
            PG8_LDA(At, 0, 1); PG8_STAGE(PG8_SA(0, 0), a2, v2[0]);
            PG8_BAR; PG8_WAIT_L(0); PG8_MMA(1, 0, At, B0); PG8_BAR; PG8_SCHED;
            PG8_STAGE(PG8_SB(0, 1), b2 + hstep, voffB);
            PG8_WAIT_V(6); PG8_BAR; PG8_MMA(1, 1, At, B1); PG8_BAR;
            PG8_LDB(B0, 1, 0); PG8_SCHED; PG8_LDA(At, 1, 0); PG8_STAGE(PG8_SA(0, 1), a2, v2[1]);
            PG8_WAIT_L(8); PG8_BAR; PG8_WAIT_L(0); PG8_MMA(0, 0, At, B0); PG8_BAR; PG8_SCHED;
            PG8_LDB(B1, 1, 1); PG8_STAGE(PG8_SB(1, 0), b3, voffB);
            PG8_BAR; PG8_WAIT_L(0); PG8_MMA(0, 1, At, B1); PG8_BAR;
            PG8_LDA(At, 1, 1); PG8_STAGE(PG8_SA(1, 0), a3, v2[0]);
            PG8_BAR; PG8_WAIT_L(0); PG8_MMA(1, 0, At, B0); PG8_BAR; PG8_SCHED;
            PG8_STAGE(PG8_SB(1, 1), b3 + hstep, voffB);
            PG8_WAIT_V(6); PG8_BAR; PG8_MMA(1, 1, At, B1); PG8_BAR;
            }
        }
        if constexpr (ALIGN_EPI) { if (wr == 0) PG8_BAR; }
        E(acc, cur, wr, wc, fr, fq);
        if (!has_next) break;
#pragma unroll
        for (int a = 0; a < 2; ++a)
#pragma unroll
            for (int b = 0; b < 2; ++b)
#pragma unroll
                for (int m = 0; m < 4; ++m)
#pragma unroll
                    for (int n = 0; n < 2; ++n) acc[a][b][m][n] = (f32x4){0.f, 0.f, 0.f, 0.f};
        cur = nxt; cB = nB; ++ui;
        cvo[0][0] = nvo[0][0]; cvo[0][1] = nvo[0][1]; cvo[1][0] = nvo[1][0]; cvo[1][1] = nvo[1][1];
        if constexpr (ALIGN_EPI) { if (wr == 1) PG8_BAR; }
    }
    PG8_WAIT_V(0);
    if constexpr (!ALIGN_EPI) { if (wr == 0) PG8_BAR; }
    PG8_BAR;
#undef PG8_SA
#undef PG8_SB
#undef PG8_STAGE
#undef PG8_LDA
#undef PG8_LDB
#undef PG8_MMA
#undef PG8_WAIT_V
#undef PG8_WAIT_L
#undef PG8_BAR
#undef PG8_SCHED
}
}

constexpr int NWAVES = 8, NTHR = 512;
constexpr int T = 16384, D = 1024, SEQ = 4096, NB = 4;
constexpr int DIN = 3600, NMAIN = 3584;
constexpr int NE = 32, TOPK = 4, ECAP = 16384, MAXMT = 288;
constexpr float EPS = 1e-6f;
constexpr int MC_DNQ = 0, MC_DNK = 512, MC_DNV = 1024, MC_DNZ = 1536, MC_MLQ = 2048, MC_MLK = 2304, MC_MLV = 2560, MC_MLO = 3072;

constexpr size_t MiB = 1u << 20;
constexpr size_t WS_CTL = 0, CTL_ZERO_BYTES = 1 * MiB;
constexpr size_t WS_MOD = 1 * MiB;
constexpr size_t WS_MODF = WS_MOD + 128 * 1024;
constexpr size_t WS_WRT = WS_MOD + 256 * 1024;
constexpr size_t WS_WGT = WS_MOD + 384 * 1024;
constexpr size_t WS_BTIN = 2 * MiB;
constexpr size_t WS_BTOUT = 9 * MiB;
constexpr size_t WS_G16 = 11 * MiB;
constexpr size_t WS_TOKE = 12 * MiB;
constexpr size_t WS_TOKR = WS_TOKE + 256 * 1024;
constexpr size_t WS_TOKW = WS_TOKE + 512 * 1024;
constexpr size_t WS_SLOTTOK = 13 * MiB;
constexpr size_t WS_H = 16 * MiB;
constexpr size_t WS_MIX = 48 * MiB;
constexpr size_t WS_X1 = 80 * MiB;
constexpr size_t WS_BTGU = 144 * MiB;
constexpr size_t WS_BTDN = 272 * MiB;
constexpr size_t WS_PROJ = 336 * MiB;
constexpr size_t WS_RAW = 448 * MiB;
constexpr size_t WS_ACT = 336 * MiB;
constexpr size_t WS_Y = 480 * MiB;
constexpr size_t WS_END = 624 * MiB;
constexpr int CW_BAR = 4096;
constexpr int CW_CNT = 1024;

constexpr int RING_BYTES = 131072;
constexpr int LDSCTL_OFF = RING_BYTES;
constexpr int L_MISC = LDSCTL_OFF;
constexpr int L_CNT = LDSCTL_OFF + 256;
constexpr int L_TST = LDSCTL_OFF + 384;
constexpr int L_TILEE = LDSCTL_OFF + 576;
constexpr int L_EXTRA = LDSCTL_OFF + 2048;
constexpr int LDS_BYTES = 147456;

#define LAS __attribute__((address_space(3)))
typedef unsigned short bf16;
typedef unsigned v4u __attribute__((ext_vector_type(4)));
typedef unsigned v2u __attribute__((ext_vector_type(2)));
typedef float f32x4 __attribute__((ext_vector_type(4)));
#define LDS_WAIT() asm volatile("s_waitcnt lgkmcnt(0)" ::: "memory")
__device__ __forceinline__ unsigned f2bf(float f) { unsigned u = __builtin_bit_cast(unsigned, f); return (u + 0x7fffu + ((u >> 16) & 1u)) >> 16; }
__device__ __forceinline__ unsigned pk2(float lo, float hi) { return f2bf(lo) | (f2bf(hi) << 16); }
__device__ __forceinline__ float bf2f(unsigned short b) { return __builtin_bit_cast(float, ((unsigned)b) << 16); }
__device__ __forceinline__ float sigmoidf_(float x) { return 1.0f / (1.0f + __expf(-x)); }
__device__ __forceinline__ float siluf_(float x) { return x / (1.0f + __expf(-x)); }
__device__ __forceinline__ float softplusf_(float x) { return x > 20.f ? x : log1pf(__expf(x)); }
__device__ __forceinline__ float logsigmoidf_(float x) { return x < 0.f ? x - log1pf(__expf(x)) : -log1pf(__expf(-x)); }

#define XB_TMO      128
#define XB_XCNT(j)  (256  + 64 * (j))
#define XB_XSUB(j)  (1280 + 64 * (j))
#define XB_XGEN(j)  (2304 + 64 * (j))
#define XB_TOP      3328
#define XB_TOPGEN   3392
#define XCD_BAR_WORDS 3456
#define XB_SPIN_CAP (1u << 18)
__device__ __forceinline__ unsigned xb_ld(unsigned* p)              { return __hip_atomic_load(p, __ATOMIC_RELAXED, __HIP_MEMORY_SCOPE_AGENT); }
__device__ __forceinline__ unsigned xb_add(unsigned* p, unsigned v) { return __hip_atomic_fetch_add(p, v, __ATOMIC_RELAXED, __HIP_MEMORY_SCOPE_AGENT); }
__device__ __forceinline__ unsigned xb_xcc_id() { return (unsigned)__builtin_amdgcn_s_getreg((3 << 11) | 20) & 0xFu; }
#define XB_SPIN(cond, bar) do { unsigned _sp = 0; while (cond) { __builtin_amdgcn_s_sleep(1); \
    if ((++_sp & 255u) == 0u) { if (xb_ld(&(bar)[XB_TMO])) break; if (_sp > XB_SPIN_CAP) { atomicAdd(&(bar)[XB_TMO], 1u); break; } } } } while (0)
struct XcdBarrier { unsigned* bar; unsigned x; volatile LAS unsigned* st; };
__device__ __forceinline__ XcdBarrier xcd_barrier_post(unsigned* bar, volatile LAS unsigned* st) {
    XcdBarrier b; b.bar = bar; b.x = xb_xcc_id(); b.st = st;
    if (threadIdx.x == 0) (void)xb_add(&bar[XB_XCNT(b.x)], 1u);
    return b;
}
__device__ __forceinline__ void xcd_barrier_complete(unsigned* bar, unsigned x, unsigned& nloc, unsigned& nx) {
    const unsigned G = gridDim.x * gridDim.y * gridDim.z;
    unsigned sum, cnt, mine, sp = 0u;
    for (;;) {
        sum = 0u; cnt = 0u; mine = 0u;
#pragma unroll
        for (unsigned j = 0; j < 16; ++j) { const unsigned c = xb_ld(&bar[XB_XCNT(j)]); sum += c; cnt += (c > 0u) ? 1u : 0u; mine = (j == x) ? c : mine; }
        if (sum == G) break;
        __builtin_amdgcn_s_sleep(1);
        if ((++sp & 255u) == 0u) { if (xb_ld(&bar[XB_TMO])) break; if (sp > XB_SPIN_CAP) { atomicAdd(&bar[XB_TMO], 1u); break; } }
    }
    nloc = mine > 0u ? mine : 1u; nx = cnt > 0u ? cnt : 1u;
}
__device__ __forceinline__ void xcd_barrier(const XcdBarrier& b) {
    asm volatile("s_waitcnt vmcnt(0)" ::: "memory");
    __syncthreads();
    if (threadIdx.x == 0) {
        unsigned* bar = b.bar;
        __builtin_amdgcn_s_waitcnt(0);
        unsigned nloc = b.st[0], nx = b.st[1];
        if (nloc == 0u) { xcd_barrier_complete(bar, b.x, nloc, nx); b.st[0] = nloc; b.st[1] = nx; }
        const unsigned old = xb_add(&bar[XB_XSUB(b.x)], 1u);
        const unsigned gen = old / nloc;
        if (old + 1u == (gen + 1u) * nloc) {
            __builtin_amdgcn_fence(__ATOMIC_RELEASE, "agent");
            asm volatile("s_waitcnt vmcnt(0)" ::: "memory");
            const unsigned og = xb_add(&bar[XB_TOP], 1u);
            const unsigned tg = og / nx;
            if (og + 1u == (tg + 1u) * nx) xb_add(&bar[XB_TOPGEN], 1u);
            else XB_SPIN(xb_ld(&bar[XB_TOPGEN]) == tg, bar);
            __builtin_amdgcn_fence(__ATOMIC_ACQUIRE, "agent");
            xb_add(&bar[XB_XGEN(b.x)], 1u);
            asm volatile("s_waitcnt vmcnt(0)" ::: "memory");
        } else {
            XB_SPIN(xb_ld(&bar[XB_XGEN(b.x)]) == gen, bar);
            __builtin_amdgcn_fence(__ATOMIC_ACQUIRE, "agent");
            asm volatile("s_waitcnt vmcnt(0)" ::: "memory");
        }
    }
    __syncthreads();
}

struct Args { const float* in[25]; float* out; unsigned char* ws; int ph_lo, ph_hi; };
struct Frame {
    LAS unsigned char* lds; unsigned char* ws; const float* in[25]; float* out;
    int tid, lane, wave, vb, G;
};
enum { I_X = 0, I_C, I_WADA, I_BADA, I_NMIX, I_WIN, I_DNCONV, I_DNALOG, I_DNDT, I_DNNORM, I_MLCONV, I_MLIB, I_MLFB, I_MLNORM, I_WOUT, I_NFFN, I_WR, I_BR, I_WGU, I_BGU, I_WDN, I_BDN, I_WADAF, I_BADAF, I_NFIN };

__device__ __forceinline__ float wave_sum(float v) {
#pragma unroll
    for (int o = 1; o < 64; o <<= 1) v += __shfl_xor(v, o);
    return v;
}

__device__ __forceinline__ void transpose_item(const float* W, int ldw, int K, bf16* WT, int k0, int src_n0, int dst_n0, LAS float* scr, int lane) {
#pragma unroll 8
    for (int i = 0; i < 32; ++i) { const int kk = 2 * i + (lane >> 5); scr[kk * 33 + (lane & 31)] = W[(size_t)(k0 + kk) * ldw + src_n0 + (lane & 31)]; }
    LDS_WAIT(); asm volatile("" ::: "memory");
    const int c = lane & 7;
#pragma unroll
    for (int j = 0; j < 4; ++j) { const int n = (lane >> 3) + 8 * j; const LAS float* s = scr + (8 * c) * 33 + n;
        v4u o; o.x = pk2(s[0 * 33], s[1 * 33]); o.y = pk2(s[2 * 33], s[3 * 33]); o.z = pk2(s[4 * 33], s[5 * 33]); o.w = pk2(s[6 * 33], s[7 * 33]);
        *(v4u*)(WT + (size_t)(dst_n0 + n) * K + k0 + 8 * c) = o; }
    LDS_WAIT(); asm volatile("" ::: "memory");
}
__device__ __forceinline__ void p0_prologue(Frame& F) {
    {
        LAS float* cond = (LAS float*)F.lds;
        LAS float* part = (LAS float*)(F.lds + 16384);
        const float* c = F.in[I_C];
        for (int i = F.tid; i < NB * D; i += NTHR) cond[i] = siluf_(c[i]);
        __syncthreads();
        for (int cb = F.vb; cb < 256; cb += F.G) {
            const int j0 = cb * 32; const bool fin = j0 >= 6144;
            const float* W = fin ? F.in[I_WADAF] : F.in[I_WADA]; const int ld = fin ? 2048 : 6144; const int jc = fin ? j0 - 6144 : j0;
            const float* bias = fin ? F.in[I_BADAF] : F.in[I_BADA];
            float* out = fin ? (float*)(F.ws + WS_MODF) : (float*)(F.ws + WS_MOD);
            const int s = F.tid >> 5, jj = F.tid & 31;
            float a0 = 0.f, a1 = 0.f, a2 = 0.f, a3 = 0.f;
            for (int k = s * 64; k < s * 64 + 64; ++k) { const float w = W[(size_t)k * ld + jc + jj]; a0 += cond[k] * w; a1 += cond[1024 + k] * w; a2 += cond[2048 + k] * w; a3 += cond[3072 + k] * w; }
            part[(s * 4 + 0) * 32 + jj] = a0; part[(s * 4 + 1) * 32 + jj] = a1; part[(s * 4 + 2) * 32 + jj] = a2; part[(s * 4 + 3) * 32 + jj] = a3;
            __syncthreads();
            if (F.tid < 128) { const int b = F.tid >> 5, j = F.tid & 31; float sum = 0.f;
                for (int q = 0; q < 16; ++q) sum += part[(q * 4 + b) * 32 + j];
                out[b * ld + jc + j] = sum + bias[jc + j]; }
            __syncthreads();
        }
    }
    {
        const int gt = F.vb * NTHR + F.tid, NGT = F.G * NTHR;
        float* wrT = (float*)(F.ws + WS_WRT); const float* wr = F.in[I_WR];
        for (int i = gt; i < NE * D; i += NGT) { const int e = i >> 10, k = i & 1023; wrT[i] = wr[k * NE + e]; }
        float* wgT = (float*)(F.ws + WS_WGT); const float* win = F.in[I_WIN];
        for (int i = gt; i < 16 * D; i += NGT) { const int g = i >> 10, k = i & 1023; const int col = g < 8 ? 2048 + g : 3592 + (g - 8); wgT[i] = win[(size_t)k * DIN + col]; }
    }
    {
        LAS float* scr = (LAS float*)(F.lds + F.wave * 16384);
        const int gw = F.vb * NWAVES + F.wave, NGW = F.G * NWAVES;
        constexpr int I_IN = 16 * (NMAIN / 32), I_OUT = 16 * 32, I_GU1 = 16 * 64, I_DN1 = 16 * 32;
        constexpr int NITEMS = I_IN + I_OUT + NE * I_GU1 + NE * I_DN1;
        for (int it = gw; it < NITEMS; it += NGW) {
            int r = it;
            if (r < I_IN) { const int nblk = NMAIN / 32, kb = r / nblk, nb = r % nblk; const int dn0 = nb * 32, sn0 = dn0 < 2048 ? dn0 : dn0 + 8;
                transpose_item(F.in[I_WIN], DIN, D, (bf16*)(F.ws + WS_BTIN), kb * 64, sn0, dn0, scr, F.lane); continue; }
            r -= I_IN;
            if (r < I_OUT) { const int kb = r / 32, nb = r % 32; transpose_item(F.in[I_WOUT], D, D, (bf16*)(F.ws + WS_BTOUT), kb * 64, nb * 32, nb * 32, scr, F.lane); continue; }
            r -= I_OUT;
            if (r < NE * I_GU1) { const int e = r / I_GU1, q = r % I_GU1, kb = q / 64, nb = q % 64; const int dn0 = nb * 32;
                const int sn0 = ((dn0 & 255) >> 7) * 1024 + (dn0 >> 8) * 128 + (dn0 & 127);
                transpose_item(F.in[I_WGU] + (size_t)e * D * 2048, 2048, D, (bf16*)(F.ws + WS_BTGU) + (size_t)e * 2048 * D, kb * 64, sn0, dn0, scr, F.lane); continue; }
            r -= NE * I_GU1;
            { const int e = r / I_DN1, q = r % I_DN1, kb = q / 32, nb = q % 32;
                transpose_item(F.in[I_WDN] + (size_t)e * D * D, D, D, (bf16*)(F.ws + WS_BTDN) + (size_t)e * D * D, kb * 64, nb * 32, nb * 32, scr, F.lane); }
        }
    }
}

#define MR_STEP(n, bit) { const bool hi = (lane & (bit)) != 0; _Pragma("unroll") for (int i = 0; i < (n) / 2; ++i) { const float send = hi ? v[i] : v[i + (n) / 2]; const float keep = hi ? v[i + (n) / 2] : v[i]; v[i] = keep + __shfl_xor(send, (bit)); } }
template <int N> __device__ __forceinline__ float multi_reduce(float (&v)[N], int lane) {
    float r;
    if constexpr (N == 32) { MR_STEP(32, 32) MR_STEP(16, 16) MR_STEP(8, 8) MR_STEP(4, 4) MR_STEP(2, 2) r = v[0]; r += __shfl_xor(r, 1); }
    else { MR_STEP(16, 32) MR_STEP(8, 16) MR_STEP(4, 8) MR_STEP(2, 4) r = v[0]; r += __shfl_xor(r, 2); r += __shfl_xor(r, 1); }
    return r;
}

__device__ __forceinline__ void p1_norm1(Frame& F) {
    LAS float* wg = (LAS float*)F.lds;
    { const float* src = (const float*)(F.ws + WS_WGT); for (int i = F.tid; i < 16 * D / 4; i += NTHR) ((LAS f32x4*)wg)[i] = ((const f32x4*)src)[i]; }
    __syncthreads();
    const float* x = F.in[I_X]; const float* nw = F.in[I_NMIX]; const float* mod = (const float*)(F.ws + WS_MOD);
    bf16* h1 = (bf16*)(F.ws + WS_H); float* g16 = (float*)(F.ws + WS_G16);
    const int gw = F.vb * NWAVES + F.wave, NGW = F.G * NWAVES;
    for (int row = gw; row < T; row += NGW) {
        const int b = row / SEQ;
        const f32x4* xr = (const f32x4*)(x + (size_t)row * D) + F.lane;
        f32x4 v[4]; float ss = 0.f;
#pragma unroll
        for (int j = 0; j < 4; ++j) { v[j] = xr[64 * j]; ss += (v[j].x * v[j].x + v[j].y * v[j].y) + (v[j].z * v[j].z + v[j].w * v[j].w); }
        const float rstd = rsqrtf(wave_sum(ss) * (1.f / D) + EPS);
        const float* sh = mod + b * 6144; const float* sc = sh + 1024;
#pragma unroll
        for (int j = 0; j < 4; ++j) { const int k = 256 * j + F.lane * 4;
            const f32x4 w = *(const f32x4*)(nw + k), s1 = *(const f32x4*)(sc + k), s0 = *(const f32x4*)(sh + k);
            v[j] = (v[j] * rstd * w) * (1.0f + s1) + s0; }
        v2u* o8 = (v2u*)(h1 + (size_t)row * D) + F.lane;
#pragma unroll
        for (int j = 0; j < 4; ++j) { v2u o; o.x = pk2(v[j].x, v[j].y); o.y = pk2(v[j].z, v[j].w); o8[64 * j] = o; }
        float acc[16];
#pragma unroll
        for (int g = 0; g < 16; ++g) { float a = 0.f;
#pragma unroll
            for (int j = 0; j < 4; ++j) { const f32x4 w = *(const LAS f32x4*)(wg + g * 1024 + 256 * j + F.lane * 4); a += (v[j].x * w.x + v[j].y * w.y) + (v[j].z * w.z + v[j].w * w.w); }
            acc[g] = a; if (g & 1) asm volatile("" ::: "memory"); }
        const float r = multi_reduce<16>(acc, F.lane);
        if ((F.lane & 3) == 0) g16[(size_t)row * 16 + (F.lane >> 2)] = r;
    }
}

struct EpiProj {
    static constexpr bool PERM = true;
    bf16* O; int ldc;
    __device__ __forceinline__ void operator()(const pg8::f32x4 (&acc)[2][2][4][2], const pg8::Unit& u, int wr, int wc, int fr, int fq) const {
        const int row0 = u.pm * 256 + wr * 64 + fr, col0 = u.pn * 256 + wc * 32 + 8 * fq;
#pragma unroll
        for (int ai = 0; ai < 2; ++ai)
#pragma unroll
            for (int m = 0; m < 4; ++m) { bf16* rowp = O + (size_t)(row0 + ai * 128 + m * 16) * ldc + col0;
#pragma unroll
                for (int bj = 0; bj < 2; ++bj) { const pg8::f32x4 v0 = acc[ai][bj][m][0], v1 = acc[ai][bj][m][1];
                    v4u w; w.x = pg8::cvt_pk_bf16(v0[0], v0[1]); w.y = pg8::cvt_pk_bf16(v0[2], v0[3]); w.z = pg8::cvt_pk_bf16(v1[0], v1[1]); w.w = pg8::cvt_pk_bf16(v1[2], v1[3]);
                    *(v4u*)(rowp + bj * 128) = w; } }
    }
};
struct EpiRes {
    static constexpr bool PERM = false;
    const float* X; float* O; const float* mod;
    __device__ __forceinline__ void operator()(const pg8::f32x4 (&acc)[2][2][4][2], const pg8::Unit& u, int wr, int wc, int fr, int fq) const {
        const int row0 = u.pm * 256 + wr * 64 + fr, col0 = u.pn * 256 + wc * 32 + 4 * fq;
        const int b = (u.pm * 256) / SEQ; const float* g1 = mod + b * 6144 + 2048;
        pg8::f32x4 gv[2][2];
#pragma unroll
        for (int bj = 0; bj < 2; ++bj)
#pragma unroll
            for (int n = 0; n < 2; ++n) gv[bj][n] = *(const pg8::f32x4*)(g1 + col0 + bj * 128 + n * 16);
#pragma unroll
        for (int ai = 0; ai < 2; ++ai)
#pragma unroll
            for (int m = 0; m < 4; ++m) { const size_t off = (size_t)(row0 + ai * 128 + m * 16) * D + col0;
#pragma unroll
                for (int bj = 0; bj < 2; ++bj)
#pragma unroll
                    for (int n = 0; n < 2; ++n) { const pg8::f32x4 xv = *(const pg8::f32x4*)(X + off + bj * 128 + n * 16);
                        *(pg8::f32x4*)(O + off + bj * 128 + n * 16) = xv + gv[bj][n] * acc[ai][bj][m][n]; }
                asm volatile("" ::: "memory"); }
    }
};
struct EpiGU {
    static constexpr bool PERM = true;
    bf16* O; const float* bgu;
    __device__ __forceinline__ void operator()(const pg8::f32x4 (&acc)[2][2][4][2], const pg8::Unit& u, int wr, int wc, int fr, int fq) const {
        const int row0 = u.pm * 256 + wr * 64 + fr, cc = u.pn * 128 + wc * 32 + 8 * fq;
        const float* bg = bgu + (size_t)u.e * 2048 + cc; const float* bu = bg + 1024;
        pg8::f32x4 bgv[2], buv[2];
#pragma unroll
        for (int n = 0; n < 2; ++n) { bgv[n] = *(const pg8::f32x4*)(bg + 4 * n); buv[n] = *(const pg8::f32x4*)(bu + 4 * n); }
#pragma unroll
        for (int ai = 0; ai < 2; ++ai)
#pragma unroll
            for (int m = 0; m < 4; ++m) { bf16* rowp = O + (size_t)(row0 + ai * 128 + m * 16) * D + cc;
                float r[8];
#pragma unroll
                for (int n = 0; n < 2; ++n)
#pragma unroll
                    for (int j = 0; j < 4; ++j) { float gt = acc[ai][0][m][n][j] + bgv[n][j], up = acc[ai][1][m][n][j] + buv[n][j];
                        gt = fminf(gt, 7.0f); up = fminf(fmaxf(up, -7.0f), 7.0f);
                        r[n * 4 + j] = (up + 1.0f) * gt * sigmoidf_(1.702f * gt); }
                v4u w; w.x = pg8::cvt_pk_bf16(r[0], r[1]); w.y = pg8::cvt_pk_bf16(r[2], r[3]); w.z = pg8::cvt_pk_bf16(r[4], r[5]); w.w = pg8::cvt_pk_bf16(r[6], r[7]);
                *(v4u*)rowp = w; }
    }
};
struct EpiDown {
    static constexpr bool PERM = true;
    bf16* O; const float* bdn;
    __device__ __forceinline__ void operator()(const pg8::f32x4 (&acc)[2][2][4][2], const pg8::Unit& u, int wr, int wc, int fr, int fq) const {
        const int row0 = u.pm * 256 + wr * 64 + fr, col0 = u.pn * 256 + wc * 32 + 8 * fq;
        const float* bb = bdn + (size_t)u.e * D + col0;
        pg8::f32x4 bv[2][2];
#pragma unroll
        for (int bj = 0; bj < 2; ++bj)
#pragma unroll
            for (int n = 0; n < 2; ++n) bv[bj][n] = *(const pg8::f32x4*)(bb + bj * 128 + 4 * n);
#pragma unroll
        for (int ai = 0; ai < 2; ++ai)
#pragma unroll
            for (int m = 0; m < 4; ++m) { bf16* rowp = O + (size_t)(row0 + ai * 128 + m * 16) * D + col0;
#pragma unroll
                for (int bj = 0; bj < 2; ++bj) { const pg8::f32x4 v0 = acc[ai][bj][m][0] + bv[bj][0], v1 = acc[ai][bj][m][1] + bv[bj][1];
                    v4u w; w.x = pg8::cvt_pk_bf16(v0[0], v0[1]); w.y = pg8::cvt_pk_bf16(v0[2], v0[3]); w.z = pg8::cvt_pk_bf16(v1[0], v1[1]); w.w = pg8::cvt_pk_bf16(v1[2], v1[3]);
                    *(v4u*)(rowp + bj * 128) = w; } }
    }
};

template <int MB, int NBK, bool GATHER> struct GroupedOrder {
    int G, c, nmt, K; const LAS int* tileE; const LAS int* tst; const LAS int* cnt; const int* slot_tok; const bf16* Bt; size_t bexp;
    __device__ bool next(int i, pg8::Unit& u) const {
        const int nwg = nmt * NBK; const long L = (long)i * G + c; if (L >= nwg) return false;
        int U = (int)L; { const int q = nwg / 8, r = nwg % 8, xcd = U % 8, off = U / 8; U = (xcd < r ? xcd * (q + 1) : r * (q + 1) + (xcd - r) * q) + off; }
        const int nig = MB * NBK, gid = U / nig, fm = gid * MB, gsz = (nmt - fm) < MB ? (nmt - fm) : MB;
        u.pm = fm + ((U % nig) % gsz); u.pn = (U % nig) / gsz; u.e = tileE[u.pm]; return true;
    }
    __device__ __forceinline__ void a_voff(const pg8::Unit& u, const int (&R)[2], const int (&C)[2], unsigned (&vo)[2][2]) const {
        if (GATHER) {
            const int r0 = (u.pm - tst[u.e]) * 256, ce = cnt[u.e];
#pragma unroll
            for (int h = 0; h < 2; ++h)
#pragma unroll
                for (int i = 0; i < 2; ++i) { const int rk = r0 + h * 128 + R[i]; int tok = 0; if (rk < ce) tok = slot_tok[u.e * ECAP + rk];
                    vo[h][i] = (unsigned)(tok * K + C[i]) * 2u; }
        } else {
#pragma unroll
            for (int h = 0; h < 2; ++h)
#pragma unroll
                for (int i = 0; i < 2; ++i) vo[h][i] = (unsigned)((u.pm * 256 + h * 128 + R[i]) * K + C[i]) * 2u;
        }
    }
    __device__ __forceinline__ const char* b_ptr(const pg8::Unit& u) const { return (const char*)(Bt + (size_t)u.e * bexp + (size_t)u.pn * 256 * K); }
};

__device__ __forceinline__ int build_expert_tables(Frame& F) {
    LAS int* lc = (LAS int*)(F.lds + L_CNT); LAS int* lt = (LAS int*)(F.lds + L_TST); LAS int* le = (LAS int*)(F.lds + L_TILEE);
    const unsigned* gc = (const unsigned*)(F.ws + WS_CTL) + CW_CNT;
    __syncthreads();
    if (F.tid < 64) {
        int c = 0; if (F.lane < NE) { c = (int)__hip_atomic_load(gc + F.lane, __ATOMIC_RELAXED, __HIP_MEMORY_SCOPE_AGENT); if (c > ECAP) c = ECAP; }
        const int nt = (c + 255) >> 8; int incl = nt;
#pragma unroll
        for (int o = 1; o < 32; o <<= 1) { const int v = __shfl_up(incl, o); if (F.lane >= o) incl += v; }
        const int excl = incl - nt;
        if (F.lane < NE) { lc[F.lane] = c; lt[F.lane] = excl; for (int i = 0; i < nt; ++i) le[excl + i] = F.lane; }
        if (F.lane == NE - 1) lt[NE] = incl;
    }
    __syncthreads();
    return lt[NE];
}

__device__ __forceinline__ void p3_naive_dn(Frame& F, int bh) {
    const int b = bh >> 2, h = bh & 3;
    LAS float* qs_ = (LAS float*)F.lds;
    LAS float* ks_ = qs_ + 64 * 128;
    LAS float* vs_ = ks_ + 64 * 128;
    LAS float* qsc = vs_ + 64 * 128;
    LAS float* ksc = qsc + 64; LAS float* bet = ksc + 64; LAS float* ade = bet + 64;
    const bf16* proj = (const bf16*)(F.ws + WS_PROJ); const float* g16 = (const float*)(F.ws + WS_G16);
    const float* cw = F.in[I_DNCONV]; float* raw = (float*)(F.ws + WS_RAW);
    const float Aexp = __expf(F.in[I_DNALOG][h]), dtb = F.in[I_DNDT][h];
    const int e = F.tid >> 2, ds = F.tid & 3, d0 = ds * 32;
    float S[32];
#pragma unroll
    for (int i = 0; i < 32; ++i) S[i] = 0.f;
    for (int n = 0; n < 64; ++n) {
        __syncthreads();
        for (int idx = F.tid; idx < 64 * 384; idx += NTHR) {
            const int i = idx / 384, c = idx % 384, which = c >> 7, cc = c & 127, col = which * 512 + h * 128 + cc;
            const int t = n * 64 + i; float a = 0.f;
#pragma unroll
            for (int j = 0; j < 4; ++j) { const int tt = t - 3 + j; if (tt >= 0) a += bf2f(proj[(size_t)(b * SEQ + tt) * NMAIN + col]) * cw[j * 1536 + col]; }
            (which == 0 ? qs_ : which == 1 ? ks_ : vs_)[i * 128 + cc] = siluf_(a);
        }
        if (F.tid < 64) { const size_t row = (size_t)b * SEQ + n * 64 + F.tid;
            bet[F.tid] = sigmoidf_(g16[row * 16 + h]); ade[F.tid] = __expf(-Aexp * softplusf_(g16[row * 16 + 4 + h] + dtb)); }
        __syncthreads();
        if (F.tid < 128) { const int i = F.tid & 63, which = F.tid >> 6; const LAS float* p = (which ? ks_ : qs_) + i * 128; float ss = 0.f;
            for (int c = 0; c < 128; ++c) ss += p[c] * p[c];
            const float sc = rsqrtf(ss + EPS); if (which) ksc[i] = sc; else qsc[i] = sc * 0.08838834764831845f; }
        __syncthreads();
        for (int i = 0; i < 64; ++i) {
            const float kscale = ksc[i], qscale = qsc[i], be = bet[i], a = ade[i];
            const LAS float* kp = ks_ + i * 128 + d0; const LAS float* qp = qs_ + i * 128 + d0;
            float kv[32]; float p = 0.f;
#pragma unroll
            for (int d = 0; d < 32; ++d) { kv[d] = kp[d] * kscale; p += kv[d] * S[d]; }
            p += __shfl_xor(p, 1); p += __shfl_xor(p, 2);
            const float uu = be * (vs_[i * 128 + e] - a * p);
            float o = 0.f;
#pragma unroll
            for (int d = 0; d < 32; ++d) { S[d] = a * S[d] + kv[d] * uu; o += qp[d] * S[d]; }
            o *= qscale; o += __shfl_xor(o, 1); o += __shfl_xor(o, 2);
            if (ds == 0) raw[((size_t)b * SEQ + n * 64 + i) * D + h * 128 + e] = o;
        }
    }
}
__device__ __forceinline__ void p3_naive_ml(Frame& F, int bh) {
    const int b = bh >> 2, h = bh & 3;
    LAS float* qs_ = (LAS float*)F.lds;
    LAS float* ks_ = qs_ + 64 * 64;
    LAS float* vs_ = ks_ + 64 * 64;
    LAS float* ipr = vs_ + 64 * 128; LAS float* lgf = ipr + 64;
    const bf16* proj = (const bf16*)(F.ws + WS_PROJ); const float* g16 = (const float*)(F.ws + WS_G16);
    const float* cw = F.in[I_MLCONV]; float* raw = (float*)(F.ws + WS_RAW);
    const float ib = F.in[I_MLIB][h], fb = F.in[I_MLFB][h];
    const int e = F.tid >> 2, ds = F.tid & 3, d0 = ds * 16;
    float C[16], nn[16]; float m = 0.f;
#pragma unroll
    for (int i = 0; i < 16; ++i) { C[i] = 0.f; nn[i] = 0.f; }
    for (int n = 0; n < 64; ++n) {
        __syncthreads();
        for (int idx = F.tid; idx < 64 * 128; idx += NTHR) {
            const int i = idx >> 7, c = idx & 127, which = c >> 6, cc = c & 63, ch = which * 256 + h * 64 + cc;
            const int t = n * 64 + i; float a = 0.f;
#pragma unroll
            for (int j = 0; j < 4; ++j) { const int tt = t - 3 + j; if (tt >= 0) a += bf2f(proj[(size_t)(b * SEQ + tt) * NMAIN + MC_MLQ + ch]) * cw[j * 512 + ch]; }
            const float y = siluf_(a);
            if (which == 0) qs_[i * 64 + cc] = y * 0.125f; else ks_[i * 64 + cc] = y;
        }
        for (int idx = F.tid; idx < 64 * 128; idx += NTHR) { const int i = idx >> 7, c = idx & 127;
            vs_[idx] = bf2f(proj[(size_t)(b * SEQ + n * 64 + i) * NMAIN + MC_MLV + h * 128 + c]); }
        if (F.tid < 64) { const size_t row = (size_t)b * SEQ + n * 64 + F.tid;
            ipr[F.tid] = g16[row * 16 + 8 + h] + ib; lgf[F.tid] = logsigmoidf_(g16[row * 16 + 12 + h] + fb); }
        __syncthreads();
        for (int i = 0; i < 64; ++i) {
            const float lf = lgf[i], ip = ipr[i];
            const float mn = fmaxf(lf + m, ip), fp = __expf(lf + m - mn), iq = __expf(ip - mn); m = mn;
            const LAS float* kp = ks_ + i * 64 + d0; const LAS float* qp = qs_ + i * 64 + d0;
            const float vv = vs_[i * 128 + e] * iq;
            float num = 0.f, den = 0.f;
#pragma unroll
            for (int d = 0; d < 16; ++d) { const float kk = kp[d], qq = qp[d]; C[d] = fp * C[d] + kk * vv; nn[d] = fp * nn[d] + iq * kk; num += qq * C[d]; den += qq * nn[d]; }
            num += __shfl_xor(num, 1); num += __shfl_xor(num, 2); den += __shfl_xor(den, 1); den += __shfl_xor(den, 2);
            const float hh = num / fmaxf(fabsf(den), __expf(-m));
            if (ds == 0) raw[((size_t)b * SEQ + n * 64 + i) * D + 512 + h * 128 + e] = hh;
        }
    }
}

__device__ __forceinline__ void p4_mixnorm(Frame& F) {
    const float* raw = (const float*)(F.ws + WS_RAW); const bf16* proj = (const bf16*)(F.ws + WS_PROJ); bf16* mix = (bf16*)(F.ws + WS_MIX);
    const float* dnn = F.in[I_DNNORM]; const float* mln = F.in[I_MLNORM];
    const int gw = F.vb * NWAVES + F.wave, NGW = F.G * NWAVES;
    for (int row = gw; row < T; row += NGW) {
        const f32x4* rr = (const f32x4*)(raw + (size_t)row * D) + F.lane;
        v2u* o8 = (v2u*)(mix + (size_t)row * D) + F.lane;
#pragma unroll
        for (int j = 0; j < 4; ++j) {
            f32x4 v = rr[64 * j]; float ss = (v.x * v.x + v.y * v.y) + (v.z * v.z + v.w * v.w);
#pragma unroll
            for (int o = 1; o < 32; o <<= 1) ss += __shfl_xor(ss, o);
            const float rstd = rsqrtf(ss * (1.f / 128.f) + EPS);
            const int k = 256 * j + F.lane * 4;
            f32x4 w, gt;
            if (j < 2) { w = *(const f32x4*)(dnn + (k & 127)); const v2u z = *(const v2u*)(proj + (size_t)row * NMAIN + MC_DNZ + k);
                gt.x = siluf_(bf2f(z.x & 0xffff)); gt.y = siluf_(bf2f(z.x >> 16)); gt.z = siluf_(bf2f(z.y & 0xffff)); gt.w = siluf_(bf2f(z.y >> 16)); }
            else { w = *(const f32x4*)(mln + (k - 512)); const v2u z = *(const v2u*)(proj + (size_t)row * NMAIN + MC_MLO + (k - 512));
                gt.x = sigmoidf_(bf2f(z.x & 0xffff)); gt.y = sigmoidf_(bf2f(z.x >> 16)); gt.z = sigmoidf_(bf2f(z.y & 0xffff)); gt.w = sigmoidf_(bf2f(z.y >> 16)); }
            v = v * rstd * w * gt;
            v2u o; o.x = pk2(v.x, v.y); o.y = pk2(v.z, v.w); o8[64 * j] = o;
        }
    }
}

__device__ __forceinline__ void p6_router(Frame& F) {
    LAS float* wr = (LAS float*)F.lds;
    LAS float* lg = (LAS float*)(F.lds + L_EXTRA);
    { const float* src = (const float*)(F.ws + WS_WRT); for (int i = F.tid; i < NE * D / 4; i += NTHR) ((LAS f32x4*)wr)[i] = ((const f32x4*)src)[i]; }
    __syncthreads();
    const float* x1 = (const float*)(F.ws + WS_X1); const float* nw = F.in[I_NFFN]; const float* mod = (const float*)(F.ws + WS_MOD);
    bf16* h2 = (bf16*)(F.ws + WS_H); const float* br = F.in[I_BR];
    int* tok_e = (int*)(F.ws + WS_TOKE); int* tok_r = (int*)(F.ws + WS_TOKR); float* tok_w = (float*)(F.ws + WS_TOKW); int* slot_tok = (int*)(F.ws + WS_SLOTTOK);
    unsigned* gcnt = (unsigned*)(F.ws + WS_CTL) + CW_CNT;
    for (int blk = F.vb; blk < T / 64; blk += F.G) {
        for (int rr = 0; rr < 8; ++rr) {
            const int lr = F.wave * 8 + rr, row = blk * 64 + lr, b = row / SEQ;
            const f32x4* xr = (const f32x4*)(x1 + (size_t)row * D) + F.lane;
            f32x4 v[4]; float ss = 0.f;
#pragma unroll
            for (int j = 0; j < 4; ++j) { v[j] = xr[64 * j]; ss += (v[j].x * v[j].x + v[j].y * v[j].y) + (v[j].z * v[j].z + v[j].w * v[j].w); }
            const float rstd = rsqrtf(wave_sum(ss) * (1.f / D) + EPS);
            const float* sh = mod + b * 6144 + 3072; const float* sc = sh + 1024;
#pragma unroll
            for (int j = 0; j < 4; ++j) { const int k = 256 * j + F.lane * 4;
                const f32x4 w = *(const f32x4*)(nw + k), s1 = *(const f32x4*)(sc + k), s0 = *(const f32x4*)(sh + k);
                v[j] = (v[j] * rstd * w) * (1.0f + s1) + s0; }
            v2u* o8 = (v2u*)(h2 + (size_t)row * D) + F.lane;
#pragma unroll
            for (int j = 0; j < 4; ++j) { v2u o; o.x = pk2(v[j].x, v[j].y); o.y = pk2(v[j].z, v[j].w); o8[64 * j] = o; }
            float acc[32];
#pragma unroll
            for (int e = 0; e < 32; ++e) { float a = 0.f;
#pragma unroll
                for (int j = 0; j < 4; ++j) { const f32x4 w = *(const LAS f32x4*)(wr + e * 1024 + 256 * j + F.lane * 4); a += (v[j].x * w.x + v[j].y * w.y) + (v[j].z * w.z + v[j].w * w.w); }
                acc[e] = a; if (e & 1) asm volatile("" ::: "memory"); }
            const float r = multi_reduce<32>(acc, F.lane);
            if ((F.lane & 1) == 0) lg[lr * 33 + (F.lane >> 1)] = r + br[F.lane >> 1];
        }
        __syncthreads();
        if (F.wave == 0) {
            const int row = blk * 64 + F.lane;
            float l[32];
#pragma unroll
            for (int e = 0; e < 32; ++e) l[e] = lg[F.lane * 33 + e];
            int te[4]; float tl[4];
#pragma unroll
            for (int k = 0; k < 4; ++k) { float best = -3.0e38f; int bi = 0;
#pragma unroll
                for (int e = 0; e < 32; ++e) { if (l[e] > best) { best = l[e]; bi = e; } }
                te[k] = bi; tl[k] = best;
#pragma unroll
                for (int e = 0; e < 32; ++e) if (e == bi) l[e] = -3.0e38f; }
            float w0 = 1.f, w1 = __expf(tl[1] - tl[0]), w2 = __expf(tl[2] - tl[0]), w3 = __expf(tl[3] - tl[0]); const float inv = 1.f / (w0 + w1 + w2 + w3);
            w0 *= inv; w1 *= inv; w2 *= inv; w3 *= inv;
            int mycount = 0;
#pragma unroll
            for (int k = 0; k < 4; ++k) {
#pragma unroll 1
                for (int e = 0; e < 32; ++e) { const unsigned long long mk = __ballot(te[k] == e); if (F.lane == e) mycount += __popcll(mk); } }
            int base = 0; if (F.lane < 32) base = (int)__hip_atomic_fetch_add(gcnt + F.lane, (unsigned)mycount, __ATOMIC_RELAXED, __HIP_MEMORY_SCOPE_AGENT);
            int run = 0;
            int rk[4];
#pragma unroll
            for (int k = 0; k < 4; ++k) { rk[k] = 0;
#pragma unroll 1
                for (int e = 0; e < 32; ++e) { const unsigned long long mk = __ballot(te[k] == e);
                    const int be = __shfl(base, e), re = __shfl(run, e);
                    if (te[k] == e) rk[k] = be + re + __popcll(mk & ((1ull << F.lane) - 1ull));
                    if (F.lane == e) run += __popcll(mk); } }
            const float ww[4] = {w0, w1, w2, w3};
#pragma unroll
            for (int k = 0; k < 4; ++k) { tok_e[row * 4 + k] = te[k]; tok_r[row * 4 + k] = rk[k]; tok_w[row * 4 + k] = ww[k]; if (rk[k] < ECAP) slot_tok[te[k] * ECAP + rk[k]] = row; }
        }
        __syncthreads();
    }
}

__device__ __forceinline__ void p9_final(Frame& F) {
    build_expert_tables(F);
    const LAS int* tst = (const LAS int*)(F.lds + L_TST);
    const float* x1 = (const float*)(F.ws + WS_X1); const bf16* y = (const bf16*)(F.ws + WS_Y);
    const float* mod = (const float*)(F.ws + WS_MOD); const float* modf = (const float*)(F.ws + WS_MODF); const float* nf = F.in[I_NFIN];
    const int* tok_e = (const int*)(F.ws + WS_TOKE); const int* tok_r = (const int*)(F.ws + WS_TOKR); const float* tok_w = (const float*)(F.ws + WS_TOKW);
    const int gw = F.vb * NWAVES + F.wave, NGW = F.G * NWAVES;
    for (int row = gw; row < T; row += NGW) {
        const int b = row / SEQ;
        const f32x4* xr = (const f32x4*)(x1 + (size_t)row * D) + F.lane;
        f32x4 v[4], m[4];
#pragma unroll
        for (int j = 0; j < 4; ++j) { v[j] = xr[64 * j]; m[j] = (f32x4){0.f, 0.f, 0.f, 0.f}; }
#pragma unroll
        for (int k = 0; k < 4; ++k) { const int e = tok_e[row * 4 + k], r = tok_r[row * 4 + k]; const float w = tok_w[row * 4 + k];
            const size_t cs = (size_t)tst[e] * 256 + r;
            const v2u* yr = (const v2u*)(y + cs * D) + F.lane;
#pragma unroll
            for (int j = 0; j < 4; ++j) { const v2u z = yr[64 * j];
                m[j].x += w * bf2f(z.x & 0xffff); m[j].y += w * bf2f(z.x >> 16); m[j].z += w * bf2f(z.y & 0xffff); m[j].w += w * bf2f(z.y >> 16); } }
        const float* g2 = mod + b * 6144 + 5120; float ss = 0.f;
#pragma unroll
        for (int j = 0; j < 4; ++j) { const f32x4 g = *(const f32x4*)(g2 + 256 * j + F.lane * 4); v[j] = v[j] + g * m[j];
            ss += (v[j].x * v[j].x + v[j].y * v[j].y) + (v[j].z * v[j].z + v[j].w * v[j].w); }
        const float rstd = rsqrtf(wave_sum(ss) * (1.f / D) + EPS);
        const float* sh = modf + b * 2048; const float* sc = sh + 1024;
        f32x4* orow = (f32x4*)(F.out + (size_t)row * D) + F.lane;
#pragma unroll
        for (int j = 0; j < 4; ++j) { const int k = 256 * j + F.lane * 4;
            const f32x4 w = *(const f32x4*)(nf + k), s1 = *(const f32x4*)(sc + k), s0 = *(const f32x4*)(sh + k);
            orow[64 * j] = (v[j] * rstd * w) * (1.0f + s1) + s0; }
    }
}

constexpr int NPH = 10;
__global__ void __launch_bounds__(NTHR, 2) fwd(Args args) {
    extern __shared__ __attribute__((aligned(16))) unsigned char lds_raw[];
    Frame F;
    F.lds = (LAS unsigned char*)lds_raw; F.ws = args.ws; F.out = args.out;
#pragma unroll
    for (int i = 0; i < 25; ++i) F.in[i] = args.in[i];
    F.tid = threadIdx.x; F.lane = F.tid & 63; F.wave = __builtin_amdgcn_readfirstlane(F.tid >> 6);
    F.G = gridDim.x; F.vb = blockIdx.x;
    for (int u = F.tid; u < (LDS_BYTES - LDSCTL_OFF) / 4; u += NTHR) ((LAS unsigned*)(F.lds + LDSCTL_OFF))[u] = 0u;
    __syncthreads();
    unsigned* ctl = (unsigned*)(F.ws + WS_CTL);
    const int lo = args.ph_lo, hi = args.ph_hi;
    XcdBarrier bar; bar.bar = ctl + CW_BAR; bar.x = 0; bar.st = nullptr;
    if (hi - lo > 1) bar = xcd_barrier_post(ctl + CW_BAR, (volatile LAS unsigned*)(F.lds + L_MISC) + 8);
#ifndef PHMASK
#define PHMASK 0x3ff
#endif
#define IN(k) (((PHMASK >> (k)) & 1) && lo <= (k) && (k) < hi)
#define SEAM(k) do { if (IN(k) && IN((k) + 1)) xcd_barrier(bar); } while (0)

    if (IN(0)) { p0_prologue(F); } SEAM(0);
    if (IN(1)) { p1_norm1(F); } SEAM(1);
    if (IN(2)) {
        pg8::Gemm g{(const bf16*)(F.ws + WS_H), D}; pg8::DenseOrder S; S.init(T, NMAIN, D, (const bf16*)(F.ws + WS_BTIN), F.G, F.vb);
        EpiProj E{(bf16*)(F.ws + WS_PROJ), NMAIN};
        pg8::gemm_phase<EpiProj, pg8::DenseOrder, true, true>(F.lds, g, S, E);
    } SEAM(2);
    if (IN(3)) { if (F.vb < 16) p3_naive_dn(F, F.vb); else if (F.vb < 32) p3_naive_ml(F, F.vb - 16); } SEAM(3);
    if (IN(4)) { p4_mixnorm(F); } SEAM(4);
    if (IN(5)) {
        pg8::Gemm g{(const bf16*)(F.ws + WS_MIX), D}; pg8::DenseOrder S; S.init(T, D, D, (const bf16*)(F.ws + WS_BTOUT), F.G, F.vb);
        EpiRes E{F.in[I_X], (float*)(F.ws + WS_X1), (const float*)(F.ws + WS_MOD)};
        pg8::gemm_phase<EpiRes, pg8::DenseOrder, false, true>(F.lds, g, S, E);
    } SEAM(5);
    if (IN(6)) { p6_router(F); } SEAM(6);
    if (IN(7)) {
        const int nmt = build_expert_tables(F);
        GroupedOrder<4, 8, true> S; S.G = F.G; S.c = F.vb; S.nmt = nmt; S.K = D; S.tileE = (const LAS int*)(F.lds + L_TILEE); S.tst = (const LAS int*)(F.lds + L_TST); S.cnt = (const LAS int*)(F.lds + L_CNT);
        S.slot_tok = (const int*)(F.ws + WS_SLOTTOK); S.Bt = (const bf16*)(F.ws + WS_BTGU); S.bexp = (size_t)2048 * D;
        pg8::Gemm g{(const bf16*)(F.ws + WS_H), D};
        EpiGU E{(bf16*)(F.ws + WS_ACT), F.in[I_BGU]};
        pg8::gemm_phase<EpiGU, GroupedOrder<4, 8, true>, true, true>(F.lds, g, S, E);
    } SEAM(7);
    if (IN(8)) {
        const int nmt = build_expert_tables(F);
        GroupedOrder<8, 4, false> S; S.G = F.G; S.c = F.vb; S.nmt = nmt; S.K = D; S.tileE = (const LAS int*)(F.lds + L_TILEE); S.tst = (const LAS int*)(F.lds + L_TST); S.cnt = (const LAS int*)(F.lds + L_CNT);
        S.slot_tok = nullptr; S.Bt = (const bf16*)(F.ws + WS_BTDN); S.bexp = (size_t)D * D;
        pg8::Gemm g{(const bf16*)(F.ws + WS_ACT), D};
        EpiDown E{(bf16*)(F.ws + WS_Y), F.in[I_BDN]};
        pg8::gemm_phase<EpiDown, GroupedOrder<8, 4, false>, true, true>(F.lds, g, S, E);
    } SEAM(8);
    if (IN(9)) { p9_final(F); }
#undef IN
#undef SEAM
}

extern "C" void kernel_launch(void* const* d_in, const int* in_sizes, int n_in, void* d_out, int out_size, void* d_ws, size_t ws_size, hipStream_t stream) {
    static int grid = 0;
    if (grid == 0) {
        if (n_in != 25 || in_sizes[0] != T * D || out_size != T * D || ws_size < WS_END) { fprintf(stderr, "kernel_launch: unexpected shapes (n_in %d, ws %zu)\n", n_in, ws_size); grid = -1; return; }
        int dev = 0, cus = 0, per_cu = 0;
        if (hipGetDevice(&dev) != hipSuccess || hipDeviceGetAttribute(&cus, hipDeviceAttributeMultiprocessorCount, dev) != hipSuccess) { grid = -1; return; }
        if (hipFuncSetAttribute((const void*)fwd, hipFuncAttributeMaxDynamicSharedMemorySize, LDS_BYTES) != hipSuccess) { fprintf(stderr, "kernel_launch: hipFuncSetAttribute failed\n"); grid = -1; return; }
        if (hipOccupancyMaxActiveBlocksPerMultiprocessor(&per_cu, (const void*)fwd, NTHR, LDS_BYTES) != hipSuccess || per_cu < 1) { fprintf(stderr, "kernel_launch: occupancy query says %d\n", per_cu); }
        (void)hipGetLastError();
        grid = cus;
    }
    if (grid < 0) return;
    hipMemsetAsync((char*)d_ws + WS_CTL, 0, CTL_ZERO_BYTES, stream);
    Args a{};
    for (int i = 0; i < 25; ++i) a.in[i] = (const float*)d_in[i];
    a.out = (float*)d_out; a.ws = (unsigned char*)d_ws;
#if MK_ONE_LAUNCH
    a.ph_lo = 0; a.ph_hi = NPH;
    hipLaunchKernelGGL(fwd, dim3(grid), dim3(NTHR), LDS_BYTES, stream, a);
#else
    for (int p = 0; p < NPH; ++p) { a.ph_lo = p; a.ph_hi = p + 1; hipLaunchKernelGGL(fwd, dim3(grid), dim3(NTHR), LDS_BYTES, stream, a); }
#endif
}
```

```cpp
#include <hip/hip_runtime.h>
#include <cstdio>
#include <cstdint>

#ifndef MK_ONE_LAUNCH
#define MK_ONE_LAUNCH 1
#endif

namespace pg8 {
#define PG8_LAS __attribute__((address_space(3)))
typedef unsigned short bf16_t;
typedef short bf16x8 __attribute__((ext_vector_type(8)));
typedef float f32x4 __attribute__((ext_vector_type(4)));
typedef unsigned u32x4 __attribute__((ext_vector_type(4)));
constexpr int BM = 256, BK = 64, HALF = 128, HTB = HALF * BK * 2, STAGE_BYTES = 8 * HTB, NXCD = 8, WGM = 8;

__host__ __device__ __forceinline__ int lds_byte(int r, int c) { const int st = (r >> 4) * 2 + (c >> 5), rr = r & 15, cc = c & 31, ob = rr * 64 + cc * 2; return st * 1024 + (ob ^ (((ob >> 9) & 1) << 5)); }
__host__ __device__ __forceinline__ void stage_rc(int b, int& R, int& C) { const int st = b / 1024, sb = b % 1024, swz = sb ^ (((sb >> 9) & 1) << 5); R = (st >> 1) * 16 + swz / 64; C = (st & 1) * 32 + (swz % 64) / 2; }
__host__ __device__ __forceinline__ int perm32(int rho) { const int n = rho >> 4, i = rho & 15; return 8 * (i >> 2) + 4 * n + (i & 3); }

struct Unit { int pm, pn, e; };
struct Gemm { const bf16_t* A; int K; };

struct DenseOrder {
    int nM, nN, nwg, G, c, K; const bf16_t* Bt;
    __device__ void init(int M, int N, int K_, const bf16_t* Bt_, int G_, int c_) { nM = M / BM; nN = N / BM; nwg = nM * nN; G = G_; c = c_; K = K_; Bt = Bt_; }
    __device__ bool next(int i, Unit& u) const {
        const long L = (long)i * G + c; if (L >= nwg) return false;
        int wgid = (int)L; { const int q = nwg / NXCD, r = nwg % NXCD, xcd = wgid % NXCD, off = wgid / NXCD; wgid = (xcd < r ? xcd * (q + 1) : r * (q + 1) + (xcd - r) * q) + off; }
        const int nig = WGM * nN, gid = wgid / nig, fm = gid * WGM, gsz = (nM - fm) < WGM ? (nM - fm) : WGM;
        u.pm = fm + ((wgid % nig) % gsz); u.pn = (wgid % nig) / gsz; u.e = 0; return true;
    }
    __device__ __forceinline__ void a_voff(const Unit& u, const int (&R)[2], const int (&C)[2], unsigned (&vo)[2][2]) const {
#pragma unroll
        for (int h = 0; h < 2; ++h)
#pragma unroll
            for (int i = 0; i < 2; ++i) vo[h][i] = (unsigned)((u.pm * BM + h * HALF + R[i]) * K + C[i]) * 2u;
    }
    __device__ __forceinline__ const char* b_ptr(const Unit& u) const { return (const char*)Bt + (size_t)u.pn * BM * K * 2; }
};

__device__ __forceinline__ unsigned cvt_pk_bf16(float lo, float hi) { unsigned r; asm volatile("v_cvt_pk_bf16_f32 %0, %1, %2" : "=v"(r) : "v"(lo), "v"(hi)); return r; }

template <class Epi, class Sched, bool ALIGN_EPI = false, bool SP2 = false>
__device__ __forceinline__ void gemm_phase(PG8_LAS unsigned char* lds, const Gemm g, const Sched& S, const Epi& E) {
    const int tid = threadIdx.x, wid = __builtin_amdgcn_readfirstlane(tid >> 6), lane = tid & 63, wr = wid >> 2, wc = wid & 3, fr = lane & 15, fq = lane >> 4;
    const int K = g.K, nt = K / BK;
    int RA[2], CA[2]; unsigned voffB[2];
#pragma unroll
    for (int i = 0; i < 2; ++i) { int R, C; stage_rc(tid * 16 + i * 8192, R, C); const int Rb = Epi::PERM ? ((R & ~31) + perm32(R & 31)) : R;
        RA[i] = R; CA[i] = C; voffB[i] = (unsigned)(Rb * K + C) * 2u; }
    const size_t kstep = (size_t)(BK * 2);
    const size_t hstep = (size_t)HALF * K * 2;
    const unsigned ldsw = (unsigned)wid * 1024u;
    const int aoff = lds_byte(wr * 64 + fr, fq * 8), boff = lds_byte(wc * 32 + fr, fq * 8);
#define PG8_SA(b, h) (((b) * 2 + (h)) * HTB)
#define PG8_SB(b, h) ((4 + (b) * 2 + (h)) * HTB)
#define PG8_STAGE(bufoff, gbase, voff) do { _Pragma("unroll") for (int _i = 0; _i < 2; ++_i) \
        __builtin_amdgcn_global_load_lds((const unsigned*)((const char*)(gbase) + (voff)[_i]), (PG8_LAS unsigned*)(lds + (bufoff) + ldsw + _i * 8192), 16, 0, 0); } while (0)
#define PG8_LDA(dst, b, h) do { _Pragma("unroll") for (int m = 0; m < 4; ++m) _Pragma("unroll") for (int k = 0; k < 2; ++k) dst[m][k] = *(const PG8_LAS bf16x8*)(lds + PG8_SA(b, h) + aoff + m * 2048 + k * 1024); } while (0)
#define PG8_LDB(dst, b, h) do { _Pragma("unroll") for (int n = 0; n < 2; ++n) _Pragma("unroll") for (int k = 0; k < 2; ++k) dst[n][k] = *(const PG8_LAS bf16x8*)(lds + PG8_SB(b, h) + boff + n * 2048 + k * 1024); } while (0)
#define PG8_MMA(ai, bj, At, Bt) do { __builtin_amdgcn_s_setprio(1); _Pragma("unroll") for (int m = 0; m < 4; ++m) _Pragma("unroll") for (int n = 0; n < 2; ++n) _Pragma("unroll") for (int k = 0; k < 2; ++k) \
        acc[ai][bj][m][n] = __builtin_amdgcn_mfma_f32_16x16x32_bf16(Bt[n][k], At[m][k], acc[ai][bj][m][n], 0, 0, 0); __builtin_amdgcn_s_setprio(0); } while (0)
#define PG8_WAIT_V(n) asm volatile("s_waitcnt vmcnt(" #n ")" ::: "memory")
#define PG8_WAIT_L(n) asm volatile("s_waitcnt lgkmcnt(" #n ")" ::: "memory")
#define PG8_BAR __builtin_amdgcn_s_barrier()
#define PG8_SCHED __builtin_amdgcn_sched_barrier(0)
    Unit cur, nxt; int ui = 0;
    if (!S.next(0, cur)) return;
    f32x4 acc[2][2][4][2];
#pragma unroll
    for (int a = 0; a < 2; ++a)
#pragma unroll
        for (int b = 0; b < 2; ++b)
#pragma unroll
            for (int m = 0; m < 4; ++m)
#pragma unroll
                for (int n = 0; n < 2; ++n) acc[a][b][m][n] = (f32x4){0.f, 0.f, 0.f, 0.f};
    bf16x8 At[4][2], B0[2][2], B1[2][2];
    unsigned cvo[2][2], nvo[2][2];
    S.a_voff(cur, RA, CA, cvo);
    const char* const Ab = (const char*)g.A;
    const char* cB = S.b_ptr(cur);
    if constexpr (SP2) {
        PG8_STAGE(PG8_SB(0, 0), cB, voffB); PG8_STAGE(PG8_SB(0, 1), cB + hstep, voffB); PG8_STAGE(PG8_SA(0, 0), Ab, cvo[0]); PG8_STAGE(PG8_SA(0, 1), Ab, cvo[1]);
        if (wr == 1) PG8_BAR;
        PG8_WAIT_V(2); PG8_BAR;
        PG8_STAGE(PG8_SB(1, 0), cB + kstep, voffB); PG8_STAGE(PG8_SA(1, 0), Ab + kstep, cvo[0]); PG8_STAGE(PG8_SB(1, 1), cB + hstep + kstep, voffB);
        PG8_WAIT_V(6); PG8_BAR;
    } else {
        PG8_STAGE(PG8_SB(0, 0), cB, voffB); PG8_STAGE(PG8_SA(0, 0), Ab, cvo[0]); PG8_STAGE(PG8_SB(0, 1), cB + hstep, voffB); PG8_STAGE(PG8_SA(0, 1), Ab, cvo[1]);
        if (wr == 1) PG8_BAR;
        PG8_WAIT_V(4); PG8_BAR;
        PG8_STAGE(PG8_SB(1, 0), cB + kstep, voffB); PG8_STAGE(PG8_SA(1, 0), Ab + kstep, cvo[0]); PG8_STAGE(PG8_SB(1, 1), cB + hstep + kstep, voffB);
        PG8_WAIT_V(6); PG8_BAR;
    }
    for (;;) {
        const bool has_next = S.next(ui + 1, nxt);
        const char* nB = cB;
        if (has_next) { nB = S.b_ptr(nxt); S.a_voff(nxt, RA, CA, nvo); }
        else { nvo[0][0] = cvo[0][0]; nvo[0][1] = cvo[0][1]; nvo[1][0] = cvo[1][0]; nvo[1][1] = cvo[1][1]; }
        for (int t = 0; t < nt; t += 2) {
            const bool last = (t == nt - 2);
            const char* a1 = Ab + (size_t)(t + 1) * kstep;
            const char* a2 = last ? Ab : Ab + (size_t)(t + 2) * kstep; const char* b2 = last ? nB : cB + (size_t)(t + 2) * kstep;
            const char* a3 = a2 + kstep; const char* b3 = b2 + kstep;
            unsigned v2[2][2];
            v2[0][0] = last ? nvo[0][0] : cvo[0][0]; v2[0][1] = last ? nvo[0][1] : cvo[0][1]; v2[1][0] = last ? nvo[1][0] : cvo[1][0]; v2[1][1] = last ? nvo[1][1] : cvo[1][1];
            if constexpr (SP2) {
            PG8_LDB(B0, 0, 0); PG8_LDB(B1, 0, 1); PG8_SCHED; PG8_LDA(At, 0, 0); PG8_STAGE(PG8_SA(1, 1), a1, cvo[1]);
            PG8_WAIT_V(8); PG8_WAIT_L(0); PG8_BAR; PG8_MMA(0, 0, At, B0); PG8_MMA(0, 1, At, B1); PG8_BAR; PG8_SCHED;
            PG8_LDA(At, 0, 1); PG8_STAGE(PG8_SB(0, 0), b2, voffB); PG8_STAGE(PG8_SB(0, 1), b2 + hstep, voffB); PG8_STAGE(PG8_SA(0, 0), a2, v2[0]);
            PG8_WAIT_V(8); PG8_WAIT_L(0); PG8_BAR; PG8_MMA(1, 0, At, B0); PG8_MMA(1, 1, At, B1); PG8_BAR; PG8_SCHED;
            PG8_LDB(B0, 1, 0); PG8_LDB(B1, 1, 1); PG8_SCHED; PG8_LDA(At, 1, 0); PG8_STAGE(PG8_SA(0, 1), a2, v2[1]);
            PG8_WAIT_V(8); PG8_WAIT_L(0); PG8_BAR; PG8_MMA(0, 0, At, B0); PG8_MMA(0, 1, At, B1); PG8_BAR; PG8_SCHED;
            PG8_LDA(At, 1, 1); PG8_STAGE(PG8_SB(1, 0), b3, voffB); PG8_STAGE(PG8_SB(1, 1), b3 + hstep, voffB); PG8_STAGE(PG8_SA(1, 0), a3, v2[0]);
            PG8_WAIT_V(8); PG8_WAIT_L(0); PG8_BAR; PG8_MMA(1, 0, At, B0); PG8_MMA(1, 1, At, B1); PG8_BAR; PG8_SCHED;
            } else {
            PG8_LDB(B0, 0, 0); PG8_SCHED; PG8_LDA(At, 0, 0); PG8_STAGE(PG8_SA(1, 1), a1, cvo[1]);
            PG8_WAIT_L(8); PG8_BAR; PG8_WAIT_L(0); PG8_MMA(0, 0, At, B0); PG8_BAR; PG8_SCHED;
            PG8_LDB(B1, 0, 1); PG8_STAGE(PG8_SB(0, 0), b2, voffB);
            PG8_BAR; PG8_WAIT_L(0); PG8_MMA(0, 1, At, B1); PG8_BAR;
            PG8_LDA(At, 0, 1); PG8_STAGE(PG8_SA(0, 0), a2, v2[0]);
            PG8_BAR; PG8_WAIT_L(0); PG8_MMA(1, 0, At, B0); PG8_BAR; PG8_SCHED;
            PG8_STAGE(PG8_SB(0, 1), b2 + hstep, voffB);
            PG8_WAIT_V(6); PG8_BAR; PG8_MMA(1, 1, At, B1); PG8_BAR;
            PG8_LDB(B0, 1, 0); PG8_SCHED; PG8_LDA(At, 1, 0); PG8_STAGE(PG8_SA(0, 1), a2, v2[1]);
            PG8_WAIT_L(8); PG8_BAR; PG8_WAIT_L(0); PG8_MMA(0, 0, At, B0); PG8_BAR; PG8_SCHED;
            PG8_LDB(B1, 1, 1); PG8_STAGE(PG8_SB(1, 0), b3, voffB);
            PG8_BAR; PG8_WAIT_L(0); PG8_MMA(0, 1, At, B1); PG8_BAR;
            PG8_LDA(At, 1, 1); PG8_STAGE(PG8_SA(1, 0), a3, v2[0]);
            PG8_BAR; PG8_WAIT_L(0); PG8_MMA(1, 0, At, B0); PG8_BAR; PG8_SCHED;
            PG8_STAGE(PG8_SB(1, 1), b3 + hstep, voffB);
            PG8_WAIT_V(6); PG8_BAR; PG8_MMA(1, 1, At, B1); PG8_BAR;
            }
        }
        if constexpr (ALIGN_EPI) { if (wr == 0) PG8_BAR; }
        E(acc, cur, wr, wc, fr, fq);
        if (!has_next) break;
#pragma unroll
        for (int a = 0; a < 2; ++a)
#pragma unroll
            for (int b = 0; b < 2; ++b)
#pragma unroll
                for (int m = 0; m < 4; ++m)
#pragma unroll
                    for (int n = 0; n < 2; ++n) acc[a][b][m][n] = (f32x4){0.f, 0.f, 0.f, 0.f};
        cur = nxt; cB = nB; ++ui;
        cvo[0][0] = nvo[0][0]; cvo[0][1] = nvo[0][1]; cvo[1][0] = nvo[1][0]; cvo[1][1] = nvo[1][1];
        if constexpr (ALIGN_EPI) { if (wr == 1) PG8_BAR; }
    }
    PG8_WAIT_V(0);
    if constexpr (!ALIGN_EPI) { if (wr == 0) PG8_BAR; }
    PG8_BAR;
#undef PG8_SA
#undef PG8_SB
#undef PG8_STAGE
#undef PG8_LDA
#undef PG8_LDB
#undef PG8_MMA
#undef PG8_WAIT_V
#undef PG8_WAIT_L
#undef PG8_BAR
#undef PG8_SCHED
}
}

constexpr int NWAVES = 8, NTHR = 512;
constexpr int T = 16384, D = 1024, SEQ = 4096, NB = 4;
constexpr int DIN = 3600, NMAIN = 3584;
constexpr int NE = 32, TOPK = 4, ECAP = 16384, MAXMT = 288;
constexpr float EPS = 1e-6f;
constexpr int MC_DNQ = 0, MC_DNK = 512, MC_DNV = 1024, MC_DNZ = 1536, MC_MLQ = 2048, MC_MLK = 2304, MC_MLV = 2560, MC_MLO = 3072;

constexpr size_t MiB = 1u << 20;
constexpr size_t WS_CTL = 0, CTL_ZERO_BYTES = 1 * MiB;
constexpr size_t WS_MOD = 1 * MiB;
constexpr size_t WS_MODF = WS_MOD + 128 * 1024;
constexpr size_t WS_WRT = WS_MOD + 256 * 1024;
constexpr size_t WS_WGT = WS_MOD + 384 * 1024;
constexpr size_t WS_BTIN = 2 * MiB;
constexpr size_t WS_BTOUT = 9 * MiB;
constexpr size_t WS_G16 = 11 * MiB;
constexpr size_t WS_TOKE = 12 * MiB;
constexpr size_t WS_TOKR = WS_TOKE + 256 * 1024;
constexpr size_t WS_TOKW = WS_TOKE + 512 * 1024;
constexpr size_t WS_SLOTTOK = 13 * MiB;
constexpr size_t WS_H = 16 * MiB;
constexpr size_t WS_MIX = 48 * MiB;
constexpr size_t WS_X1 = 80 * MiB;
constexpr size_t WS_BTGU = 144 * MiB;
constexpr size_t WS_BTDN = 272 * MiB;
constexpr size_t WS_PROJ = 336 * MiB;
constexpr size_t WS_RAW = 448 * MiB;
constexpr size_t WS_ACT = 336 * MiB;
constexpr size_t WS_Y = 480 * MiB;
constexpr size_t WS_DN_MP = 512 * MiB;
constexpr size_t WS_DN_UT = 544 * MiB;
constexpr size_t WS_DN_KC = 608 * MiB;
constexpr size_t WS_DN_WT = 624 * MiB;
constexpr size_t WS_DN_QD = 640 * MiB;
constexpr size_t WS_DN_QK = 656 * MiB;
constexpr size_t WS_DN_SD = 664 * MiB;
constexpr size_t WS_DN_ST = 666 * MiB;
constexpr size_t WS_ML_UPT = 698 * MiB;
constexpr size_t WS_ML_QC = 730 * MiB;
constexpr size_t WS_ML_KC = 738 * MiB;
constexpr size_t WS_ML_CT = 746 * MiB;
constexpr size_t WS_ML_AUX = 762 * MiB;
constexpr size_t WS_END = 764 * MiB;
constexpr int CW_BAR = 4096;
constexpr int CW_CNT = 1024;

constexpr int RING_BYTES = 131072;
constexpr int LDSCTL_OFF = RING_BYTES;
constexpr int L_MISC = LDSCTL_OFF;
constexpr int L_CNT = LDSCTL_OFF + 256;
constexpr int L_TST = LDSCTL_OFF + 384;
constexpr int L_TILEE = LDSCTL_OFF + 576;
constexpr int L_EXTRA = LDSCTL_OFF + 2048;
constexpr int LDS_BYTES = 147456;

#define LAS __attribute__((address_space(3)))
typedef unsigned short bf16;
typedef unsigned v4u __attribute__((ext_vector_type(4)));
typedef unsigned v2u __attribute__((ext_vector_type(2)));
typedef float f32x4 __attribute__((ext_vector_type(4)));
#define LDS_WAIT() asm volatile("s_waitcnt lgkmcnt(0)" ::: "memory")
__device__ __forceinline__ unsigned f2bf(float f) { unsigned u = __builtin_bit_cast(unsigned, f); return (u + 0x7fffu + ((u >> 16) & 1u)) >> 16; }
__device__ __forceinline__ unsigned pk2(float lo, float hi) { return f2bf(lo) | (f2bf(hi) << 16); }
__device__ __forceinline__ float bf2f(unsigned short b) { return __builtin_bit_cast(float, ((unsigned)b) << 16); }
__device__ __forceinline__ float sigmoidf_(float x) { return 1.0f / (1.0f + __expf(-x)); }
__device__ __forceinline__ float siluf_(float x) { return x / (1.0f + __expf(-x)); }
__device__ __forceinline__ float softplusf_(float x) { return x > 20.f ? x : log1pf(__expf(x)); }
__device__ __forceinline__ float logsigmoidf_(float x) { return x < 0.f ? x - log1pf(__expf(x)) : -log1pf(__expf(-x)); }

#define XB_TMO      128
#define XB_XCNT(j)  (256  + 64 * (j))
#define XB_XSUB(j)  (1280 + 64 * (j))
#define XB_XGEN(j)  (2304 + 64 * (j))
#define XB_TOP      3328
#define XB_TOPGEN   3392
#define XCD_BAR_WORDS 3456
#define XB_SPIN_CAP (1u << 18)
__device__ __forceinline__ unsigned xb_ld(unsigned* p)              { return __hip_atomic_load(p, __ATOMIC_RELAXED, __HIP_MEMORY_SCOPE_AGENT); }
__device__ __forceinline__ unsigned xb_add(unsigned* p, unsigned v) { return __hip_atomic_fetch_add(p, v, __ATOMIC_RELAXED, __HIP_MEMORY_SCOPE_AGENT); }
__device__ __forceinline__ unsigned xb_xcc_id() { return (unsigned)__builtin_amdgcn_s_getreg((3 << 11) | 20) & 0xFu; }
#define XB_SPIN(cond, bar) do { unsigned _sp = 0; while (cond) { __builtin_amdgcn_s_sleep(1); \
    if ((++_sp & 255u) == 0u) { if (xb_ld(&(bar)[XB_TMO])) break; if (_sp > XB_SPIN_CAP) { atomicAdd(&(bar)[XB_TMO], 1u); break; } } } } while (0)
struct XcdBarrier { unsigned* bar; unsigned x; volatile LAS unsigned* st; };
__device__ __forceinline__ XcdBarrier xcd_barrier_post(unsigned* bar, volatile LAS unsigned* st) {
    XcdBarrier b; b.bar = bar; b.x = xb_xcc_id(); b.st = st;
    if (threadIdx.x == 0) (void)xb_add(&bar[XB_XCNT(b.x)], 1u);
    return b;
}
__device__ __forceinline__ void xcd_barrier_complete(unsigned* bar, unsigned x, unsigned& nloc, unsigned& nx) {
    const unsigned G = gridDim.x * gridDim.y * gridDim.z;
    unsigned sum, cnt, mine, sp = 0u;
    for (;;) {
        sum = 0u; cnt = 0u; mine = 0u;
#pragma unroll
        for (unsigned j = 0; j < 16; ++j) { const unsigned c = xb_ld(&bar[XB_XCNT(j)]); sum += c; cnt += (c > 0u) ? 1u : 0u; mine = (j == x) ? c : mine; }
        if (sum == G) break;
        __builtin_amdgcn_s_sleep(1);
        if ((++sp & 255u) == 0u) { if (xb_ld(&bar[XB_TMO])) break; if (sp > XB_SPIN_CAP) { atomicAdd(&bar[XB_TMO], 1u); break; } }
    }
    nloc = mine > 0u ? mine : 1u; nx = cnt > 0u ? cnt : 1u;
}
__device__ __forceinline__ void xcd_barrier(const XcdBarrier& b) {
    asm volatile("s_waitcnt vmcnt(0)" ::: "memory");
    __syncthreads();
    if (threadIdx.x == 0) {
        unsigned* bar = b.bar;
        __builtin_amdgcn_s_waitcnt(0);
        unsigned nloc = b.st[0], nx = b.st[1];
        if (nloc == 0u) { xcd_barrier_complete(bar, b.x, nloc, nx); b.st[0] = nloc; b.st[1] = nx; }
        const unsigned old = xb_add(&bar[XB_XSUB(b.x)], 1u);
        const unsigned gen = old / nloc;
        if (old + 1u == (gen + 1u) * nloc) {
            __builtin_amdgcn_fence(__ATOMIC_RELEASE, "agent");
            asm volatile("s_waitcnt vmcnt(0)" ::: "memory");
            const unsigned og = xb_add(&bar[XB_TOP], 1u);
            const unsigned tg = og / nx;
            if (og + 1u == (tg + 1u) * nx) xb_add(&bar[XB_TOPGEN], 1u);
            else XB_SPIN(xb_ld(&bar[XB_TOPGEN]) == tg, bar);
            __builtin_amdgcn_fence(__ATOMIC_ACQUIRE, "agent");
            xb_add(&bar[XB_XGEN(b.x)], 1u);
            asm volatile("s_waitcnt vmcnt(0)" ::: "memory");
        } else {
            XB_SPIN(xb_ld(&bar[XB_XGEN(b.x)]) == gen, bar);
            __builtin_amdgcn_fence(__ATOMIC_ACQUIRE, "agent");
            asm volatile("s_waitcnt vmcnt(0)" ::: "memory");
        }
    }
    __syncthreads();
}

struct Args { const float* in[25]; float* out; unsigned char* ws; int ph_lo, ph_hi; };
struct Frame {
    LAS unsigned char* lds; unsigned char* ws; const float* in[25]; float* out;
    int tid, lane, wave, vb, G;
};
enum { I_X = 0, I_C, I_WADA, I_BADA, I_NMIX, I_WIN, I_DNCONV, I_DNALOG, I_DNDT, I_DNNORM, I_MLCONV, I_MLIB, I_MLFB, I_MLNORM, I_WOUT, I_NFFN, I_WR, I_BR, I_WGU, I_BGU, I_WDN, I_BDN, I_WADAF, I_BADAF, I_NFIN };

__device__ __forceinline__ float wave_sum(float v) {
#pragma unroll
    for (int o = 1; o < 64; o <<= 1) v += __shfl_xor(v, o);
    return v;
}

__device__ __forceinline__ void transpose_item(const float* W, int ldw, int K, bf16* WT, int k0, int src_n0, int dst_n0, LAS float* scr, int lane) {
#pragma unroll 8
    for (int i = 0; i < 32; ++i) { const int kk = 2 * i + (lane >> 5); scr[kk * 33 + (lane & 31)] = W[(size_t)(k0 + kk) * ldw + src_n0 + (lane & 31)]; }
    LDS_WAIT(); asm volatile("" ::: "memory");
    const int c = lane & 7;
#pragma unroll
    for (int j = 0; j < 4; ++j) { const int n = (lane >> 3) + 8 * j; const LAS float* s = scr + (8 * c) * 33 + n;
        v4u o; o.x = pk2(s[0 * 33], s[1 * 33]); o.y = pk2(s[2 * 33], s[3 * 33]); o.z = pk2(s[4 * 33], s[5 * 33]); o.w = pk2(s[6 * 33], s[7 * 33]);
        *(v4u*)(WT + (size_t)(dst_n0 + n) * K + k0 + 8 * c) = o; }
    LDS_WAIT(); asm volatile("" ::: "memory");
}
__device__ __forceinline__ void p0_prologue(Frame& F) {
    {
        LAS float* cond = (LAS float*)F.lds;
        LAS float* part = (LAS float*)(F.lds + 16384);
        const float* c = F.in[I_C];
        for (int i = F.tid; i < NB * D; i += NTHR) cond[i] = siluf_(c[i]);
        __syncthreads();
        for (int cb = F.vb; cb < 256; cb += F.G) {
            const int j0 = cb * 32; const bool fin = j0 >= 6144;
            const float* W = fin ? F.in[I_WADAF] : F.in[I_WADA]; const int ld = fin ? 2048 : 6144; const int jc = fin ? j0 - 6144 : j0;
            const float* bias = fin ? F.in[I_BADAF] : F.in[I_BADA];
            float* out = fin ? (float*)(F.ws + WS_MODF) : (float*)(F.ws + WS_MOD);
            const int s = F.tid >> 5, jj = F.tid & 31;
            float a0 = 0.f, a1 = 0.f, a2 = 0.f, a3 = 0.f;
            for (int k = s * 64; k < s * 64 + 64; ++k) { const float w = W[(size_t)k * ld + jc + jj]; a0 += cond[k] * w; a1 += cond[1024 + k] * w; a2 += cond[2048 + k] * w; a3 += cond[3072 + k] * w; }
            part[(s * 4 + 0) * 32 + jj] = a0; part[(s * 4 + 1) * 32 + jj] = a1; part[(s * 4 + 2) * 32 + jj] = a2; part[(s * 4 + 3) * 32 + jj] = a3;
            __syncthreads();
            if (F.tid < 128) { const int b = F.tid >> 5, j = F.tid & 31; float sum = 0.f;
                for (int q = 0; q < 16; ++q) sum += part[(q * 4 + b) * 32 + j];
                out[b * ld + jc + j] = sum + bias[jc + j]; }
            __syncthreads();
        }
    }
    {
        const int gt = F.vb * NTHR + F.tid, NGT = F.G * NTHR;
        float* wrT = (float*)(F.ws + WS_WRT); const float* wr = F.in[I_WR];
        for (int i = gt; i < NE * D; i += NGT) { const int e = i >> 10, k = i & 1023; wrT[i] = wr[k * NE + e]; }
        float* wgT = (float*)(F.ws + WS_WGT); const float* win = F.in[I_WIN];
        for (int i = gt; i < 16 * D; i += NGT) { const int g = i >> 10, k = i & 1023; const int col = g < 8 ? 2048 + g : 3592 + (g - 8); wgT[i] = win[(size_t)k * DIN + col]; }
    }
    {
        LAS float* scr = (LAS float*)(F.lds + F.wave * 16384);
        const int gw = F.vb * NWAVES + F.wave, NGW = F.G * NWAVES;
        constexpr int I_IN = 16 * (NMAIN / 32), I_OUT = 16 * 32, I_GU1 = 16 * 64, I_DN1 = 16 * 32;
        constexpr int NITEMS = I_IN + I_OUT + NE * I_GU1 + NE * I_DN1;
        for (int it = gw; it < NITEMS; it += NGW) {
            int r = it;
            if (r < I_IN) { const int nblk = NMAIN / 32, kb = r / nblk, nb = r % nblk; const int dn0 = nb * 32, sn0 = dn0 < 2048 ? dn0 : dn0 + 8;
                transpose_item(F.in[I_WIN], DIN, D, (bf16*)(F.ws + WS_BTIN), kb * 64, sn0, dn0, scr, F.lane); continue; }
            r -= I_IN;
            if (r < I_OUT) { const int kb = r / 32, nb = r % 32; transpose_item(F.in[I_WOUT], D, D, (bf16*)(F.ws + WS_BTOUT), kb * 64, nb * 32, nb * 32, scr, F.lane); continue; }
            r -= I_OUT;
            if (r < NE * I_GU1) { const int e = r / I_GU1, q = r % I_GU1, kb = q / 64, nb = q % 64; const int dn0 = nb * 32;
                const int sn0 = ((dn0 & 255) >> 7) * 1024 + (dn0 >> 8) * 128 + (dn0 & 127);
                transpose_item(F.in[I_WGU] + (size_t)e * D * 2048, 2048, D, (bf16*)(F.ws + WS_BTGU) + (size_t)e * 2048 * D, kb * 64, sn0, dn0, scr, F.lane); continue; }
            r -= NE * I_GU1;
            { const int e = r / I_DN1, q = r % I_DN1, kb = q / 32, nb = q % 32;
                transpose_item(F.in[I_WDN] + (size_t)e * D * D, D, D, (bf16*)(F.ws + WS_BTDN) + (size_t)e * D * D, kb * 64, nb * 32, nb * 32, scr, F.lane); }
        }
    }
}

#define MR_STEP(n, bit) { const bool hi = (lane & (bit)) != 0; _Pragma("unroll") for (int i = 0; i < (n) / 2; ++i) { const float send = hi ? v[i] : v[i + (n) / 2]; const float keep = hi ? v[i + (n) / 2] : v[i]; v[i] = keep + __shfl_xor(send, (bit)); } }
template <int N> __device__ __forceinline__ float multi_reduce(float (&v)[N], int lane) {
    float r;
    if constexpr (N == 32) { MR_STEP(32, 32) MR_STEP(16, 16) MR_STEP(8, 8) MR_STEP(4, 4) MR_STEP(2, 2) r = v[0]; r += __shfl_xor(r, 1); }
    else { MR_STEP(16, 32) MR_STEP(8, 16) MR_STEP(4, 8) MR_STEP(2, 4) r = v[0]; r += __shfl_xor(r, 2); r += __shfl_xor(r, 1); }
    return r;
}

__device__ __forceinline__ void p1_norm1(Frame& F) {
    LAS float* wg = (LAS float*)F.lds;
    { const float* src = (const float*)(F.ws + WS_WGT); for (int i = F.tid; i < 16 * D / 4; i += NTHR) ((LAS f32x4*)wg)[i] = ((const f32x4*)src)[i]; }
    __syncthreads();
    const float* x = F.in[I_X]; const float* nw = F.in[I_NMIX]; const float* mod = (const float*)(F.ws + WS_MOD);
    bf16* h1 = (bf16*)(F.ws + WS_H); float* g16 = (float*)(F.ws + WS_G16);
    const int gw = F.vb * NWAVES + F.wave, NGW = F.G * NWAVES;
    for (int row = gw; row < T; row += NGW) {
        const int b = row / SEQ;
        const f32x4* xr = (const f32x4*)(x + (size_t)row * D) + F.lane;
        f32x4 v[4]; float ss = 0.f;
#pragma unroll
        for (int j = 0; j < 4; ++j) { v[j] = xr[64 * j]; ss += (v[j].x * v[j].x + v[j].y * v[j].y) + (v[j].z * v[j].z + v[j].w * v[j].w); }
        const float rstd = rsqrtf(wave_sum(ss) * (1.f / D) + EPS);
        const float* sh = mod + b * 6144; const float* sc = sh + 1024;
#pragma unroll
        for (int j = 0; j < 4; ++j) { const int k = 256 * j + F.lane * 4;
            const f32x4 w = *(const f32x4*)(nw + k), s1 = *(const f32x4*)(sc + k), s0 = *(const f32x4*)(sh + k);
            v[j] = (v[j] * rstd * w) * (1.0f + s1) + s0; }
        v2u* o8 = (v2u*)(h1 + (size_t)row * D) + F.lane;
#pragma unroll
        for (int j = 0; j < 4; ++j) { v2u o; o.x = pk2(v[j].x, v[j].y); o.y = pk2(v[j].z, v[j].w); o8[64 * j] = o; }
        float acc[16];
#pragma unroll
        for (int g = 0; g < 16; ++g) { float a = 0.f;
#pragma unroll
            for (int j = 0; j < 4; ++j) { const f32x4 w = *(const LAS f32x4*)(wg + g * 1024 + 256 * j + F.lane * 4); a += (v[j].x * w.x + v[j].y * w.y) + (v[j].z * w.z + v[j].w * w.w); }
            acc[g] = a; if (g & 1) asm volatile("" ::: "memory"); }
        const float r = multi_reduce<16>(acc, F.lane);
        if ((F.lane & 3) == 0) g16[(size_t)row * 16 + (F.lane >> 2)] = r;
    }
}

struct EpiProj {
    static constexpr bool PERM = true;
    bf16* O; int ldc;
    __device__ __forceinline__ void operator()(const pg8::f32x4 (&acc)[2][2][4][2], const pg8::Unit& u, int wr, int wc, int fr, int fq) const {
        const int row0 = u.pm * 256 + wr * 64 + fr, col0 = u.pn * 256 + wc * 32 + 8 * fq;
#pragma unroll
        for (int ai = 0; ai < 2; ++ai)
#pragma unroll
            for (int m = 0; m < 4; ++m) { bf16* rowp = O + (size_t)(row0 + ai * 128 + m * 16) * ldc + col0;
#pragma unroll
                for (int bj = 0; bj < 2; ++bj) { const pg8::f32x4 v0 = acc[ai][bj][m][0], v1 = acc[ai][bj][m][1];
                    v4u w; w.x = pg8::cvt_pk_bf16(v0[0], v0[1]); w.y = pg8::cvt_pk_bf16(v0[2], v0[3]); w.z = pg8::cvt_pk_bf16(v1[0], v1[1]); w.w = pg8::cvt_pk_bf16(v1[2], v1[3]);
                    *(v4u*)(rowp + bj * 128) = w; } }
    }
};
struct EpiRes {
    static constexpr bool PERM = false;
    const float* X; float* O; const float* mod;
    __device__ __forceinline__ void operator()(const pg8::f32x4 (&acc)[2][2][4][2], const pg8::Unit& u, int wr, int wc, int fr, int fq) const {
        const int row0 = u.pm * 256 + wr * 64 + fr, col0 = u.pn * 256 + wc * 32 + 4 * fq;
        const int b = (u.pm * 256) / SEQ; const float* g1 = mod + b * 6144 + 2048;
        pg8::f32x4 gv[2][2];
#pragma unroll
        for (int bj = 0; bj < 2; ++bj)
#pragma unroll
            for (int n = 0; n < 2; ++n) gv[bj][n] = *(const pg8::f32x4*)(g1 + col0 + bj * 128 + n * 16);
#pragma unroll
        for (int ai = 0; ai < 2; ++ai)
#pragma unroll
            for (int m = 0; m < 4; ++m) { const size_t off = (size_t)(row0 + ai * 128 + m * 16) * D + col0;
#pragma unroll
                for (int bj = 0; bj < 2; ++bj)
#pragma unroll
                    for (int n = 0; n < 2; ++n) { const pg8::f32x4 xv = *(const pg8::f32x4*)(X + off + bj * 128 + n * 16);
                        *(pg8::f32x4*)(O + off + bj * 128 + n * 16) = xv + gv[bj][n] * acc[ai][bj][m][n]; }
                asm volatile("" ::: "memory"); }
    }
};
struct EpiGU {
    static constexpr bool PERM = true;
    bf16* O; const float* bgu;
    __device__ __forceinline__ void operator()(const pg8::f32x4 (&acc)[2][2][4][2], const pg8::Unit& u, int wr, int wc, int fr, int fq) const {
        const int row0 = u.pm * 256 + wr * 64 + fr, cc = u.pn * 128 + wc * 32 + 8 * fq;
        const float* bg = bgu + (size_t)u.e * 2048 + cc; const float* bu = bg + 1024;
        pg8::f32x4 bgv[2], buv[2];
#pragma unroll
        for (int n = 0; n < 2; ++n) { bgv[n] = *(const pg8::f32x4*)(bg + 4 * n); buv[n] = *(const pg8::f32x4*)(bu + 4 * n); }
#pragma unroll
        for (int ai = 0; ai < 2; ++ai)
#pragma unroll
            for (int m = 0; m < 4; ++m) { bf16* rowp = O + (size_t)(row0 + ai * 128 + m * 16) * D + cc;
                float r[8];
#pragma unroll
                for (int n = 0; n < 2; ++n)
#pragma unroll
                    for (int j = 0; j < 4; ++j) { float gt = acc[ai][0][m][n][j] + bgv[n][j], up = acc[ai][1][m][n][j] + buv[n][j];
                        gt = fminf(gt, 7.0f); up = fminf(fmaxf(up, -7.0f), 7.0f);
                        r[n * 4 + j] = (up + 1.0f) * gt * sigmoidf_(1.702f * gt); }
                v4u w; w.x = pg8::cvt_pk_bf16(r[0], r[1]); w.y = pg8::cvt_pk_bf16(r[2], r[3]); w.z = pg8::cvt_pk_bf16(r[4], r[5]); w.w = pg8::cvt_pk_bf16(r[6], r[7]);
                *(v4u*)rowp = w; }
    }
};
struct EpiDown {
    static constexpr bool PERM = true;
    bf16* O; const float* bdn;
    __device__ __forceinline__ void operator()(const pg8::f32x4 (&acc)[2][2][4][2], const pg8::Unit& u, int wr, int wc, int fr, int fq) const {
        const int row0 = u.pm * 256 + wr * 64 + fr, col0 = u.pn * 256 + wc * 32 + 8 * fq;
        const float* bb = bdn + (size_t)u.e * D + col0;
        pg8::f32x4 bv[2][2];
#pragma unroll
        for (int bj = 0; bj < 2; ++bj)
#pragma unroll
            for (int n = 0; n < 2; ++n) bv[bj][n] = *(const pg8::f32x4*)(bb + bj * 128 + 4 * n);
#pragma unroll
        for (int ai = 0; ai < 2; ++ai)
#pragma unroll
            for (int m = 0; m < 4; ++m) { bf16* rowp = O + (size_t)(row0 + ai * 128 + m * 16) * D + col0;
#pragma unroll
                for (int bj = 0; bj < 2; ++bj) { const pg8::f32x4 v0 = acc[ai][bj][m][0] + bv[bj][0], v1 = acc[ai][bj][m][1] + bv[bj][1];
                    v4u w; w.x = pg8::cvt_pk_bf16(v0[0], v0[1]); w.y = pg8::cvt_pk_bf16(v0[2], v0[3]); w.z = pg8::cvt_pk_bf16(v1[0], v1[1]); w.w = pg8::cvt_pk_bf16(v1[2], v1[3]);
                    *(v4u*)(rowp + bj * 128) = w; } }
    }
};

template <int MB, int NBK, bool GATHER> struct GroupedOrder {
    int G, c, nmt, K; const LAS int* tileE; const LAS int* tst; const LAS int* cnt; const int* slot_tok; const bf16* Bt; size_t bexp;
    __device__ bool next(int i, pg8::Unit& u) const {
        const int nwg = nmt * NBK; const long L = (long)i * G + c; if (L >= nwg) return false;
        int U = (int)L; { const int q = nwg / 8, r = nwg % 8, xcd = U % 8, off = U / 8; U = (xcd < r ? xcd * (q + 1) : r * (q + 1) + (xcd - r) * q) + off; }
        const int nig = MB * NBK, gid = U / nig, fm = gid * MB, gsz = (nmt - fm) < MB ? (nmt - fm) : MB;
        u.pm = fm + ((U % nig) % gsz); u.pn = (U % nig) / gsz; u.e = tileE[u.pm]; return true;
    }
    __device__ __forceinline__ void a_voff(const pg8::Unit& u, const int (&R)[2], const int (&C)[2], unsigned (&vo)[2][2]) const {
        if (GATHER) {
            const int r0 = (u.pm - tst[u.e]) * 256, ce = cnt[u.e];
#pragma unroll
            for (int h = 0; h < 2; ++h)
#pragma unroll
                for (int i = 0; i < 2; ++i) { const int rk = r0 + h * 128 + R[i]; int tok = 0; if (rk < ce) tok = slot_tok[u.e * ECAP + rk];
                    vo[h][i] = (unsigned)(tok * K + C[i]) * 2u; }
        } else {
#pragma unroll
            for (int h = 0; h < 2; ++h)
#pragma unroll
                for (int i = 0; i < 2; ++i) vo[h][i] = (unsigned)((u.pm * 256 + h * 128 + R[i]) * K + C[i]) * 2u;
        }
    }
    __device__ __forceinline__ const char* b_ptr(const pg8::Unit& u) const { return (const char*)(Bt + (size_t)u.e * bexp + (size_t)u.pn * 256 * K); }
};

__device__ __forceinline__ int build_expert_tables(Frame& F) {
    LAS int* lc = (LAS int*)(F.lds + L_CNT); LAS int* lt = (LAS int*)(F.lds + L_TST); LAS int* le = (LAS int*)(F.lds + L_TILEE);
    const unsigned* gc = (const unsigned*)(F.ws + WS_CTL) + CW_CNT;
    __syncthreads();
    if (F.tid < 64) {
        int c = 0; if (F.lane < NE) { c = (int)__hip_atomic_load(gc + F.lane, __ATOMIC_RELAXED, __HIP_MEMORY_SCOPE_AGENT); if (c > ECAP) c = ECAP; }
        const int nt = (c + 255) >> 8; int incl = nt;
#pragma unroll
        for (int o = 1; o < 32; o <<= 1) { const int v = __shfl_up(incl, o); if (F.lane >= o) incl += v; }
        const int excl = incl - nt;
        if (F.lane < NE) { lc[F.lane] = c; lt[F.lane] = excl; for (int i = 0; i < nt; ++i) le[excl + i] = F.lane; }
        if (F.lane == NE - 1) lt[NE] = incl;
    }
    __syncthreads();
    return lt[NE];
}

__device__ __forceinline__ void p3_naive_dn(Frame& F, int bh) {
    const int b = bh >> 2, h = bh & 3;
    LAS float* qs_ = (LAS float*)F.lds;
    LAS float* ks_ = qs_ + 64 * 128;
    LAS float* vs_ = ks_ + 64 * 128;
    LAS float* qsc = vs_ + 64 * 128;
    LAS float* ksc = qsc + 64; LAS float* bet = ksc + 64; LAS float* ade = bet + 64;
    const bf16* proj = (const bf16*)(F.ws + WS_PROJ); const float* g16 = (const float*)(F.ws + WS_G16);
    const float* cw = F.in[I_DNCONV]; float* raw = (float*)(F.ws + WS_RAW);
    const float Aexp = __expf(F.in[I_DNALOG][h]), dtb = F.in[I_DNDT][h];
    const int e = F.tid >> 2, ds = F.tid & 3, d0 = ds * 32;
    float S[32];
#pragma unroll
    for (int i = 0; i < 32; ++i) S[i] = 0.f;
    for (int n = 0; n < 64; ++n) {
        __syncthreads();
        for (int idx = F.tid; idx < 64 * 384; idx += NTHR) {
            const int i = idx / 384, c = idx % 384, which = c >> 7, cc = c & 127, col = which * 512 + h * 128 + cc;
            const int t = n * 64 + i; float a = 0.f;
#pragma unroll
            for (int j = 0; j < 4; ++j) { const int tt = t - 3 + j; if (tt >= 0) a += bf2f(proj[(size_t)(b * SEQ + tt) * NMAIN + col]) * cw[j * 1536 + col]; }
            (which == 0 ? qs_ : which == 1 ? ks_ : vs_)[i * 128 + cc] = siluf_(a);
        }
        if (F.tid < 64) { const size_t row = (size_t)b * SEQ + n * 64 + F.tid;
            bet[F.tid] = sigmoidf_(g16[row * 16 + h]); ade[F.tid] = __expf(-Aexp * softplusf_(g16[row * 16 + 4 + h] + dtb)); }
        __syncthreads();
        if (F.tid < 128) { const int i = F.tid & 63, which = F.tid >> 6; const LAS float* p = (which ? ks_ : qs_) + i * 128; float ss = 0.f;
            for (int c = 0; c < 128; ++c) ss += p[c] * p[c];
            const float sc = rsqrtf(ss + EPS); if (which) ksc[i] = sc; else qsc[i] = sc * 0.08838834764831845f; }
        __syncthreads();
        for (int i = 0; i < 64; ++i) {
            const float kscale = ksc[i], qscale = qsc[i], be = bet[i], a = ade[i];
            const LAS float* kp = ks_ + i * 128 + d0; const LAS float* qp = qs_ + i * 128 + d0;
            float kv[32]; float p = 0.f;
#pragma unroll
            for (int d = 0; d < 32; ++d) { kv[d] = kp[d] * kscale; p += kv[d] * S[d]; }
            p += __shfl_xor(p, 1); p += __shfl_xor(p, 2);
            const float uu = be * (vs_[i * 128 + e] - a * p);
            float o = 0.f;
#pragma unroll
            for (int d = 0; d < 32; ++d) { S[d] = a * S[d] + kv[d] * uu; o += qp[d] * S[d]; }
            o *= qscale; o += __shfl_xor(o, 1); o += __shfl_xor(o, 2);
            if (ds == 0) raw[((size_t)b * SEQ + n * 64 + i) * D + h * 128 + e] = o;
        }
    }
}
__device__ __forceinline__ void p3_naive_ml(Frame& F, int bh) {
    const int b = bh >> 2, h = bh & 3;
    LAS float* qs_ = (LAS float*)F.lds;
    LAS float* ks_ = qs_ + 64 * 64;
    LAS float* vs_ = ks_ + 64 * 64;
    LAS float* ipr = vs_ + 64 * 128; LAS float* lgf = ipr + 64;
    const bf16* proj = (const bf16*)(F.ws + WS_PROJ); const float* g16 = (const float*)(F.ws + WS_G16);
    const float* cw = F.in[I_MLCONV]; float* raw = (float*)(F.ws + WS_RAW);
    const float ib = F.in[I_MLIB][h], fb = F.in[I_MLFB][h];
    const int e = F.tid >> 2, ds = F.tid & 3, d0 = ds * 16;
    float C[16], nn[16]; float m = 0.f;
#pragma unroll
    for (int i = 0; i < 16; ++i) { C[i] = 0.f; nn[i] = 0.f; }
    for (int n = 0; n < 64; ++n) {
        __syncthreads();
        for (int idx = F.tid; idx < 64 * 128; idx += NTHR) {
            const int i = idx >> 7, c = idx & 127, which = c >> 6, cc = c & 63, ch = which * 256 + h * 64 + cc;
            const int t = n * 64 + i; float a = 0.f;
#pragma unroll
            for (int j = 0; j < 4; ++j) { const int tt = t - 3 + j; if (tt >= 0) a += bf2f(proj[(size_t)(b * SEQ + tt) * NMAIN + MC_MLQ + ch]) * cw[j * 512 + ch]; }
            const float y = siluf_(a);
            if (which == 0) qs_[i * 64 + cc] = y * 0.125f; else ks_[i * 64 + cc] = y;
        }
        for (int idx = F.tid; idx < 64 * 128; idx += NTHR) { const int i = idx >> 7, c = idx & 127;
            vs_[idx] = bf2f(proj[(size_t)(b * SEQ + n * 64 + i) * NMAIN + MC_MLV + h * 128 + c]); }
        if (F.tid < 64) { const size_t row = (size_t)b * SEQ + n * 64 + F.tid;
            ipr[F.tid] = g16[row * 16 + 8 + h] + ib; lgf[F.tid] = logsigmoidf_(g16[row * 16 + 12 + h] + fb); }
        __syncthreads();
        for (int i = 0; i < 64; ++i) {
            const float lf = lgf[i], ip = ipr[i];
            const float mn = fmaxf(lf + m, ip), fp = __expf(lf + m - mn), iq = __expf(ip - mn); m = mn;
            const LAS float* kp = ks_ + i * 64 + d0; const LAS float* qp = qs_ + i * 64 + d0;
            const float vv = vs_[i * 128 + e] * iq;
            float num = 0.f, den = 0.f;
#pragma unroll
            for (int d = 0; d < 16; ++d) { const float kk = kp[d], qq = qp[d]; C[d] = fp * C[d] + kk * vv; nn[d] = fp * nn[d] + iq * kk; num += qq * C[d]; den += qq * nn[d]; }
            num += __shfl_xor(num, 1); num += __shfl_xor(num, 2); den += __shfl_xor(den, 1); den += __shfl_xor(den, 2);
            const float hh = num / fmaxf(fabsf(den), __expf(-m));
            if (ds == 0) raw[((size_t)b * SEQ + n * 64 + i) * D + 512 + h * 128 + e] = hh;
        }
    }
}

typedef short bf16x8_t __attribute__((ext_vector_type(8)));
template <int K> __device__ __forceinline__ f32x4 tile_mma(const LAS bf16* A, int lda, const LAS bf16* Bt, int ldb, int m0, int n0, int lane, f32x4 acc) {
    const int r = lane & 15, kq = (lane >> 4) * 8;
    const LAS bf16* ap = A + (m0 + r) * lda + kq; const LAS bf16* bp = Bt + (n0 + r) * ldb + kq;
#pragma unroll
    for (int k = 0; k < K; k += 32) { const bf16x8_t a = *(const LAS bf16x8_t*)(ap + k); const bf16x8_t b = *(const LAS bf16x8_t*)(bp + k);
        acc = __builtin_amdgcn_mfma_f32_16x16x32_bf16(a, b, acc, 0, 0, 0); }
    return acc;
}
__device__ __forceinline__ v2u pk4(f32x4 v) { v2u o; o.x = pk2(v.x, v.y); o.y = pk2(v.z, v.w); return o; }

__device__ __forceinline__ void dn_prep(Frame& F, int ch) {
    const int bh = ch >> 6, n = ch & 63, b = bh >> 2, h = bh & 3;
    const size_t row0 = (size_t)b * SEQ + n * 64;
    LAS bf16* kN = (LAS bf16*)(F.lds + 0);
    LAS bf16* qN = (LAS bf16*)(F.lds + 17408);
    LAS bf16* solT = (LAS bf16*)(F.lds + 0);
    LAS bf16* rhsT = (LAS bf16*)(F.lds + 36864);
    LAS bf16* kdT = (LAS bf16*)(F.lds + 73728);
    LAS bf16* Tm = (LAS bf16*)(F.lds + 92160);
    LAS float* Lm = (LAS float*)(F.lds + 101376);
    LAS float* gb = (LAS float*)(F.lds + 118784);
    const bf16* proj = (const bf16*)(F.ws + WS_PROJ); const float* g16 = (const float*)(F.ws + WS_G16); const float* cw = F.in[I_DNCONV];
    bf16* gMp = (bf16*)(F.ws + WS_DN_MP) + (size_t)ch * 16384; float* gUT = (float*)(F.ws + WS_DN_UT) + (size_t)ch * 16384;
    bf16* gKC = (bf16*)(F.ws + WS_DN_KC) + (size_t)ch * 8192; bf16* gWT = (bf16*)(F.ws + WS_DN_WT) + (size_t)ch * 8192;
    bf16* gQD = (bf16*)(F.ws + WS_DN_QD) + (size_t)ch * 8192; bf16* gQK = (bf16*)(F.ws + WS_DN_QK) + (size_t)ch * 4096;
    const int lane = F.lane, w = F.wave, r = lane & 15, q4 = (lane >> 4) * 4;
    __syncthreads();
    if (w == 0) {
        const float* g = g16 + (row0 + lane) * 16;
        const float be = sigmoidf_(g[h]); float G = -__expf(F.in[I_DNALOG][h]) * softplusf_(g[4 + h] + F.in[I_DNDT][h]);
#pragma unroll
        for (int o = 1; o < 64; o <<= 1) { const float v = __shfl_up(G, o); if (lane >= o) G += v; }
        const float Gl = __shfl(G, 63);
        gb[lane] = be; gb[64 + lane] = G; gb[128 + lane] = __expf(G); gb[192 + lane] = __expf(Gl - G);
        if (lane == 0) ((float*)(F.ws + WS_DN_SD))[ch] = __expf(Gl);
    }
    __syncthreads();
#pragma unroll 1
    for (int it = 0; it < 6; ++it) {
        const int which = it >> 1, item = (it & 1) * 512 + F.tid, i = item >> 4, cg = item & 15, col = which * 512 + h * 128 + cg * 8;
        float y[8];
#pragma unroll
        for (int j = 0; j < 8; ++j) y[j] = 0.f;
#pragma unroll
        for (int j = 0; j < 4; ++j) { const int tt = n * 64 + i - 3 + j;
            if (tt >= 0) { const v4u raw = *(const v4u*)(proj + ((size_t)b * SEQ + tt) * NMAIN + col);
                const f32x4 w0 = *(const f32x4*)(cw + j * 1536 + col), w1 = *(const f32x4*)(cw + j * 1536 + col + 4);
                y[0] += bf2f(raw.x & 0xffff) * w0.x; y[1] += bf2f(raw.x >> 16) * w0.y; y[2] += bf2f(raw.y & 0xffff) * w0.z; y[3] += bf2f(raw.y >> 16) * w0.w;
                y[4] += bf2f(raw.z & 0xffff) * w1.x; y[5] += bf2f(raw.z >> 16) * w1.y; y[6] += bf2f(raw.w & 0xffff) * w1.z; y[7] += bf2f(raw.w >> 16) * w1.w; } }
        float ss = 0.f;
#pragma unroll
        for (int j = 0; j < 8; ++j) { y[j] = siluf_(y[j]); ss += y[j] * y[j]; }
        ss += __shfl_xor(ss, 1); ss += __shfl_xor(ss, 2); ss += __shfl_xor(ss, 4); ss += __shfl_xor(ss, 8);
        const float be = gb[i], eG = gb[128 + i], kds = gb[192 + i];
        if (which == 0) { const float sc = rsqrtf(ss + EPS) * 0.08838834764831845f;
            v4u o; o.x = pk2(y[0] * sc, y[1] * sc); o.y = pk2(y[2] * sc, y[3] * sc); o.z = pk2(y[4] * sc, y[5] * sc); o.w = pk2(y[6] * sc, y[7] * sc);
            *(LAS v4u*)(qN + i * 136 + cg * 8) = o;
            const float s2 = sc * eG; v4u o2; o2.x = pk2(y[0] * s2, y[1] * s2); o2.y = pk2(y[2] * s2, y[3] * s2); o2.z = pk2(y[4] * s2, y[5] * s2); o2.w = pk2(y[6] * s2, y[7] * s2);
            *(v4u*)(gQD + i * 128 + cg * 8) = o2;
        } else if (which == 1) { const float sc = rsqrtf(ss + EPS);
            v4u o; o.x = pk2(y[0] * sc, y[1] * sc); o.y = pk2(y[2] * sc, y[3] * sc); o.z = pk2(y[4] * sc, y[5] * sc); o.w = pk2(y[6] * sc, y[7] * sc);
            *(LAS v4u*)(kN + i * 136 + cg * 8) = o;
            const float s1 = sc * be * eG, s2 = sc * kds;
#pragma unroll
            for (int j = 0; j < 8; ++j) { rhsT[(128 + cg * 8 + j) * 72 + i] = (bf16)f2bf(y[j] * s1); kdT[(cg * 8 + j) * 72 + i] = (bf16)f2bf(y[j] * s2); }
        } else {
#pragma unroll
            for (int j = 0; j < 8; ++j) rhsT[(cg * 8 + j) * 72 + i] = (bf16)f2bf(y[j] * be);
        }
    }
    __syncthreads();
    for (int t = w; t < 16; t += 8) { const int mt = t >> 2, nt = t & 3;
        const f32x4 a = tile_mma<128>(kN, 136, kN, 136, mt * 16, nt * 16, lane, (f32x4){0.f, 0.f, 0.f, 0.f});
        const int j = nt * 16 + r; const float Gj = gb[64 + j];
#pragma unroll
        for (int x = 0; x < 4; ++x) { const int i = mt * 16 + q4 + x; Lm[i * 68 + j] = (i > j) ? gb[i] * a[x] * __expf(gb[64 + i] - Gj) : 0.f; }
    }
    for (int t = w; t < 16; t += 8) { const int jt = t >> 2, itl = t & 3;
        const f32x4 a = tile_mma<128>(kN, 136, qN, 136, jt * 16, itl * 16, lane, (f32x4){0.f, 0.f, 0.f, 0.f});
        const int i = itl * 16 + r; const float Gi = gb[64 + i]; f32x4 o;
#pragma unroll
        for (int x = 0; x < 4; ++x) { const int j = jt * 16 + q4 + x; o[x] = (j <= i) ? a[x] * __expf(Gi - gb[64 + j]) : 0.f; }
        *(v2u*)(gQK + i * 64 + jt * 16 + q4) = pk4(o);
    }
    __syncthreads();
    if (w == 0) {
        float t[64];
#pragma unroll
        for (int i = 0; i < 64; ++i) {
            float s = (lane == i) ? 1.f : 0.f;
#pragma unroll
            for (int j4 = 0; j4 < (i + 3) / 4; ++j4) { const f32x4 l = *(const LAS f32x4*)(Lm + i * 68 + j4 * 4);
                if (j4 * 4 + 0 < i) s -= l.x * t[j4 * 4 + 0]; if (j4 * 4 + 1 < i) s -= l.y * t[j4 * 4 + 1]; if (j4 * 4 + 2 < i) s -= l.z * t[j4 * 4 + 2]; if (j4 * 4 + 3 < i) s -= l.w * t[j4 * 4 + 3]; }
            t[i] = s; Tm[i * 72 + lane] = (bf16)f2bf(s);
        }
    }
    __syncthreads();
    for (int t = w; t < 64; t += 8) { const int mt = t & 3, nt = t >> 2;
        const f32x4 a = tile_mma<64>(Tm, 72, rhsT, 72, mt * 16, nt * 16, lane, (f32x4){0.f, 0.f, 0.f, 0.f});
        *(LAS v2u*)(solT + (nt * 16 + r) * 72 + mt * 16 + q4) = pk4(a);
    }
    for (int t = w; t < 32; t += 8) { const int mt = t & 7, nt = t >> 3;
        const f32x4 a = tile_mma<64>(rhsT + 128 * 72, 72, Tm, 72, mt * 16, nt * 16, lane, (f32x4){0.f, 0.f, 0.f, 0.f});
        *(v2u*)(gKC + (nt * 16 + r) * 128 + mt * 16 + q4) = pk4(a);
    }
    __syncthreads();
    for (int t = w; t < 64; t += 8) { const int mt = t & 7, nt = t >> 3;
        f32x4 a = tile_mma<64>(solT + 128 * 72, 72, kdT, 72, mt * 16, nt * 16, lane, (f32x4){0.f, 0.f, 0.f, 0.f});
        a = -a; *(v2u*)(gMp + (nt * 16 + r) * 128 + mt * 16 + q4) = pk4(a);
    }
    for (int t = w; t < 64; t += 8) { const int mt = t & 7, nt = t >> 3;
        const f32x4 a = tile_mma<64>(kdT, 72, solT, 72, mt * 16, nt * 16, lane, (f32x4){0.f, 0.f, 0.f, 0.f});
        *(f32x4*)(gUT + (nt * 16 + r) * 128 + mt * 16 + q4) = a;
    }
    for (int c = F.tid; c < 1024; c += NTHR) { const int row = c >> 3, pc = c & 7; *(v4u*)(gWT + row * 64 + pc * 8) = *(const LAS v4u*)(solT + row * 72 + pc * 8); }
}

__device__ __forceinline__ void dn_scan(Frame& F, int bh) {
    LAS bf16* ST = (LAS bf16*)(F.lds);
    LAS bf16* MP = (LAS bf16*)(F.lds + 34816);
    const int ch0 = bh * 64, lane = F.lane, w = F.wave, r = lane & 15, q4 = (lane >> 4) * 4, kq = (lane >> 4) * 8;
    const bf16* gMp = (const bf16*)(F.ws + WS_DN_MP) + (size_t)ch0 * 16384; const float* gUT = (const float*)(F.ws + WS_DN_UT) + (size_t)ch0 * 16384;
    bf16* gST = (bf16*)(F.ws + WS_DN_ST) + (size_t)ch0 * 16384; const float* sdec = (const float*)(F.ws + WS_DN_SD) + ch0;
    __syncthreads();
    for (int i = F.tid; i < 128 * 136 / 2; i += NTHR) ((LAS unsigned*)ST)[i] = 0u;
    for (int c = F.tid; c < 2048; c += NTHR) *(v4u*)(gST + c * 8) = (v4u){0u, 0u, 0u, 0u};
    v4u mpr[4]; f32x4 u[8], un[8], acc[8]; float sd = sdec[0], sdn = 0.f;
#pragma unroll
    for (int x = 0; x < 4; ++x) { const int c = F.tid + 512 * x, row = c >> 4, pc = c & 15; mpr[x] = *(const v4u*)(gMp + row * 128 + pc * 8); *(LAS v4u*)(MP + row * 136 + pc * 8) = mpr[x]; }
#pragma unroll
    for (int j = 0; j < 8; ++j) { u[j] = *(const f32x4*)(gUT + (16 * j + r) * 128 + 16 * w + q4); un[j] = u[j]; acc[j] = (f32x4){0.f, 0.f, 0.f, 0.f}; }
    __syncthreads();
#pragma unroll 1
    for (int n = 0; n < 64; ++n) {
        if (n + 1 < 64) {
            const bf16* m1 = gMp + (size_t)(n + 1) * 16384; const float* u1 = gUT + (size_t)(n + 1) * 16384;
#pragma unroll
            for (int x = 0; x < 4; ++x) { const int c = F.tid + 512 * x, row = c >> 4, pc = c & 15; mpr[x] = *(const v4u*)(m1 + row * 128 + pc * 8); }
#pragma unroll
            for (int j = 0; j < 8; ++j) un[j] = *(const f32x4*)(u1 + (16 * j + r) * 128 + 16 * w + q4);
            sdn = sdec[n + 1];
        }
        bf16x8_t a[4];
#pragma unroll
        for (int s = 0; s < 4; ++s) a[s] = *(const LAS bf16x8_t*)(MP + (16 * w + r) * 136 + kq + 32 * s);
#pragma unroll
        for (int j = 0; j < 8; ++j) { acc[j] = acc[j] * sd + u[j];
#pragma unroll
            for (int s = 0; s < 4; ++s) { const bf16x8_t bb = *(const LAS bf16x8_t*)(ST + (16 * j + r) * 136 + kq + 32 * s); acc[j] = __builtin_amdgcn_mfma_f32_16x16x32_bf16(a[s], bb, acc[j], 0, 0, 0); } }
        __syncthreads();
        if (n + 1 < 64) {
            bf16* gs = gST + (size_t)(n + 1) * 16384;
#pragma unroll
            for (int j = 0; j < 8; ++j) { const v2u pv = pk4(acc[j]); *(LAS v2u*)(ST + (16 * j + r) * 136 + 16 * w + q4) = pv; *(v2u*)(gs + (16 * j + r) * 128 + 16 * w + q4) = pv; }
#pragma unroll
            for (int x = 0; x < 4; ++x) { const int c = F.tid + 512 * x, row = c >> 4, pc = c & 15; *(LAS v4u*)(MP + row * 136 + pc * 8) = mpr[x]; }
#pragma unroll
            for (int j = 0; j < 8; ++j) u[j] = un[j];
            sd = sdn;
        }
        __syncthreads();
    }
}

__device__ __forceinline__ void dn_out(Frame& F, int ch) {
    const int bh = ch >> 6, n = ch & 63, b = bh >> 2, h = bh & 3;
    const size_t row0 = (size_t)b * SEQ + n * 64;
    LAS bf16* kc = (LAS bf16*)(F.lds + 0);
    LAS bf16* wT = (LAS bf16*)(F.lds + 17408);
    LAS float* ob = (LAS float*)(F.lds + 0);
    LAS bf16* qd = (LAS bf16*)(F.lds + 35840);
    LAS bf16* qk = (LAS bf16*)(F.lds + 53248);
    LAS bf16* ST = (LAS bf16*)(F.lds + 62464);
    LAS bf16* vnT = (LAS bf16*)(F.lds + 97280);
    const bf16* gKC = (const bf16*)(F.ws + WS_DN_KC) + (size_t)ch * 8192; const bf16* gWT = (const bf16*)(F.ws + WS_DN_WT) + (size_t)ch * 8192;
    const bf16* gQD = (const bf16*)(F.ws + WS_DN_QD) + (size_t)ch * 8192; const bf16* gQK = (const bf16*)(F.ws + WS_DN_QK) + (size_t)ch * 4096;
    const bf16* gST = (const bf16*)(F.ws + WS_DN_ST) + (size_t)ch * 16384;
    const int lane = F.lane, w = F.wave, r = lane & 15, q4 = (lane >> 4) * 4;
    __syncthreads();
    for (int c = F.tid; c < 1024; c += NTHR) { const int row = c >> 4, pc = c & 15; *(LAS v4u*)(kc + row * 136 + pc * 8) = *(const v4u*)(gKC + row * 128 + pc * 8); *(LAS v4u*)(qd + row * 136 + pc * 8) = *(const v4u*)(gQD + row * 128 + pc * 8); }
    for (int c = F.tid; c < 2048; c += NTHR) { const int row = c >> 4, pc = c & 15; *(LAS v4u*)(ST + row * 136 + pc * 8) = *(const v4u*)(gST + row * 128 + pc * 8); }
    for (int c = F.tid; c < 1024; c += NTHR) { const int row = c >> 3, pc = c & 7; *(LAS v4u*)(wT + row * 72 + pc * 8) = *(const v4u*)(gWT + row * 64 + pc * 8); }
    { const int c = F.tid, row = c >> 3, pc = c & 7; *(LAS v4u*)(qk + row * 72 + pc * 8) = *(const v4u*)(gQK + row * 64 + pc * 8); }
    __syncthreads();
    for (int t = w; t < 32; t += 8) { const int mt = t & 3, nt = t >> 2;
        const f32x4 a = tile_mma<128>(kc, 136, ST, 136, mt * 16, nt * 16, lane, (f32x4){0.f, 0.f, 0.f, 0.f});
        const int e = nt * 16 + r; const v2u wv = *(const LAS v2u*)(wT + e * 72 + mt * 16 + q4);
        f32x4 vn; vn.x = bf2f(wv.x & 0xffff) - a.x; vn.y = bf2f(wv.x >> 16) - a.y; vn.z = bf2f(wv.y & 0xffff) - a.z; vn.w = bf2f(wv.y >> 16) - a.w;
        *(LAS v2u*)(vnT + e * 72 + mt * 16 + q4) = pk4(vn);
    }
    __syncthreads();
    for (int t = w; t < 32; t += 8) { const int mt = t & 3, nt = t >> 2;
        f32x4 a = tile_mma<128>(qd, 136, ST, 136, mt * 16, nt * 16, lane, (f32x4){0.f, 0.f, 0.f, 0.f});
        a = tile_mma<64>(qk, 72, vnT, 72, mt * 16, nt * 16, lane, a);
        const int e = nt * 16 + r;
#pragma unroll
        for (int x = 0; x < 4; ++x) ob[(mt * 16 + q4 + x) * 132 + e] = a[x];
    }
    __syncthreads();
    const bf16* proj = (const bf16*)(F.ws + WS_PROJ); bf16* mix = (bf16*)(F.ws + WS_MIX); const float* dnn = F.in[I_DNNORM];
    for (int rr = 0; rr < 8; ++rr) { const int i = w * 8 + rr;
        const float o0 = ob[i * 132 + 2 * lane], o1 = ob[i * 132 + 2 * lane + 1];
        const float rstd = rsqrtf(wave_sum(o0 * o0 + o1 * o1) * (1.f / 128.f) + EPS);
        const unsigned z = *(const unsigned*)(proj + (row0 + i) * NMAIN + MC_DNZ + h * 128 + 2 * lane);
        const float y0 = o0 * rstd * dnn[2 * lane] * siluf_(bf2f(z & 0xffff)), y1 = o1 * rstd * dnn[2 * lane + 1] * siluf_(bf2f(z >> 16));
        *(unsigned*)(mix + (row0 + i) * D + h * 128 + 2 * lane) = pk2(y0, y1);
    }
}

__device__ __forceinline__ void ml_prep(Frame& F, int ch) {
    const int bh = ch >> 6, n = ch & 63, b = bh >> 2, h = bh & 3;
    const size_t row0 = (size_t)b * SEQ + n * 64;
    LAS bf16* kwT = (LAS bf16*)(F.lds + 0);
    LAS bf16* vT = (LAS bf16*)(F.lds + 9216);
    LAS float* gsc = (LAS float*)(F.lds + 27648);
    const bf16* proj = (const bf16*)(F.ws + WS_PROJ); const float* g16 = (const float*)(F.ws + WS_G16); const float* cw = F.in[I_MLCONV];
    float* gUp = (float*)(F.ws + WS_ML_UPT) + (size_t)ch * 8192; bf16* gQC = (bf16*)(F.ws + WS_ML_QC) + (size_t)ch * 4096; bf16* gKC = (bf16*)(F.ws + WS_ML_KC) + (size_t)ch * 4096;
    float* aux = (float*)(F.ws + WS_ML_AUX);
    const int lane = F.lane, w = F.wave, r = lane & 15, q4 = (lane >> 4) * 4;
    __syncthreads();
    if (w == 0) {
        const float* g = g16 + (row0 + lane) * 16;
        const float ip = g[8 + h] + F.in[I_MLIB][h]; float bc = logsigmoidf_(g[12 + h] + F.in[I_MLFB][h]);
#pragma unroll
        for (int o = 1; o < 64; o <<= 1) { const float v = __shfl_up(bc, o); if (lane >= o) bc += v; }
        const float bl = __shfl(bc, 63), ge = bl - bc + ip; float gm = ge;
#pragma unroll
        for (int o = 1; o < 64; o <<= 1) gm = fmaxf(gm, __shfl_xor(gm, o));
        gsc[lane] = __expf(ge - gm);
        if (lane == 0) { aux[131072 + ch * 2] = bl; aux[131072 + ch * 2 + 1] = gm; }
    }
    __syncthreads();
#pragma unroll 1
    for (int it = 0; it < 2; ++it) {
        const int item = it * 512 + F.tid, i = item >> 4, cg = item & 15, isk = cg >> 3, c8 = (cg & 7) * 8, chn = isk * 256 + h * 64 + c8;
        float y[8];
#pragma unroll
        for (int j = 0; j < 8; ++j) y[j] = 0.f;
#pragma unroll
        for (int j = 0; j < 4; ++j) { const int tt = n * 64 + i - 3 + j;
            if (tt >= 0) { const v4u raw = *(const v4u*)(proj + ((size_t)b * SEQ + tt) * NMAIN + MC_MLQ + chn);
                const f32x4 w0 = *(const f32x4*)(cw + j * 512 + chn), w1 = *(const f32x4*)(cw + j * 512 + chn + 4);
                y[0] += bf2f(raw.x & 0xffff) * w0.x; y[1] += bf2f(raw.x >> 16) * w0.y; y[2] += bf2f(raw.y & 0xffff) * w0.z; y[3] += bf2f(raw.y >> 16) * w0.w;
                y[4] += bf2f(raw.z & 0xffff) * w1.x; y[5] += bf2f(raw.z >> 16) * w1.y; y[6] += bf2f(raw.w & 0xffff) * w1.z; y[7] += bf2f(raw.w >> 16) * w1.w; } }
#pragma unroll
        for (int j = 0; j < 8; ++j) y[j] = siluf_(y[j]);
        if (!isk) { v4u o; o.x = pk2(y[0] * 0.125f, y[1] * 0.125f); o.y = pk2(y[2] * 0.125f, y[3] * 0.125f); o.z = pk2(y[4] * 0.125f, y[5] * 0.125f); o.w = pk2(y[6] * 0.125f, y[7] * 0.125f);
            *(v4u*)(gQC + i * 64 + c8) = o; }
        else { v4u o; o.x = pk2(y[0], y[1]); o.y = pk2(y[2], y[3]); o.z = pk2(y[4], y[5]); o.w = pk2(y[6], y[7]); *(v4u*)(gKC + i * 64 + c8) = o;
            const float sc = gsc[i];
#pragma unroll
            for (int j = 0; j < 8; ++j) kwT[(c8 + j) * 72 + i] = (bf16)f2bf(y[j] * sc); }
    }
#pragma unroll 1
    for (int it = 0; it < 2; ++it) {
        const int item = it * 512 + F.tid, i = item >> 4, cg = item & 15;
        const v4u raw = *(const v4u*)(proj + (row0 + i) * NMAIN + MC_MLV + h * 128 + cg * 8);
        LAS bf16* d = vT + (cg * 8) * 72 + i;
        d[0] = (bf16)(raw.x & 0xffff); d[72] = (bf16)(raw.x >> 16); d[144] = (bf16)(raw.y & 0xffff); d[216] = (bf16)(raw.y >> 16);
        d[288] = (bf16)(raw.z & 0xffff); d[360] = (bf16)(raw.z >> 16); d[432] = (bf16)(raw.w & 0xffff); d[504] = (bf16)(raw.w >> 16);
    }
    __syncthreads();
    for (int t = w; t < 32; t += 8) { const int mt = t & 3, nt = t >> 2;
        const f32x4 a = tile_mma<64>(kwT, 72, vT, 72, mt * 16, nt * 16, lane, (f32x4){0.f, 0.f, 0.f, 0.f});
        *(f32x4*)(gUp + (nt * 16 + r) * 64 + mt * 16 + q4) = a;
    }
    if (F.tid < 64) { float s = 0.f; for (int x = 0; x < 64; ++x) s += bf2f(kwT[F.tid * 72 + x]); aux[ch * 64 + F.tid] = s; }
}

__device__ __forceinline__ void ml_scan(Frame& F, int bh) {
    const int ch0 = bh * 64;
    const float* gUp = (const float*)(F.ws + WS_ML_UPT) + (size_t)ch0 * 8192; bf16* gCT = (bf16*)(F.ws + WS_ML_CT) + (size_t)ch0 * 8192;
    float* aux = (float*)(F.ws + WS_ML_AUX);
    f32x4 C[4], un[4]; float nv = 0.f, m = 0.f;
#pragma unroll
    for (int x = 0; x < 4; ++x) { C[x] = (f32x4){0.f, 0.f, 0.f, 0.f}; un[x] = *(const f32x4*)(gUp + x * 2048 + F.tid * 4); }
    float npn = (F.tid < 64) ? aux[ch0 * 64 + F.tid] : 0.f;
#pragma unroll 1
    for (int n = 0; n < 64; ++n) {
        const int ch = ch0 + n;
        f32x4 u[4]; const float np = npn;
#pragma unroll
        for (int x = 0; x < 4; ++x) u[x] = un[x];
        if (n + 1 < 64) {
#pragma unroll
            for (int x = 0; x < 4; ++x) un[x] = *(const f32x4*)(gUp + (size_t)(n + 1) * 8192 + x * 2048 + F.tid * 4);
            if (F.tid < 64) npn = aux[(ch + 1) * 64 + F.tid];
        }
#pragma unroll
        for (int x = 0; x < 4; ++x) *(v2u*)(gCT + (size_t)n * 8192 + x * 2048 + F.tid * 4) = pk4(C[x]);
        if (F.tid < 64) aux[65536 + ch * 64 + F.tid] = nv;
        if (F.tid == 0) aux[133120 + ch] = m;
        const float bl = aux[131072 + ch * 2], gm = aux[131072 + ch * 2 + 1];
        const float m1 = fmaxf(bl + m, gm), keep = __expf(bl + m - m1), sc = __expf(gm - m1);
#pragma unroll
        for (int x = 0; x < 4; ++x) C[x] = C[x] * keep + u[x] * sc;
        nv = nv * keep + np * sc; m = m1;
    }
}

__device__ __forceinline__ void ml_out(Frame& F, int ch) {
    const int bh = ch >> 6, n = ch & 63, b = bh >> 2, h = bh & 3;
    const size_t row0 = (size_t)b * SEQ + n * 64;
    LAS bf16* qI = (LAS bf16*)(F.lds + 0);
    LAS bf16* qS = (LAS bf16*)(F.lds + 9216);
    LAS bf16* kS = (LAS bf16*)(F.lds + 18432);
    LAS bf16* pM = (LAS bf16*)(F.lds + 27648);
    LAS bf16* vT = (LAS bf16*)(F.lds + 36864);
    LAS bf16* cT = (LAS bf16*)(F.lds + 57600);
    LAS float* hb = (LAS float*)(F.lds + 78336);
    LAS float* gg = (LAS float*)(F.lds + 116224);
    const bf16* proj = (const bf16*)(F.ws + WS_PROJ); const float* g16 = (const float*)(F.ws + WS_G16);
    const bf16* gQC = (const bf16*)(F.ws + WS_ML_QC) + (size_t)ch * 4096; const bf16* gKC = (const bf16*)(F.ws + WS_ML_KC) + (size_t)ch * 4096;
    const bf16* gCT = (const bf16*)(F.ws + WS_ML_CT) + (size_t)ch * 8192; const float* aux = (const float*)(F.ws + WS_ML_AUX);
    const int lane = F.lane, w = F.wave, r = lane & 15, q4 = (lane >> 4) * 4;
    __syncthreads();
    if (w == 0) {
        const float* g = g16 + (row0 + lane) * 16;
        const float ip = g[8 + h] + F.in[I_MLIB][h]; float bc = logsigmoidf_(g[12 + h] + F.in[I_MLFB][h]);
#pragma unroll
        for (int o = 1; o < 64; o <<= 1) { const float v = __shfl_up(bc, o); if (lane >= o) bc += v; }
        const float rj = ip - bc; float pm = rj;
#pragma unroll
        for (int o = 1; o < 64; o <<= 1) { const float v = __shfl_up(pm, o); if (lane >= o) pm = fmaxf(pm, v); }
        const float ms = aux[133120 + ch], mt = fmaxf(bc + ms, bc + pm);
        gg[lane] = bc; gg[64 + lane] = rj; gg[128 + lane] = mt; gg[192 + lane] = __expf(bc + ms - mt);
    }
    for (int i = F.tid; i < 16 * 72; i += NTHR) { const bf16 one = (bf16)0x3f80; vT[128 * 72 + i] = (i < 64) ? one : (bf16)0; cT[128 * 72 + i] = (bf16)0; }
    __syncthreads();
    { const int c = F.tid, row = c >> 3, pc = c & 7;
        const v4u qv = *(const v4u*)(gQC + row * 64 + pc * 8); *(LAS v4u*)(qS + row * 72 + pc * 8) = qv; *(LAS v4u*)(kS + row * 72 + pc * 8) = *(const v4u*)(gKC + row * 64 + pc * 8);
        const float in = gg[192 + row]; v4u o;
        o.x = pk2(bf2f(qv.x & 0xffff) * in, bf2f(qv.x >> 16) * in); o.y = pk2(bf2f(qv.y & 0xffff) * in, bf2f(qv.y >> 16) * in);
        o.z = pk2(bf2f(qv.z & 0xffff) * in, bf2f(qv.z >> 16) * in); o.w = pk2(bf2f(qv.w & 0xffff) * in, bf2f(qv.w >> 16) * in);
        *(LAS v4u*)(qI + row * 72 + pc * 8) = o; }
    for (int c = F.tid; c < 1024; c += NTHR) { const int row = c >> 3, pc = c & 7; *(LAS v4u*)(cT + row * 72 + pc * 8) = *(const v4u*)(gCT + row * 64 + pc * 8); }
    if (F.tid < 64) cT[128 * 72 + F.tid] = (bf16)f2bf(aux[65536 + ch * 64 + F.tid]);
#pragma unroll 1
    for (int it = 0; it < 2; ++it) {
        const int item = it * 512 + F.tid, i = item >> 4, cg = item & 15;
        const v4u raw = *(const v4u*)(proj + (row0 + i) * NMAIN + MC_MLV + h * 128 + cg * 8);
        LAS bf16* d = vT + (cg * 8) * 72 + i;
        d[0] = (bf16)(raw.x & 0xffff); d[72] = (bf16)(raw.x >> 16); d[144] = (bf16)(raw.y & 0xffff); d[216] = (bf16)(raw.y >> 16);
        d[288] = (bf16)(raw.z & 0xffff); d[360] = (bf16)(raw.z >> 16); d[432] = (bf16)(raw.w & 0xffff); d[504] = (bf16)(raw.w >> 16);
    }
    __syncthreads();
    for (int t = w; t < 16; t += 8) { const int jt = t >> 2, itl = t & 3;
        const f32x4 a = tile_mma<64>(kS, 72, qS, 72, jt * 16, itl * 16, lane, (f32x4){0.f, 0.f, 0.f, 0.f});
        const int i = itl * 16 + r; const float e0 = gg[i] - gg[128 + i]; f32x4 o;
#pragma unroll
        for (int x = 0; x < 4; ++x) { const int j = jt * 16 + q4 + x; o[x] = (j <= i) ? a[x] * __expf(e0 + gg[64 + j]) : 0.f; }
        *(LAS v2u*)(pM + i * 72 + jt * 16 + q4) = pk4(o);
    }
    __syncthreads();
    for (int t = w; t < 36; t += 8) { const int mt = t & 3, nt = t >> 2;
        f32x4 a = tile_mma<64>(qI, 72, cT, 72, mt * 16, nt * 16, lane, (f32x4){0.f, 0.f, 0.f, 0.f});
        a = tile_mma<64>(pM, 72, vT, 72, mt * 16, nt * 16, lane, a);
        const int e = nt * 16 + r;
#pragma unroll
        for (int x = 0; x < 4; ++x) hb[(mt * 16 + q4 + x) * 148 + e] = a[x];
    }
    __syncthreads();
    bf16* mix = (bf16*)(F.ws + WS_MIX); const float* mln = F.in[I_MLNORM];
    for (int rr = 0; rr < 8; ++rr) { const int i = w * 8 + rr;
        const float dd = fmaxf(fabsf(hb[i * 148 + 128]), __expf(-gg[128 + i]));
        const float o0 = hb[i * 148 + 2 * lane] / dd, o1 = hb[i * 148 + 2 * lane + 1] / dd;
        const float rstd = rsqrtf(wave_sum(o0 * o0 + o1 * o1) * (1.f / 128.f) + EPS);
        const unsigned z = *(const unsigned*)(proj + (row0 + i) * NMAIN + MC_MLO + h * 128 + 2 * lane);
        const float y0 = o0 * rstd * mln[h * 128 + 2 * lane] * sigmoidf_(bf2f(z & 0xffff)), y1 = o1 * rstd * mln[h * 128 + 2 * lane + 1] * sigmoidf_(bf2f(z >> 16));
        *(unsigned*)(mix + (row0 + i) * D + 512 + h * 128 + 2 * lane) = pk2(y0, y1);
    }
}

template <int J0> __device__ __forceinline__ void p4_mixnorm(Frame& F) {
    const float* raw = (const float*)(F.ws + WS_RAW); const bf16* proj = (const bf16*)(F.ws + WS_PROJ); bf16* mix = (bf16*)(F.ws + WS_MIX);
    const float* dnn = F.in[I_DNNORM]; const float* mln = F.in[I_MLNORM];
    const int gw = F.vb * NWAVES + F.wave, NGW = F.G * NWAVES;
    for (int row = gw; row < T; row += NGW) {
        const f32x4* rr = (const f32x4*)(raw + (size_t)row * D) + F.lane;
        v2u* o8 = (v2u*)(mix + (size_t)row * D) + F.lane;
#pragma unroll
        for (int j = J0; j < 4; ++j) {
            f32x4 v = rr[64 * j]; float ss = (v.x * v.x + v.y * v.y) + (v.z * v.z + v.w * v.w);
#pragma unroll
            for (int o = 1; o < 32; o <<= 1) ss += __shfl_xor(ss, o);
            const float rstd = rsqrtf(ss * (1.f / 128.f) + EPS);
            const int k = 256 * j + F.lane * 4;
            f32x4 w, gt;
            if (j < 2) { w = *(const f32x4*)(dnn + (k & 127)); const v2u z = *(const v2u*)(proj + (size_t)row * NMAIN + MC_DNZ + k);
                gt.x = siluf_(bf2f(z.x & 0xffff)); gt.y = siluf_(bf2f(z.x >> 16)); gt.z = siluf_(bf2f(z.y & 0xffff)); gt.w = siluf_(bf2f(z.y >> 16)); }
            else { w = *(const f32x4*)(mln + (k - 512)); const v2u z = *(const v2u*)(proj + (size_t)row * NMAIN + MC_MLO + (k - 512));
                gt.x = sigmoidf_(bf2f(z.x & 0xffff)); gt.y = sigmoidf_(bf2f(z.x >> 16)); gt.z = sigmoidf_(bf2f(z.y & 0xffff)); gt.w = sigmoidf_(bf2f(z.y >> 16)); }
            v = v * rstd * w * gt;
            v2u o; o.x = pk2(v.x, v.y); o.y = pk2(v.z, v.w); o8[64 * j] = o;
        }
    }
}

__device__ __forceinline__ void p6_router(Frame& F) {
    LAS float* wr = (LAS float*)F.lds;
    LAS float* lg = (LAS float*)(F.lds + L_EXTRA);
    { const float* src = (const float*)(F.ws + WS_WRT); for (int i = F.tid; i < NE * D / 4; i += NTHR) ((LAS f32x4*)wr)[i] = ((const f32x4*)src)[i]; }
    __syncthreads();
    const float* x1 = (const float*)(F.ws + WS_X1); const float* nw = F.in[I_NFFN]; const float* mod = (const float*)(F.ws + WS_MOD);
    bf16* h2 = (bf16*)(F.ws + WS_H); const float* br = F.in[I_BR];
    int* tok_e = (int*)(F.ws + WS_TOKE); int* tok_r = (int*)(F.ws + WS_TOKR); float* tok_w = (float*)(F.ws + WS_TOKW); int* slot_tok = (int*)(F.ws + WS_SLOTTOK);
    unsigned* gcnt = (unsigned*)(F.ws + WS_CTL) + CW_CNT;
    for (int blk = F.vb; blk < T / 64; blk += F.G) {
        for (int rr = 0; rr < 8; ++rr) {
            const int lr = F.wave * 8 + rr, row = blk * 64 + lr, b = row / SEQ;
            const f32x4* xr = (const f32x4*)(x1 + (size_t)row * D) + F.lane;
            f32x4 v[4]; float ss = 0.f;
#pragma unroll
            for (int j = 0; j < 4; ++j) { v[j] = xr[64 * j]; ss += (v[j].x * v[j].x + v[j].y * v[j].y) + (v[j].z * v[j].z + v[j].w * v[j].w); }
            const float rstd = rsqrtf(wave_sum(ss) * (1.f / D) + EPS);
            const float* sh = mod + b * 6144 + 3072; const float* sc = sh + 1024;
#pragma unroll
            for (int j = 0; j < 4; ++j) { const int k = 256 * j + F.lane * 4;
                const f32x4 w = *(const f32x4*)(nw + k), s1 = *(const f32x4*)(sc + k), s0 = *(const f32x4*)(sh + k);
                v[j] = (v[j] * rstd * w) * (1.0f + s1) + s0; }
            v2u* o8 = (v2u*)(h2 + (size_t)row * D) + F.lane;
#pragma unroll
            for (int j = 0; j < 4; ++j) { v2u o; o.x = pk2(v[j].x, v[j].y); o.y = pk2(v[j].z, v[j].w); o8[64 * j] = o; }
            float acc[32];
#pragma unroll
            for (int e = 0; e < 32; ++e) { float a = 0.f;
#pragma unroll
                for (int j = 0; j < 4; ++j) { const f32x4 w = *(const LAS f32x4*)(wr + e * 1024 + 256 * j + F.lane * 4); a += (v[j].x * w.x + v[j].y * w.y) + (v[j].z * w.z + v[j].w * w.w); }
                acc[e] = a; if (e & 1) asm volatile("" ::: "memory"); }
            const float r = multi_reduce<32>(acc, F.lane);
            if ((F.lane & 1) == 0) lg[lr * 33 + (F.lane >> 1)] = r + br[F.lane >> 1];
        }
        __syncthreads();
        if (F.wave == 0) {
            const int row = blk * 64 + F.lane;
            float l[32];
#pragma unroll
            for (int e = 0; e < 32; ++e) l[e] = lg[F.lane * 33 + e];
            int te[4]; float tl[4];
#pragma unroll
            for (int k = 0; k < 4; ++k) { float best = -3.0e38f; int bi = 0;
#pragma unroll
                for (int e = 0; e < 32; ++e) { if (l[e] > best) { best = l[e]; bi = e; } }
                te[k] = bi; tl[k] = best;
#pragma unroll
                for (int e = 0; e < 32; ++e) if (e == bi) l[e] = -3.0e38f; }
            float w0 = 1.f, w1 = __expf(tl[1] - tl[0]), w2 = __expf(tl[2] - tl[0]), w3 = __expf(tl[3] - tl[0]); const float inv = 1.f / (w0 + w1 + w2 + w3);
            w0 *= inv; w1 *= inv; w2 *= inv; w3 *= inv;
            int mycount = 0;
#pragma unroll
            for (int k = 0; k < 4; ++k) {
#pragma unroll 1
                for (int e = 0; e < 32; ++e) { const unsigned long long mk = __ballot(te[k] == e); if (F.lane == e) mycount += __popcll(mk); } }
            int base = 0; if (F.lane < 32) base = (int)__hip_atomic_fetch_add(gcnt + F.lane, (unsigned)mycount, __ATOMIC_RELAXED, __HIP_MEMORY_SCOPE_AGENT);
            int run = 0;
            int rk[4];
#pragma unroll
            for (int k = 0; k < 4; ++k) { rk[k] = 0;
#pragma unroll 1
                for (int e = 0; e < 32; ++e) { const unsigned long long mk = __ballot(te[k] == e);
                    const int be = __shfl(base, e), re = __shfl(run, e);
                    if (te[k] == e) rk[k] = be + re + __popcll(mk & ((1ull << F.lane) - 1ull));
                    if (F.lane == e) run += __popcll(mk); } }
            const float ww[4] = {w0, w1, w2, w3};
#pragma unroll
            for (int k = 0; k < 4; ++k) { tok_e[row * 4 + k] = te[k]; tok_r[row * 4 + k] = rk[k]; tok_w[row * 4 + k] = ww[k]; if (rk[k] < ECAP) slot_tok[te[k] * ECAP + rk[k]] = row; }
        }
        __syncthreads();
    }
}

__device__ __forceinline__ void p9_final(Frame& F) {
    build_expert_tables(F);
    const LAS int* tst = (const LAS int*)(F.lds + L_TST);
    const float* x1 = (const float*)(F.ws + WS_X1); const bf16* y = (const bf16*)(F.ws + WS_Y);
    const float* mod = (const float*)(F.ws + WS_MOD); const float* modf = (const float*)(F.ws + WS_MODF); const float* nf = F.in[I_NFIN];
    const int* tok_e = (const int*)(F.ws + WS_TOKE); const int* tok_r = (const int*)(F.ws + WS_TOKR); const float* tok_w = (const float*)(F.ws + WS_TOKW);
    const int gw = F.vb * NWAVES + F.wave, NGW = F.G * NWAVES;
    for (int row = gw; row < T; row += NGW) {
        const int b = row / SEQ;
        const f32x4* xr = (const f32x4*)(x1 + (size_t)row * D) + F.lane;
        f32x4 v[4], m[4];
#pragma unroll
        for (int j = 0; j < 4; ++j) { v[j] = xr[64 * j]; m[j] = (f32x4){0.f, 0.f, 0.f, 0.f}; }
#pragma unroll
        for (int k = 0; k < 4; ++k) { const int e = tok_e[row * 4 + k], r = tok_r[row * 4 + k]; const float w = tok_w[row * 4 + k];
            const size_t cs = (size_t)tst[e] * 256 + r;
            const v2u* yr = (const v2u*)(y + cs * D) + F.lane;
#pragma unroll
            for (int j = 0; j < 4; ++j) { const v2u z = yr[64 * j];
                m[j].x += w * bf2f(z.x & 0xffff); m[j].y += w * bf2f(z.x >> 16); m[j].z += w * bf2f(z.y & 0xffff); m[j].w += w * bf2f(z.y >> 16); } }
        const float* g2 = mod + b * 6144 + 5120; float ss = 0.f;
#pragma unroll
        for (int j = 0; j < 4; ++j) { const f32x4 g = *(const f32x4*)(g2 + 256 * j + F.lane * 4); v[j] = v[j] + g * m[j];
            ss += (v[j].x * v[j].x + v[j].y * v[j].y) + (v[j].z * v[j].z + v[j].w * v[j].w); }
        const float rstd = rsqrtf(wave_sum(ss) * (1.f / D) + EPS);
        const float* sh = modf + b * 2048; const float* sc = sh + 1024;
        f32x4* orow = (f32x4*)(F.out + (size_t)row * D) + F.lane;
#pragma unroll
        for (int j = 0; j < 4; ++j) { const int k = 256 * j + F.lane * 4;
            const f32x4 w = *(const f32x4*)(nf + k), s1 = *(const f32x4*)(sc + k), s0 = *(const f32x4*)(sh + k);
            orow[64 * j] = (v[j] * rstd * w) * (1.0f + s1) + s0; }
    }
}

constexpr int NPH = 11;
__global__ void __launch_bounds__(NTHR, 2) fwd(Args args) {
    extern __shared__ __attribute__((aligned(16))) unsigned char lds_raw[];
    Frame F;
    F.lds = (LAS unsigned char*)lds_raw; F.ws = args.ws; F.out = args.out;
#pragma unroll
    for (int i = 0; i < 25; ++i) F.in[i] = args.in[i];
    F.tid = threadIdx.x; F.lane = F.tid & 63; F.wave = __builtin_amdgcn_readfirstlane(F.tid >> 6);
    F.G = gridDim.x; F.vb = blockIdx.x;
    for (int u = F.tid; u < (LDS_BYTES - LDSCTL_OFF) / 4; u += NTHR) ((LAS unsigned*)(F.lds + LDSCTL_OFF))[u] = 0u;
    __syncthreads();
    unsigned* ctl = (unsigned*)(F.ws + WS_CTL);
    const int lo = args.ph_lo, hi = args.ph_hi;
    XcdBarrier bar; bar.bar = ctl + CW_BAR; bar.x = 0; bar.st = nullptr;
    if (hi - lo > 1) bar = xcd_barrier_post(ctl + CW_BAR, (volatile LAS unsigned*)(F.lds + L_MISC) + 8);
#ifndef PHMASK
#define PHMASK 0x7ff
#endif
#define IN(k) (((PHMASK >> (k)) & 1) && lo <= (k) && (k) < hi)
#define SEAM(k) do { if (IN(k) && IN((k) + 1)) xcd_barrier(bar); } while (0)

    if (IN(0)) { p0_prologue(F); } SEAM(0);
    if (IN(1)) { p1_norm1(F); } SEAM(1);
    if (IN(2)) {
        pg8::Gemm g{(const bf16*)(F.ws + WS_H), D}; pg8::DenseOrder S; S.init(T, NMAIN, D, (const bf16*)(F.ws + WS_BTIN), F.G, F.vb);
        EpiProj E{(bf16*)(F.ws + WS_PROJ), NMAIN};
        pg8::gemm_phase<EpiProj, pg8::DenseOrder, true, true>(F.lds, g, S, E);
    } SEAM(2);
    if (IN(3)) { for (int it = F.vb; it < 2048; it += F.G) { if (it < 1024) dn_prep(F, it); else ml_prep(F, it - 1024); } } SEAM(3);
    if (IN(4)) { if (F.vb < 16) dn_scan(F, F.vb); else if (F.vb < 32) ml_scan(F, F.vb - 16); } SEAM(4);
    if (IN(5)) { for (int it = F.vb; it < 2048; it += F.G) { if (it < 1024) dn_out(F, it); else ml_out(F, it - 1024); } } SEAM(5);
    if (IN(6)) {
        pg8::Gemm g{(const bf16*)(F.ws + WS_MIX), D}; pg8::DenseOrder S; S.init(T, D, D, (const bf16*)(F.ws + WS_BTOUT), F.G, F.vb);
        EpiRes E{F.in[I_X], (float*)(F.ws + WS_X1), (const float*)(F.ws + WS_MOD)};
        pg8::gemm_phase<EpiRes, pg8::DenseOrder, false, true>(F.lds, g, S, E);
    } SEAM(6);
    if (IN(7)) { p6_router(F); } SEAM(7);
    if (IN(8)) {
        const int nmt = build_expert_tables(F);
        GroupedOrder<4, 8, true> S; S.G = F.G; S.c = F.vb; S.nmt = nmt; S.K = D; S.tileE = (const LAS int*)(F.lds + L_TILEE); S.tst = (const LAS int*)(F.lds + L_TST); S.cnt = (const LAS int*)(F.lds + L_CNT);
        S.slot_tok = (const int*)(F.ws + WS_SLOTTOK); S.Bt = (const bf16*)(F.ws + WS_BTGU); S.bexp = (size_t)2048 * D;
        pg8::Gemm g{(const bf16*)(F.ws + WS_H), D};
        EpiGU E{(bf16*)(F.ws + WS_ACT), F.in[I_BGU]};
        pg8::gemm_phase<EpiGU, GroupedOrder<4, 8, true>, true, true>(F.lds, g, S, E);
    } SEAM(8);
    if (IN(9)) {
        const int nmt = build_expert_tables(F);
        GroupedOrder<8, 4, false> S; S.G = F.G; S.c = F.vb; S.nmt = nmt; S.K = D; S.tileE = (const LAS int*)(F.lds + L_TILEE); S.tst = (const LAS int*)(F.lds + L_TST); S.cnt = (const LAS int*)(F.lds + L_CNT);
        S.slot_tok = nullptr; S.Bt = (const bf16*)(F.ws + WS_BTDN); S.bexp = (size_t)D * D;
        pg8::Gemm g{(const bf16*)(F.ws + WS_ACT), D};
        EpiDown E{(bf16*)(F.ws + WS_Y), F.in[I_BDN]};
        pg8::gemm_phase<EpiDown, GroupedOrder<8, 4, false>, true, true>(F.lds, g, S, E);
    } SEAM(9);
    if (IN(10)) { p9_final(F); }
#undef IN
#undef SEAM
}

extern "C" void kernel_launch(void* const* d_in, const int* in_sizes, int n_in, void* d_out, int out_size, void* d_ws, size_t ws_size, hipStream_t stream) {
    static int grid = 0;
    if (grid == 0) {
        if (n_in != 25 || in_sizes[0] != T * D || out_size != T * D || ws_size < WS_END) { fprintf(stderr, "kernel_launch: unexpected shapes (n_in %d, ws %zu)\n", n_in, ws_size); grid = -1; return; }
        int dev = 0, cus = 0, per_cu = 0;
        if (hipGetDevice(&dev) != hipSuccess || hipDeviceGetAttribute(&cus, hipDeviceAttributeMultiprocessorCount, dev) != hipSuccess) { grid = -1; return; }
        if (hipFuncSetAttribute((const void*)fwd, hipFuncAttributeMaxDynamicSharedMemorySize, LDS_BYTES) != hipSuccess) { fprintf(stderr, "kernel_launch: hipFuncSetAttribute failed\n"); grid = -1; return; }
        if (hipOccupancyMaxActiveBlocksPerMultiprocessor(&per_cu, (const void*)fwd, NTHR, LDS_BYTES) != hipSuccess || per_cu < 1) { fprintf(stderr, "kernel_launch: occupancy query says %d\n", per_cu); }
        (void)hipGetLastError();
        grid = cus;
    }
    if (grid < 0) return;
    hipMemsetAsync((char*)d_ws + WS_CTL, 0, CTL_ZERO_BYTES, stream);
    Args a{};
    for (int i = 0; i < 25; ++i) a.in[i] = (const float*)d_in[i];
    a.out = (float*)d_out; a.ws = (unsigned char*)d_ws;
#if MK_ONE_LAUNCH
    a.ph_lo = 0; a.ph_hi = NPH;
    hipLaunchKernelGGL(fwd, dim3(grid), dim3(NTHR), LDS_BYTES, stream, a);
#else
    for (int p = 0; p < NPH; ++p) { a.ph_lo = p; a.ph_hi = p + 1; hipLaunchKernelGGL(fwd, dim3(grid), dim3(NTHR), LDS_BYTES, stream, a); }
#endif
}
```

```cpp
#include <hip/hip_runtime.h>
#include <cstdio>
#include <cstdint>

#ifndef MK_ONE_LAUNCH
#define MK_ONE_LAUNCH 1
#endif

namespace pg8 {
#define PG8_LAS __attribute__((address_space(3)))
typedef unsigned short bf16_t;
typedef short bf16x8 __attribute__((ext_vector_type(8)));
typedef float f32x4 __attribute__((ext_vector_type(4)));
typedef unsigned u32x4 __attribute__((ext_vector_type(4)));
constexpr int BM = 256, BK = 64, HALF = 128, HTB = HALF * BK * 2, STAGE_BYTES = 8 * HTB, NXCD = 8, WGM = 8;

__host__ __device__ __forceinline__ int lds_byte(int r, int c) { const int st = (r >> 4) * 2 + (c >> 5), rr = r & 15, cc = c & 31, ob = rr * 64 + cc * 2; return st * 1024 + (ob ^ (((ob >> 9) & 1) << 5)); }
__host__ __device__ __forceinline__ void stage_rc(int b, int& R, int& C) { const int st = b / 1024, sb = b % 1024, swz = sb ^ (((sb >> 9) & 1) << 5); R = (st >> 1) * 16 + swz / 64; C = (st & 1) * 32 + (swz % 64) / 2; }
__host__ __device__ __forceinline__ int perm32(int rho) { const int n = rho >> 4, i = rho & 15; return 8 * (i >> 2) + 4 * n + (i & 3); }

struct Unit { int pm, pn, e; };
struct Gemm { const bf16_t* A; int K; };

struct DenseOrder {
    int nM, nN, nwg, G, c, K; const bf16_t* Bt;
    __device__ void init(int M, int N, int K_, const bf16_t* Bt_, int G_, int c_) { nM = M / BM; nN = N / BM; nwg = nM * nN; G = G_; c = c_; K = K_; Bt = Bt_; }
    __device__ bool next(int i, Unit& u) const {
        const long L = (long)i * G + c; if (L >= nwg) return false;
        int wgid = (int)L; { const int q = nwg / NXCD, r = nwg % NXCD, xcd = wgid % NXCD, off = wgid / NXCD; wgid = (xcd < r ? xcd * (q + 1) : r * (q + 1) + (xcd - r) * q) + off; }
        const int nig = WGM * nN, gid = wgid / nig, fm = gid * WGM, gsz = (nM - fm) < WGM ? (nM - fm) : WGM;
        u.pm = fm + ((wgid % nig) % gsz); u.pn = (wgid % nig) / gsz; u.e = 0; return true;
    }
    __device__ __forceinline__ void a_voff(const Unit& u, const int (&R)[2], const int (&C)[2], unsigned (&vo)[2][2]) const {
#pragma unroll
        for (int h = 0; h < 2; ++h)
#pragma unroll
            for (int i = 0; i < 2; ++i) vo[h][i] = (unsigned)((u.pm * BM + h * HALF + R[i]) * K + C[i]) * 2u;
    }
    __device__ __forceinline__ const char* b_ptr(const Unit& u) const { return (const char*)Bt + (size_t)u.pn * BM * K * 2; }
};

__device__ __forceinline__ unsigned cvt_pk_bf16(float lo, float hi) { unsigned r; asm volatile("v_cvt_pk_bf16_f32 %0, %1, %2" : "=v"(r) : "v"(lo), "v"(hi)); return r; }

template <class Epi, class Sched, bool ALIGN_EPI = false, bool SP2 = false>
__device__ __forceinline__ void gemm_phase(PG8_LAS unsigned char* lds, const Gemm g, const Sched& S, const Epi& E) {
    const int tid = threadIdx.x, wid = __builtin_amdgcn_readfirstlane(tid >> 6), lane = tid & 63, wr = wid >> 2, wc = wid & 3, fr = lane & 15, fq = lane >> 4;
    const int K = g.K, nt = K / BK;
    int RA[2], CA[2]; unsigned voffB[2];
#pragma unroll
    for (int i = 0; i < 2; ++i) { int R, C; stage_rc(tid * 16 + i * 8192, R, C); const int Rb = Epi::PERM ? ((R & ~31) + perm32(R & 31)) : R;
        RA[i] = R; CA[i] = C; voffB[i] = (unsigned)(Rb * K + C) * 2u; }
    const size_t kstep = (size_t)(BK * 2);
    const size_t hstep = (size_t)HALF * K * 2;
    const unsigned ldsw = (unsigned)wid * 1024u;
    const int aoff = lds_byte(wr * 64 + fr, fq * 8), boff = lds_byte(wc * 32 + fr, fq * 8);
#define PG8_SA(b, h) (((b) * 2 + (h)) * HTB)
#define PG8_SB(b, h) ((4 + (b) * 2 + (h)) * HTB)
#define PG8_STAGE(bufoff, gbase, voff) do { _Pragma("unroll") for (int _i = 0; _i < 2; ++_i) \
        __builtin_amdgcn_global_load_lds((const unsigned*)((const char*)(gbase) + (voff)[_i]), (PG8_LAS unsigned*)(lds + (bufoff) + ldsw + _i * 8192), 16, 0, 0); } while (0)
#define PG8_LDA(dst, b, h) do { _Pragma("unroll") for (int m = 0; m < 4; ++m) _Pragma("unroll") for (int k = 0; k < 2; ++k) dst[m][k] = *(const PG8_LAS bf16x8*)(lds + PG8_SA(b, h) + aoff + m * 2048 + k * 1024); } while (0)
#define PG8_LDB(dst, b, h) do { _Pragma("unroll") for (int n = 0; n < 2; ++n) _Pragma("unroll") for (int k = 0; k < 2; ++k) dst[n][k] = *(const PG8_LAS bf16x8*)(lds + PG8_SB(b, h) + boff + n * 2048 + k * 1024); } while (0)
#define PG8_MMA(ai, bj, At, Bt) do { __builtin_amdgcn_s_setprio(1); _Pragma("unroll") for (int m = 0; m < 4; ++m) _Pragma("unroll") for (int n = 0; n < 2; ++n) _Pragma("unroll") for (int k = 0; k < 2; ++k) \
        acc[ai][bj][m][n] = __builtin_amdgcn_mfma_f32_16x16x32_bf16(Bt[n][k], At[m][k], acc[ai][bj][m][n], 0, 0, 0); __builtin_amdgcn_s_setprio(0); } while (0)
#define PG8_WAIT_V(n) asm volatile("s_waitcnt vmcnt(" #n ")" ::: "memory")
#define PG8_WAIT_L(n) asm volatile("s_waitcnt lgkmcnt(" #n ")" ::: "memory")
#define PG8_BAR __builtin_amdgcn_s_barrier()
#define PG8_SCHED __builtin_amdgcn_sched_barrier(0)
    Unit cur, nxt; int ui = 0;
    if (!S.next(0, cur)) return;
    f32x4 acc[2][2][4][2];
#pragma unroll
    for (int a = 0; a < 2; ++a)
#pragma unroll
        for (int b = 0; b < 2; ++b)
#pragma unroll
            for (int m = 0; m < 4; ++m)
#pragma unroll
                for (int n = 0; n < 2; ++n) acc[a][b][m][n] = (f32x4){0.f, 0.f, 0.f, 0.f};
    bf16x8 At[4][2], B0[2][2], B1[2][2];
    unsigned cvo[2][2], nvo[2][2];
    S.a_voff(cur, RA, CA, cvo);
    const char* const Ab = (const char*)g.A;
    const char* cB = S.b_ptr(cur);
    if constexpr (SP2) {
        PG8_STAGE(PG8_SB(0, 0), cB, voffB); PG8_STAGE(PG8_SB(0, 1), cB + hstep, voffB); PG8_STAGE(PG8_SA(0, 0), Ab, cvo[0]); PG8_STAGE(PG8_SA(0, 1), Ab, cvo[1]);
        if (wr == 1) PG8_BAR;
        PG8_WAIT_V(2); PG8_BAR;
        PG8_STAGE(PG8_SB(1, 0), cB + kstep, voffB); PG8_STAGE(PG8_SA(1, 0), Ab + kstep, cvo[0]); PG8_STAGE(PG8_SB(1, 1), cB + hstep + kstep, voffB);
        PG8_WAIT_V(6); PG8_BAR;
    } else {
        PG8_STAGE(PG8_SB(0, 0), cB, voffB); PG8_STAGE(PG8_SA(0, 0), Ab, cvo[0]); PG8_STAGE(PG8_SB(0, 1), cB + hstep, voffB); PG8_STAGE(PG8_SA(0, 1), Ab, cvo[1]);
        if (wr == 1) PG8_BAR;
        PG8_WAIT_V(4); PG8_BAR;
        PG8_STAGE(PG8_SB(1, 0), cB + kstep, voffB); PG8_STAGE(PG8_SA(1, 0), Ab + kstep, cvo[0]); PG8_STAGE(PG8_SB(1, 1), cB + hstep + kstep, voffB);
        PG8_WAIT_V(6); PG8_BAR;
    }
    for (;;) {
        const bool has_next = S.next(ui + 1, nxt);
        const char* nB = cB;
        if (has_next) { nB = S.b_ptr(nxt); S.a_voff(nxt, RA, CA, nvo); }
        else { nvo[0][0] = cvo[0][0]; nvo[0][1] = cvo[0][1]; nvo[1][0] = cvo[1][0]; nvo[1][1] = cvo[1][1]; }
        for (int t = 0; t < nt; t += 2) {
            const bool last = (t == nt - 2);
            const char* a1 = Ab + (size_t)(t + 1) * kstep;
            const char* a2 = last ? Ab : Ab + (size_t)(t + 2) * kstep; const char* b2 = last ? nB : cB + (size_t)(t + 2) * kstep;
            const char* a3 = a2 + kstep; const char* b3 = b2 + kstep;
            unsigned v2[2][2];
            v2[0][0] = last ? nvo[0][0] : cvo[0][0]; v2[0][1] = last ? nvo[0][1] : cvo[0][1]; v2[1][0] = last ? nvo[1][0] : cvo[1][0]; v2[1][1] = last ? nvo[1][1] : cvo[1][1];
            if constexpr (SP2) {
            PG8_LDB(B0, 0, 0); PG8_LDB(B1, 0, 1); PG8_SCHED; PG8_LDA(At, 0, 0); PG8_STAGE(PG8_SA(1, 1), a1, cvo[1]);
            PG8_WAIT_V(8); PG8_WAIT_L(0); PG8_BAR; PG8_MMA(0, 0, At, B0); PG8_MMA(0, 1, At, B1); PG8_BAR; PG8_SCHED;
            PG8_LDA(At, 0, 1); PG8_STAGE(PG8_SB(0, 0), b2, voffB); PG8_STAGE(PG8_SB(0, 1), b2 + hstep, voffB); PG8_STAGE(PG8_SA(0, 0), a2, v2[0]);
            PG8_WAIT_V(8); PG8_WAIT_L(0); PG8_BAR; PG8_MMA(1, 0, At, B0); PG8_MMA(1, 1, At, B1); PG8_BAR; PG8_SCHED;
            PG8_LDB(B0, 1, 0); PG8_LDB(B1, 1, 1); PG8_SCHED; PG8_LDA(At, 1, 0); PG8_STAGE(PG8_SA(0, 1), a2, v2[1]);
            PG8_WAIT_V(8); PG8_WAIT_L(0); PG8_BAR; PG8_MMA(0, 0, At, B0); PG8_MMA(0, 1, At, B1); PG8_BAR; PG8_SCHED;
            PG8_LDA(At, 1, 1); PG8_STAGE(PG8_SB(1, 0), b3, voffB); PG8_STAGE(PG8_SB(1, 1), b3 + hstep, voffB); PG8_STAGE(PG8_SA(1, 0), a3, v2[0]);
            PG8_WAIT_V(8); PG8_WAIT_L(0); PG8_BAR; PG8_MMA(1, 0, At, B0); PG8_MMA(1, 1, At, B1); PG8_BAR; PG8_SCHED;
            } else {
            PG8_LDB(B0, 0, 0); PG8_SCHED; PG8_LDA(At, 0, 0); PG8_STAGE(PG8_SA(1, 1), a1, cvo[1]);
            PG8_WAIT_L(8); PG8_BAR; PG8_WAIT_L(0); PG8_MMA(0, 0, At, B0); PG8_BAR; PG8_SCHED;
            PG8_LDB(B1, 0, 1); PG8_STAGE(PG8_SB(0, 0), b2, voffB);
            PG8_BAR; PG8_WAIT_L(0); PG8_MMA(0, 1, At, B1); PG8_BAR;
            PG8_LDA(At, 0, 1); PG8_STAGE(PG8_SA(0, 0), a2, v2[0]);
            PG8_BAR; PG8_WAIT_L(0); PG8_MMA(1, 0, At, B0); PG8_BAR; PG8_SCHED;
            PG8_STAGE(PG8_SB(0, 1), b2 + hstep, voffB);
            PG8_WAIT_V(6); PG8_BAR; PG8_MMA(1, 1, At, B1); PG8_BAR;
            PG8_LDB(B0, 1, 0); PG8_SCHED; PG8_LDA(At, 1, 0); PG8_STAGE(PG8_SA(0, 1), a2, v2[1]);
            PG8_WAIT_L(8); PG8_BAR; PG8_WAIT_L(0); PG8_MMA(0, 0, At, B0); PG8_BAR; PG8_SCHED;
            PG8_LDB(B1, 1, 1); PG8_STAGE(PG8_SB(1, 0), b3, voffB);
            PG8_BAR; PG8_WAIT_L(0); PG8_MMA(0, 1, At, B1); PG8_BAR;
            PG8_LDA(At, 1, 1); PG8_STAGE(PG8_SA(1, 0), a3, v2[0]);
            PG8_BAR; PG8_WAIT_L(0); PG8_MMA(1, 0, At, B0); PG8_BAR; PG8_SCHED;
            PG8_STAGE(PG8_SB(1, 1), b3 + hstep, voffB);
            PG8_WAIT_V(6); PG8_BAR; PG8_MMA(1, 1, At, B1); PG8_BAR;
            }
        }
        if constexpr (ALIGN_EPI) { if (wr == 0) PG8_BAR; }
        E(acc, cur, wr, wc, fr, fq);
        if (!has_next) break;
#pragma unroll
        for (int a = 0; a < 2; ++a)
#pragma unroll
            for (int b = 0; b < 2; ++b)
#pragma unroll
                for (int m = 0; m < 4; ++m)
#pragma unroll
                    for (int n = 0; n < 2; ++n) acc[a][b][m][n] = (f32x4){0.f, 0.f, 0.f, 0.f};
        cur = nxt; cB = nB; ++ui;
        cvo[0][0] = nvo[0][0]; cvo[0][1] = nvo[0][1]; cvo[1][0] = nvo[1][0]; cvo[1][1] = nvo[1][1];
        if constexpr (ALIGN_EPI) { if (wr == 1) PG8_BAR; }
    }
    PG8_WAIT_V(0);
    if constexpr (!ALIGN_EPI) { if (wr == 0) PG8_BAR; }
    PG8_BAR;
#undef PG8_SA
#undef PG8_SB
#undef PG8_STAGE
#undef PG8_LDA
#undef PG8_LDB
#undef PG8_MMA
#undef PG8_WAIT_V
#undef PG8_WAIT_L
#undef PG8_BAR
#undef PG8_SCHED
}
}

constexpr int NWAVES = 8, NTHR = 512;
constexpr int T = 16384, D = 1024, SEQ = 4096, NB = 4;
constexpr int DIN = 3600, NMAIN = 3584;
constexpr int NE = 32, TOPK = 4, ECAP = 16384, MAXMT = 288;
constexpr float EPS = 1e-6f;
constexpr int MC_DNQ = 0, MC_DNK = 512, MC_DNV = 1024, MC_DNZ = 1536, MC_MLQ = 2048, MC_MLK = 2304, MC_MLV = 2560, MC_MLO = 3072;

constexpr size_t MiB = 1u << 20;
constexpr size_t WS_CTL = 0, CTL_ZERO_BYTES = 1 * MiB;
constexpr size_t WS_MOD = 1 * MiB;
constexpr size_t WS_MODF = WS_MOD + 128 * 1024;
constexpr size_t WS_WRT = WS_MOD + 256 * 1024;
constexpr size_t WS_WGT = WS_MOD + 384 * 1024;
constexpr size_t WS_BTIN = 2 * MiB;
constexpr size_t WS_BTOUT = 9 * MiB;
constexpr size_t WS_G16 = 11 * MiB;
constexpr size_t WS_TOKE = 12 * MiB;
constexpr size_t WS_TOKR = WS_TOKE + 256 * 1024;
constexpr size_t WS_TOKW = WS_TOKE + 512 * 1024;
constexpr size_t WS_SLOTTOK = 13 * MiB;
constexpr size_t WS_H = 16 * MiB;
constexpr size_t WS_MIX = 48 * MiB;
constexpr size_t WS_X1 = 80 * MiB;
constexpr size_t WS_BTGU = 144 * MiB;
constexpr size_t WS_BTDN = 272 * MiB;
constexpr size_t WS_PROJ = 336 * MiB;
constexpr size_t WS_RAW = 448 * MiB;
constexpr size_t WS_ACT = 336 * MiB;
constexpr size_t WS_Y = 480 * MiB;
constexpr size_t WS_DN_MP = 512 * MiB;
constexpr size_t WS_DN_UT = 544 * MiB;
constexpr size_t WS_DN_KC = 608 * MiB;
constexpr size_t WS_DN_WT = 624 * MiB;
constexpr size_t WS_DN_QD = 640 * MiB;
constexpr size_t WS_DN_QK = 656 * MiB;
constexpr size_t WS_DN_SD = 664 * MiB;
constexpr size_t WS_DN_ST = 666 * MiB;
constexpr size_t WS_ML_UPT = 698 * MiB;
constexpr size_t WS_ML_QC = 730 * MiB;
constexpr size_t WS_ML_KC = 738 * MiB;
constexpr size_t WS_ML_CT = 746 * MiB;
constexpr size_t WS_ML_AUX = 762 * MiB;
constexpr size_t WS_END = 764 * MiB;
constexpr int CW_BAR = 8192;
constexpr int CW_CNT = 1024;

constexpr int RING_BYTES = 131072;
constexpr int LDSCTL_OFF = RING_BYTES;
constexpr int L_MISC = LDSCTL_OFF;
constexpr int L_CNT = LDSCTL_OFF + 256;
constexpr int L_TST = LDSCTL_OFF + 384;
constexpr int L_TILEE = LDSCTL_OFF + 576;
constexpr int L_EXTRA = LDSCTL_OFF + 2048;
constexpr int LDS_BYTES = 147456;

#define LAS __attribute__((address_space(3)))
typedef unsigned short bf16;
typedef unsigned v4u __attribute__((ext_vector_type(4)));
typedef unsigned v2u __attribute__((ext_vector_type(2)));
typedef float f32x4 __attribute__((ext_vector_type(4)));
#define LDS_WAIT() asm volatile("s_waitcnt lgkmcnt(0)" ::: "memory")
__device__ __forceinline__ unsigned f2bf(float f) { unsigned u = __builtin_bit_cast(unsigned, f); return (u + 0x7fffu + ((u >> 16) & 1u)) >> 16; }
__device__ __forceinline__ unsigned pk2(float lo, float hi) { return f2bf(lo) | (f2bf(hi) << 16); }
__device__ __forceinline__ float bf2f(unsigned short b) { return __builtin_bit_cast(float, ((unsigned)b) << 16); }
__device__ __forceinline__ float sigmoidf_(float x) { return 1.0f / (1.0f + __expf(-x)); }
__device__ __forceinline__ float siluf_(float x) { return x / (1.0f + __expf(-x)); }
__device__ __forceinline__ float softplusf_(float x) { return x > 20.f ? x : log1pf(__expf(x)); }
__device__ __forceinline__ float logsigmoidf_(float x) { return x < 0.f ? x - log1pf(__expf(x)) : -log1pf(__expf(-x)); }

#define XB_TMO      128
#define XB_XCNT(j)  (256  + 64 * (j))
#define XB_XSUB(j)  (1280 + 64 * (j))
#define XB_XGEN(j)  (2304 + 64 * (j))
#define XB_TOP      3328
#define XB_TOPGEN   3392
#define XCD_BAR_WORDS 3456
#define XB_SPIN_CAP (1u << 18)
__device__ __forceinline__ unsigned xb_ld(unsigned* p)              { return __hip_atomic_load(p, __ATOMIC_RELAXED, __HIP_MEMORY_SCOPE_AGENT); }
__device__ __forceinline__ unsigned xb_add(unsigned* p, unsigned v) { return __hip_atomic_fetch_add(p, v, __ATOMIC_RELAXED, __HIP_MEMORY_SCOPE_AGENT); }
__device__ __forceinline__ unsigned xb_xcc_id() { return (unsigned)__builtin_amdgcn_s_getreg((3 << 11) | 20) & 0xFu; }
#define XB_SPIN(cond, bar) do { unsigned _sp = 0; while (cond) { __builtin_amdgcn_s_sleep(1); \
    if ((++_sp & 255u) == 0u) { if (xb_ld(&(bar)[XB_TMO])) break; if (_sp > XB_SPIN_CAP) { atomicAdd(&(bar)[XB_TMO], 1u); break; } } } } while (0)
struct XcdBarrier { unsigned* bar; unsigned x; volatile LAS unsigned* st; };
__device__ __forceinline__ XcdBarrier xcd_barrier_post(unsigned* bar, volatile LAS unsigned* st) {
    XcdBarrier b; b.bar = bar; b.x = xb_xcc_id(); b.st = st;
    if (threadIdx.x == 0) (void)xb_add(&bar[XB_XCNT(b.x)], 1u);
    return b;
}
__device__ __forceinline__ void xcd_barrier_complete(unsigned* bar, unsigned x, unsigned& nloc, unsigned& nx) {
    const unsigned G = gridDim.x * gridDim.y * gridDim.z;
    unsigned sum, cnt, mine, sp = 0u;
    for (;;) {
        sum = 0u; cnt = 0u; mine = 0u;
#pragma unroll
        for (unsigned j = 0; j < 16; ++j) { const unsigned c = xb_ld(&bar[XB_XCNT(j)]); sum += c; cnt += (c > 0u) ? 1u : 0u; mine = (j == x) ? c : mine; }
        if (sum == G) break;
        __builtin_amdgcn_s_sleep(1);
        if ((++sp & 255u) == 0u) { if (xb_ld(&bar[XB_TMO])) break; if (sp > XB_SPIN_CAP) { atomicAdd(&bar[XB_TMO], 1u); break; } }
    }
    nloc = mine > 0u ? mine : 1u; nx = cnt > 0u ? cnt : 1u;
}
__device__ __forceinline__ void xcd_barrier(const XcdBarrier& b) {
    asm volatile("s_waitcnt vmcnt(0)" ::: "memory");
    __syncthreads();
    if (threadIdx.x == 0) {
        unsigned* bar = b.bar;
        __builtin_amdgcn_s_waitcnt(0);
        unsigned nloc = b.st[0], nx = b.st[1];
        if (nloc == 0u) { xcd_barrier_complete(bar, b.x, nloc, nx); b.st[0] = nloc; b.st[1] = nx; }
        const unsigned old = xb_add(&bar[XB_XSUB(b.x)], 1u);
        const unsigned gen = old / nloc;
        if (old + 1u == (gen + 1u) * nloc) {
            __builtin_amdgcn_fence(__ATOMIC_RELEASE, "agent");
            asm volatile("s_waitcnt vmcnt(0)" ::: "memory");
            const unsigned og = xb_add(&bar[XB_TOP], 1u);
            const unsigned tg = og / nx;
            if (og + 1u == (tg + 1u) * nx) xb_add(&bar[XB_TOPGEN], 1u);
            else XB_SPIN(xb_ld(&bar[XB_TOPGEN]) == tg, bar);
            __builtin_amdgcn_fence(__ATOMIC_ACQUIRE, "agent");
            xb_add(&bar[XB_XGEN(b.x)], 1u);
            asm volatile("s_waitcnt vmcnt(0)" ::: "memory");
        } else {
            XB_SPIN(xb_ld(&bar[XB_XGEN(b.x)]) == gen, bar);
            __builtin_amdgcn_fence(__ATOMIC_ACQUIRE, "agent");
            asm volatile("s_waitcnt vmcnt(0)" ::: "memory");
        }
    }
    __syncthreads();
}

struct Args { const float* in[25]; float* out; unsigned char* ws; int ph_lo, ph_hi; };
struct Frame {
    LAS unsigned char* lds; unsigned char* ws; const float* in[25]; float* out;
    int tid, lane, wave, vb, G;
};
enum { I_X = 0, I_C, I_WADA, I_BADA, I_NMIX, I_WIN, I_DNCONV, I_DNALOG, I_DNDT, I_DNNORM, I_MLCONV, I_MLIB, I_MLFB, I_MLNORM, I_WOUT, I_NFFN, I_WR, I_BR, I_WGU, I_BGU, I_WDN, I_BDN, I_WADAF, I_BADAF, I_NFIN };

__device__ __forceinline__ float wave_sum(float v) {
#pragma unroll
    for (int o = 1; o < 64; o <<= 1) v += __shfl_xor(v, o);
    return v;
}

__device__ __forceinline__ void transpose_item(const float* W, int ldw, int K, bf16* WT, int k0, int src_n0, int dst_n0, LAS float* scr, int lane) {
#pragma unroll 8
    for (int i = 0; i < 32; ++i) { const int kk = 2 * i + (lane >> 5); scr[kk * 33 + (lane & 31)] = W[(size_t)(k0 + kk) * ldw + src_n0 + (lane & 31)]; }
    LDS_WAIT(); asm volatile("" ::: "memory");
    const int c = lane & 7;
#pragma unroll
    for (int j = 0; j < 4; ++j) { const int n = (lane >> 3) + 8 * j; const LAS float* s = scr + (8 * c) * 33 + n;
        v4u o; o.x = pk2(s[0 * 33], s[1 * 33]); o.y = pk2(s[2 * 33], s[3 * 33]); o.z = pk2(s[4 * 33], s[5 * 33]); o.w = pk2(s[6 * 33], s[7 * 33]);
        *(v4u*)(WT + (size_t)(dst_n0 + n) * K + k0 + 8 * c) = o; }
    LDS_WAIT(); asm volatile("" ::: "memory");
}
__device__ __forceinline__ void p0_prologue(Frame& F) {
    __syncthreads();
    {
        LAS float* cond = (LAS float*)F.lds;
        LAS float* part = (LAS float*)(F.lds + 16384);
        const float* c = F.in[I_C];
        for (int i = F.tid; i < NB * D; i += NTHR) cond[i] = siluf_(c[i]);
        __syncthreads();
        for (int cb = F.vb; cb < 256; cb += F.G) {
            const int j0 = cb * 32; const bool fin = j0 >= 6144;
            const float* W = fin ? F.in[I_WADAF] : F.in[I_WADA]; const int ld = fin ? 2048 : 6144; const int jc = fin ? j0 - 6144 : j0;
            const float* bias = fin ? F.in[I_BADAF] : F.in[I_BADA];
            float* out = fin ? (float*)(F.ws + WS_MODF) : (float*)(F.ws + WS_MOD);
            const int s = F.tid >> 5, jj = F.tid & 31;
            float a0 = 0.f, a1 = 0.f, a2 = 0.f, a3 = 0.f;
            for (int k = s * 64; k < s * 64 + 64; ++k) { const float w = W[(size_t)k * ld + jc + jj]; a0 += cond[k] * w; a1 += cond[1024 + k] * w; a2 += cond[2048 + k] * w; a3 += cond[3072 + k] * w; }
            part[(s * 4 + 0) * 32 + jj] = a0; part[(s * 4 + 1) * 32 + jj] = a1; part[(s * 4 + 2) * 32 + jj] = a2; part[(s * 4 + 3) * 32 + jj] = a3;
            __syncthreads();
            if (F.tid < 128) { const int b = F.tid >> 5, j = F.tid & 31; float sum = 0.f;
                for (int q = 0; q < 16; ++q) sum += part[(q * 4 + b) * 32 + j];
                out[b * ld + jc + j] = sum + bias[jc + j]; }
            __syncthreads();
        }
    }
    {
        const int gt = F.vb * NTHR + F.tid, NGT = F.G * NTHR;
        float* wrT = (float*)(F.ws + WS_WRT); const float* wr = F.in[I_WR];
        for (int i = gt; i < NE * D; i += NGT) { const int e = i >> 10, k = i & 1023; wrT[i] = wr[k * NE + e]; }
        float* wgT = (float*)(F.ws + WS_WGT); const float* win = F.in[I_WIN];
        for (int i = gt; i < 16 * D; i += NGT) { const int g = i >> 10, k = i & 1023; const int col = g < 8 ? 2048 + g : 3592 + (g - 8); wgT[i] = win[(size_t)k * DIN + col]; }
    }
    {
        LAS float* scr = (LAS float*)(F.lds + F.wave * 16384);
        const int gw = F.vb * NWAVES + F.wave, NGW = F.G * NWAVES;
        constexpr int I_IN = 16 * (NMAIN / 32), I_OUT = 16 * 32;
        for (int it = gw; it < I_IN + I_OUT; it += NGW) {
            int r = it;
            if (r < I_IN) { const int nblk = NMAIN / 32, kb = r / nblk, nb = r % nblk; const int dn0 = nb * 32, sn0 = dn0 < 2048 ? dn0 : dn0 + 8;
                transpose_item(F.in[I_WIN], DIN, D, (bf16*)(F.ws + WS_BTIN), kb * 64, sn0, dn0, scr, F.lane); continue; }
            r -= I_IN;
            { const int kb = r / 32, nb = r % 32; transpose_item(F.in[I_WOUT], D, D, (bf16*)(F.ws + WS_BTOUT), kb * 64, nb * 32, nb * 32, scr, F.lane); }
        }
    }
}
__device__ __forceinline__ void convert_moe(Frame& F, int vb, int nvb) {
    LAS float* scr = (LAS float*)(F.lds + F.wave * 16384);
    const int gw = vb * NWAVES + F.wave, NGW = nvb * NWAVES;
    constexpr int I_GU1 = 16 * 64, I_DN1 = 16 * 32;
    for (int it = gw; it < NE * (I_GU1 + I_DN1); it += NGW) {
        int r = it;
        if (r < NE * I_GU1) { const int e = r / I_GU1, q = r % I_GU1, kb = q / 64, nb = q % 64; const int dn0 = nb * 32;
            const int sn0 = ((dn0 & 255) >> 7) * 1024 + (dn0 >> 8) * 128 + (dn0 & 127);
            transpose_item(F.in[I_WGU] + (size_t)e * D * 2048, 2048, D, (bf16*)(F.ws + WS_BTGU) + (size_t)e * 2048 * D, kb * 64, sn0, dn0, scr, F.lane); continue; }
        r -= NE * I_GU1;
        { const int e = r / I_DN1, q = r % I_DN1, kb = q / 32, nb = q % 32;
            transpose_item(F.in[I_WDN] + (size_t)e * D * D, D, D, (bf16*)(F.ws + WS_BTDN) + (size_t)e * D * D, kb * 64, nb * 32, nb * 32, scr, F.lane); }
    }
}

#define MR_STEP(n, bit) { const bool hi = (lane & (bit)) != 0; _Pragma("unroll") for (int i = 0; i < (n) / 2; ++i) { const float send = hi ? v[i] : v[i + (n) / 2]; const float keep = hi ? v[i + (n) / 2] : v[i]; v[i] = keep + __shfl_xor(send, (bit)); } }
template <int N> __device__ __forceinline__ float multi_reduce(float (&v)[N], int lane) {
    float r;
    if constexpr (N == 32) { MR_STEP(32, 32) MR_STEP(16, 16) MR_STEP(8, 8) MR_STEP(4, 4) MR_STEP(2, 2) r = v[0]; r += __shfl_xor(r, 1); }
    else { MR_STEP(16, 32) MR_STEP(8, 16) MR_STEP(4, 8) MR_STEP(2, 4) r = v[0]; r += __shfl_xor(r, 2); r += __shfl_xor(r, 1); }
    return r;
}

__device__ __forceinline__ void p1_norm1(Frame& F) {
    LAS float* wg = (LAS float*)F.lds;
    { const float* src = (const float*)(F.ws + WS_WGT); for (int i = F.tid; i < 16 * D / 4; i += NTHR) ((LAS f32x4*)wg)[i] = ((const f32x4*)src)[i]; }
    __syncthreads();
    const float* x = F.in[I_X]; const float* nw = F.in[I_NMIX]; const float* mod = (const float*)(F.ws + WS_MOD);
    bf16* h1 = (bf16*)(F.ws + WS_H); float* g16 = (float*)(F.ws + WS_G16);
    const int gw = F.vb * NWAVES + F.wave, NGW = F.G * NWAVES;
    for (int row = gw; row < T; row += NGW) {
        const int b = row / SEQ;
        const f32x4* xr = (const f32x4*)(x + (size_t)row * D) + F.lane;
        f32x4 v[4]; float ss = 0.f;
#pragma unroll
        for (int j = 0; j < 4; ++j) { v[j] = xr[64 * j]; ss += (v[j].x * v[j].x + v[j].y * v[j].y) + (v[j].z * v[j].z + v[j].w * v[j].w); }
        const float rstd = rsqrtf(wave_sum(ss) * (1.f / D) + EPS);
        const float* sh = mod + b * 6144; const float* sc = sh + 1024;
#pragma unroll
        for (int j = 0; j < 4; ++j) { const int k = 256 * j + F.lane * 4;
            const f32x4 w = *(const f32x4*)(nw + k), s1 = *(const f32x4*)(sc + k), s0 = *(const f32x4*)(sh + k);
            v[j] = (v[j] * rstd * w) * (1.0f + s1) + s0; }
        v2u* o8 = (v2u*)(h1 + (size_t)row * D) + F.lane;
#pragma unroll
        for (int j = 0; j < 4; ++j) { v2u o; o.x = pk2(v[j].x, v[j].y); o.y = pk2(v[j].z, v[j].w); o8[64 * j] = o; }
        float acc[16];
#pragma unroll
        for (int g = 0; g < 16; ++g) { float a = 0.f;
#pragma unroll
            for (int j = 0; j < 4; ++j) { const f32x4 w = *(const LAS f32x4*)(wg + g * 1024 + 256 * j + F.lane * 4); a += (v[j].x * w.x + v[j].y * w.y) + (v[j].z * w.z + v[j].w * w.w); }
            acc[g] = a; if (g & 1) asm volatile("" ::: "memory"); }
        const float r = multi_reduce<16>(acc, F.lane);
        if ((F.lane & 3) == 0) g16[(size_t)row * 16 + (F.lane >> 2)] = r;
    }
}

struct EpiProj {
    static constexpr bool PERM = true;
    bf16* O; int ldc;
    __device__ __forceinline__ void operator()(const pg8::f32x4 (&acc)[2][2][4][2], const pg8::Unit& u, int wr, int wc, int fr, int fq) const {
        const int row0 = u.pm * 256 + wr * 64 + fr, col0 = u.pn * 256 + wc * 32 + 8 * fq;
#pragma unroll
        for (int ai = 0; ai < 2; ++ai)
#pragma unroll
            for (int m = 0; m < 4; ++m) { bf16* rowp = O + (size_t)(row0 + ai * 128 + m * 16) * ldc + col0;
#pragma unroll
                for (int bj = 0; bj < 2; ++bj) { const pg8::f32x4 v0 = acc[ai][bj][m][0], v1 = acc[ai][bj][m][1];
                    v4u w; w.x = pg8::cvt_pk_bf16(v0[0], v0[1]); w.y = pg8::cvt_pk_bf16(v0[2], v0[3]); w.z = pg8::cvt_pk_bf16(v1[0], v1[1]); w.w = pg8::cvt_pk_bf16(v1[2], v1[3]);
                    *(v4u*)(rowp + bj * 128) = w; } }
    }
};
struct EpiRes {
    static constexpr bool PERM = false;
    const float* X; float* O; const float* mod;
    __device__ __forceinline__ void operator()(const pg8::f32x4 (&acc)[2][2][4][2], const pg8::Unit& u, int wr, int wc, int fr, int fq) const {
        const int row0 = u.pm * 256 + wr * 64 + fr, col0 = u.pn * 256 + wc * 32 + 4 * fq;
        const int b = (u.pm * 256) / SEQ; const float* g1 = mod + b * 6144 + 2048;
        pg8::f32x4 gv[2][2];
#pragma unroll
        for (int bj = 0; bj < 2; ++bj)
#pragma unroll
            for (int n = 0; n < 2; ++n) gv[bj][n] = *(const pg8::f32x4*)(g1 + col0 + bj * 128 + n * 16);
#pragma unroll
        for (int ai = 0; ai < 2; ++ai)
#pragma unroll
            for (int m = 0; m < 4; ++m) { const size_t off = (size_t)(row0 + ai * 128 + m * 16) * D + col0;
#pragma unroll
                for (int bj = 0; bj < 2; ++bj)
#pragma unroll
                    for (int n = 0; n < 2; ++n) { const pg8::f32x4 xv = *(const pg8::f32x4*)(X + off + bj * 128 + n * 16);
                        *(pg8::f32x4*)(O + off + bj * 128 + n * 16) = xv + gv[bj][n] * acc[ai][bj][m][n]; }
                asm volatile("" ::: "memory"); }
    }
};
struct EpiGU {
    static constexpr bool PERM = true;
    bf16* O; const float* bgu;
    __device__ __forceinline__ void operator()(const pg8::f32x4 (&acc)[2][2][4][2], const pg8::Unit& u, int wr, int wc, int fr, int fq) const {
        const int row0 = u.pm * 256 + wr * 64 + fr, cc = u.pn * 128 + wc * 32 + 8 * fq;
        const float* bg = bgu + (size_t)u.e * 2048 + cc; const float* bu = bg + 1024;
        pg8::f32x4 bgv[2], buv[2];
#pragma unroll
        for (int n = 0; n < 2; ++n) { bgv[n] = *(const pg8::f32x4*)(bg + 4 * n); buv[n] = *(const pg8::f32x4*)(bu + 4 * n); }
#pragma unroll
        for (int ai = 0; ai < 2; ++ai)
#pragma unroll
            for (int m = 0; m < 4; ++m) { bf16* rowp = O + (size_t)(row0 + ai * 128 + m * 16) * D + cc;
                float r[8];
#pragma unroll
                for (int n = 0; n < 2; ++n)
#pragma unroll
                    for (int j = 0; j < 4; ++j) { float gt = acc[ai][0][m][n][j] + bgv[n][j], up = acc[ai][1][m][n][j] + buv[n][j];
                        gt = fminf(gt, 7.0f); up = fminf(fmaxf(up, -7.0f), 7.0f);
                        r[n * 4 + j] = (up + 1.0f) * gt * sigmoidf_(1.702f * gt); }
                v4u w; w.x = pg8::cvt_pk_bf16(r[0], r[1]); w.y = pg8::cvt_pk_bf16(r[2], r[3]); w.z = pg8::cvt_pk_bf16(r[4], r[5]); w.w = pg8::cvt_pk_bf16(r[6], r[7]);
                *(v4u*)rowp = w; }
    }
};
struct EpiDown {
    static constexpr bool PERM = true;
    bf16* O; const float* bdn;
    __device__ __forceinline__ void operator()(const pg8::f32x4 (&acc)[2][2][4][2], const pg8::Unit& u, int wr, int wc, int fr, int fq) const {
        const int row0 = u.pm * 256 + wr * 64 + fr, col0 = u.pn * 256 + wc * 32 + 8 * fq;
        const float* bb = bdn + (size_t)u.e * D + col0;
        pg8::f32x4 bv[2][2];
#pragma unroll
        for (int bj = 0; bj < 2; ++bj)
#pragma unroll
            for (int n = 0; n < 2; ++n) bv[bj][n] = *(const pg8::f32x4*)(bb + bj * 128 + 4 * n);
#pragma unroll
        for (int ai = 0; ai < 2; ++ai)
#pragma unroll
            for (int m = 0; m < 4; ++m) { bf16* rowp = O + (size_t)(row0 + ai * 128 + m * 16) * D + col0;
#pragma unroll
                for (int bj = 0; bj < 2; ++bj) { const pg8::f32x4 v0 = acc[ai][bj][m][0] + bv[bj][0], v1 = acc[ai][bj][m][1] + bv[bj][1];
                    v4u w; w.x = pg8::cvt_pk_bf16(v0[0], v0[1]); w.y = pg8::cvt_pk_bf16(v0[2], v0[3]); w.z = pg8::cvt_pk_bf16(v1[0], v1[1]); w.w = pg8::cvt_pk_bf16(v1[2], v1[3]);
                    *(v4u*)(rowp + bj * 128) = w; } }
    }
};

template <int MB, int NBK, bool GATHER> struct GroupedOrder {
    int G, c, nmt, K; const LAS int* tileE; const LAS int* tst; const LAS int* cnt; const int* slot_tok; const bf16* Bt; size_t bexp;
    __device__ bool next(int i, pg8::Unit& u) const {
        const int nwg = nmt * NBK; const long L = (long)i * G + c; if (L >= nwg) return false;
        int U = (int)L; { const int q = nwg / 8, r = nwg % 8, xcd = U % 8, off = U / 8; U = (xcd < r ? xcd * (q + 1) : r * (q + 1) + (xcd - r) * q) + off; }
        const int nig = MB * NBK, gid = U / nig, fm = gid * MB, gsz = (nmt - fm) < MB ? (nmt - fm) : MB;
        u.pm = fm + ((U % nig) % gsz); u.pn = (U % nig) / gsz; u.e = tileE[u.pm]; return true;
    }
    __device__ __forceinline__ void a_voff(const pg8::Unit& u, const int (&R)[2], const int (&C)[2], unsigned (&vo)[2][2]) const {
        if (GATHER) {
            const int r0 = (u.pm - tst[u.e]) * 256, ce = cnt[u.e];
#pragma unroll
            for (int h = 0; h < 2; ++h)
#pragma unroll
                for (int i = 0; i < 2; ++i) { const int rk = r0 + h * 128 + R[i]; int tok = 0; if (rk < ce) tok = slot_tok[u.e * ECAP + rk];
                    vo[h][i] = (unsigned)(tok * K + C[i]) * 2u; }
        } else {
#pragma unroll
            for (int h = 0; h < 2; ++h)
#pragma unroll
                for (int i = 0; i < 2; ++i) vo[h][i] = (unsigned)((u.pm * 256 + h * 128 + R[i]) * K + C[i]) * 2u;
        }
    }
    __device__ __forceinline__ const char* b_ptr(const pg8::Unit& u) const { return (const char*)(Bt + (size_t)u.e * bexp + (size_t)u.pn * 256 * K); }
};

__device__ __forceinline__ int build_expert_tables(Frame& F) {
    LAS int* lc = (LAS int*)(F.lds + L_CNT); LAS int* lt = (LAS int*)(F.lds + L_TST); LAS int* le = (LAS int*)(F.lds + L_TILEE);
    const unsigned* gc = (const unsigned*)(F.ws + WS_CTL) + CW_CNT;
    __syncthreads();
    if (F.tid < 64) {
        int c = 0; if (F.lane < NE) { c = (int)__hip_atomic_load(gc + 64 * F.lane, __ATOMIC_RELAXED, __HIP_MEMORY_SCOPE_AGENT); if (c > ECAP) c = ECAP; }
        const int nt = (c + 255) >> 8; int incl = nt;
#pragma unroll
        for (int o = 1; o < 32; o <<= 1) { const int v = __shfl_up(incl, o); if (F.lane >= o) incl += v; }
        const int excl = incl - nt;
        if (F.lane < NE) { lc[F.lane] = c; lt[F.lane] = excl; for (int i = 0; i < nt; ++i) le[excl + i] = F.lane; }
        if (F.lane == NE - 1) lt[NE] = incl;
    }
    __syncthreads();
    return lt[NE];
}

__device__ __forceinline__ void p3_naive_dn(Frame& F, int bh) {
    const int b = bh >> 2, h = bh & 3;
    LAS float* qs_ = (LAS float*)F.lds;
    LAS float* ks_ = qs_ + 64 * 128;
    LAS float* vs_ = ks_ + 64 * 128;
    LAS float* qsc = vs_ + 64 * 128;
    LAS float* ksc = qsc + 64; LAS float* bet = ksc + 64; LAS float* ade = bet + 64;
    const bf16* proj = (const bf16*)(F.ws + WS_PROJ); const float* g16 = (const float*)(F.ws + WS_G16);
    const float* cw = F.in[I_DNCONV]; float* raw = (float*)(F.ws + WS_RAW);
    const float Aexp = __expf(F.in[I_DNALOG][h]), dtb = F.in[I_DNDT][h];
    const int e = F.tid >> 2, ds = F.tid & 3, d0 = ds * 32;
    float S[32];
#pragma unroll
    for (int i = 0; i < 32; ++i) S[i] = 0.f;
    for (int n = 0; n < 64; ++n) {
        __syncthreads();
        for (int idx = F.tid; idx < 64 * 384; idx += NTHR) {
            const int i = idx / 384, c = idx % 384, which = c >> 7, cc = c & 127, col = which * 512 + h * 128 + cc;
            const int t = n * 64 + i; float a = 0.f;
#pragma unroll
            for (int j = 0; j < 4; ++j) { const int tt = t - 3 + j; if (tt >= 0) a += bf2f(proj[(size_t)(b * SEQ + tt) * NMAIN + col]) * cw[j * 1536 + col]; }
            (which == 0 ? qs_ : which == 1 ? ks_ : vs_)[i * 128 + cc] = siluf_(a);
        }
        if (F.tid < 64) { const size_t row = (size_t)b * SEQ + n * 64 + F.tid;
            bet[F.tid] = sigmoidf_(g16[row * 16 + h]); ade[F.tid] = __expf(-Aexp * softplusf_(g16[row * 16 + 4 + h] + dtb)); }
        __syncthreads();
        if (F.tid < 128) { const int i = F.tid & 63, which = F.tid >> 6; const LAS float* p = (which ? ks_ : qs_) + i * 128; float ss = 0.f;
            for (int c = 0; c < 128; ++c) ss += p[c] * p[c];
            const float sc = rsqrtf(ss + EPS); if (which) ksc[i] = sc; else qsc[i] = sc * 0.08838834764831845f; }
        __syncthreads();
        for (int i = 0; i < 64; ++i) {
            const float kscale = ksc[i], qscale = qsc[i], be = bet[i], a = ade[i];
            const LAS float* kp = ks_ + i * 128 + d0; const LAS float* qp = qs_ + i * 128 + d0;
            float kv[32]; float p = 0.f;
#pragma unroll
            for (int d = 0; d < 32; ++d) { kv[d] = kp[d] * kscale; p += kv[d] * S[d]; }
            p += __shfl_xor(p, 1); p += __shfl_xor(p, 2);
            const float uu = be * (vs_[i * 128 + e] - a * p);
            float o = 0.f;
#pragma unroll
            for (int d = 0; d < 32; ++d) { S[d] = a * S[d] + kv[d] * uu; o += qp[d] * S[d]; }
            o *= qscale; o += __shfl_xor(o, 1); o += __shfl_xor(o, 2);
            if (ds == 0) raw[((size_t)b * SEQ + n * 64 + i) * D + h * 128 + e] = o;
        }
    }
}
__device__ __forceinline__ void p3_naive_ml(Frame& F, int bh) {
    const int b = bh >> 2, h = bh & 3;
    LAS float* qs_ = (LAS float*)F.lds;
    LAS float* ks_ = qs_ + 64 * 64;
    LAS float* vs_ = ks_ + 64 * 64;
    LAS float* ipr = vs_ + 64 * 128; LAS float* lgf = ipr + 64;
    const bf16* proj = (const bf16*)(F.ws + WS_PROJ); const float* g16 = (const float*)(F.ws + WS_G16);
    const float* cw = F.in[I_MLCONV]; float* raw = (float*)(F.ws + WS_RAW);
    const float ib = F.in[I_MLIB][h], fb = F.in[I_MLFB][h];
    const int e = F.tid >> 2, ds = F.tid & 3, d0 = ds * 16;
    float C[16], nn[16]; float m = 0.f;
#pragma unroll
    for (int i = 0; i < 16; ++i) { C[i] = 0.f; nn[i] = 0.f; }
    for (int n = 0; n < 64; ++n) {
        __syncthreads();
        for (int idx = F.tid; idx < 64 * 128; idx += NTHR) {
            const int i = idx >> 7, c = idx & 127, which = c >> 6, cc = c & 63, ch = which * 256 + h * 64 + cc;
            const int t = n * 64 + i; float a = 0.f;
#pragma unroll
            for (int j = 0; j < 4; ++j) { const int tt = t - 3 + j; if (tt >= 0) a += bf2f(proj[(size_t)(b * SEQ + tt) * NMAIN + MC_MLQ + ch]) * cw[j * 512 + ch]; }
            const float y = siluf_(a);
            if (which == 0) qs_[i * 64 + cc] = y * 0.125f; else ks_[i * 64 + cc] = y;
        }
        for (int idx = F.tid; idx < 64 * 128; idx += NTHR) { const int i = idx >> 7, c = idx & 127;
            vs_[idx] = bf2f(proj[(size_t)(b * SEQ + n * 64 + i) * NMAIN + MC_MLV + h * 128 + c]); }
        if (F.tid < 64) { const size_t row = (size_t)b * SEQ + n * 64 + F.tid;
            ipr[F.tid] = g16[row * 16 + 8 + h] + ib; lgf[F.tid] = logsigmoidf_(g16[row * 16 + 12 + h] + fb); }
        __syncthreads();
        for (int i = 0; i < 64; ++i) {
            const float lf = lgf[i], ip = ipr[i];
            const float mn = fmaxf(lf + m, ip), fp = __expf(lf + m - mn), iq = __expf(ip - mn); m = mn;
            const LAS float* kp = ks_ + i * 64 + d0; const LAS float* qp = qs_ + i * 64 + d0;
            const float vv = vs_[i * 128 + e] * iq;
            float num = 0.f, den = 0.f;
#pragma unroll
            for (int d = 0; d < 16; ++d) { const float kk = kp[d], qq = qp[d]; C[d] = fp * C[d] + kk * vv; nn[d] = fp * nn[d] + iq * kk; num += qq * C[d]; den += qq * nn[d]; }
            num += __shfl_xor(num, 1); num += __shfl_xor(num, 2); den += __shfl_xor(den, 1); den += __shfl_xor(den, 2);
            const float hh = num / fmaxf(fabsf(den), __expf(-m));
            if (ds == 0) raw[((size_t)b * SEQ + n * 64 + i) * D + 512 + h * 128 + e] = hh;
        }
    }
}

typedef short bf16x8_t __attribute__((ext_vector_type(8)));
template <int K> __device__ __forceinline__ f32x4 tile_mma(const LAS bf16* A, int lda, const LAS bf16* Bt, int ldb, int m0, int n0, int lane, f32x4 acc) {
    const int r = lane & 15, kq = (lane >> 4) * 8;
    const LAS bf16* ap = A + (m0 + r) * lda + kq; const LAS bf16* bp = Bt + (n0 + r) * ldb + kq;
#pragma unroll
    for (int k = 0; k < K; k += 32) { const bf16x8_t a = *(const LAS bf16x8_t*)(ap + k); const bf16x8_t b = *(const LAS bf16x8_t*)(bp + k);
        acc = __builtin_amdgcn_mfma_f32_16x16x32_bf16(a, b, acc, 0, 0, 0); }
    return acc;
}
__device__ __forceinline__ v2u pk4(f32x4 v) { v2u o; o.x = pk2(v.x, v.y); o.y = pk2(v.z, v.w); return o; }

__device__ __forceinline__ void dn_prep(Frame& F, int ch) {
    const int bh = ch >> 6, n = ch & 63, b = bh >> 2, h = bh & 3;
    const size_t row0 = (size_t)b * SEQ + n * 64;
    LAS bf16* kN = (LAS bf16*)(F.lds + 0);
    LAS bf16* qN = (LAS bf16*)(F.lds + 17408);
    LAS bf16* solT = (LAS bf16*)(F.lds + 0);
    LAS bf16* rhsT = (LAS bf16*)(F.lds + 36864);
    LAS bf16* kdT = (LAS bf16*)(F.lds + 73728);
    LAS bf16* Tm = (LAS bf16*)(F.lds + 92160);
    LAS float* Lm = (LAS float*)(F.lds + 101376);
    LAS float* gb = (LAS float*)(F.lds + 118784);
    const bf16* proj = (const bf16*)(F.ws + WS_PROJ); const float* g16 = (const float*)(F.ws + WS_G16); const float* cw = F.in[I_DNCONV];
    bf16* gMp = (bf16*)(F.ws + WS_DN_MP) + (size_t)ch * 16384; float* gUT = (float*)(F.ws + WS_DN_UT) + (size_t)ch * 16384;
    bf16* gKC = (bf16*)(F.ws + WS_DN_KC) + (size_t)ch * 8192; bf16* gWT = (bf16*)(F.ws + WS_DN_WT) + (size_t)ch * 8192;
    bf16* gQD = (bf16*)(F.ws + WS_DN_QD) + (size_t)ch * 8192; bf16* gQK = (bf16*)(F.ws + WS_DN_QK) + (size_t)ch * 4096;
    const int lane = F.lane, w = F.wave, r = lane & 15, q4 = (lane >> 4) * 4;
    __syncthreads();
    if (w == 0) {
        const float* g = g16 + (row0 + lane) * 16;
        const float be = sigmoidf_(g[h]); float G = -__expf(F.in[I_DNALOG][h]) * softplusf_(g[4 + h] + F.in[I_DNDT][h]);
#pragma unroll
        for (int o = 1; o < 64; o <<= 1) { const float v = __shfl_up(G, o); if (lane >= o) G += v; }
        const float Gl = __shfl(G, 63);
        gb[lane] = be; gb[64 + lane] = G; gb[128 + lane] = __expf(G); gb[192 + lane] = __expf(Gl - G);
        if (lane == 0) ((float*)(F.ws + WS_DN_SD))[ch] = __expf(Gl);
    }
    __syncthreads();
#pragma unroll 1
    for (int it = 0; it < 6; ++it) {
        const int which = it >> 1, item = (it & 1) * 512 + F.tid, i = item >> 4, cg = item & 15, col = which * 512 + h * 128 + cg * 8;
        float y[8];
#pragma unroll
        for (int j = 0; j < 8; ++j) y[j] = 0.f;
#pragma unroll
        for (int j = 0; j < 4; ++j) { const int tt = n * 64 + i - 3 + j;
            if (tt >= 0) { const v4u raw = *(const v4u*)(proj + ((size_t)b * SEQ + tt) * NMAIN + col);
                const f32x4 w0 = *(const f32x4*)(cw + j * 1536 + col), w1 = *(const f32x4*)(cw + j * 1536 + col + 4);
                y[0] += bf2f(raw.x & 0xffff) * w0.x; y[1] += bf2f(raw.x >> 16) * w0.y; y[2] += bf2f(raw.y & 0xffff) * w0.z; y[3] += bf2f(raw.y >> 16) * w0.w;
                y[4] += bf2f(raw.z & 0xffff) * w1.x; y[5] += bf2f(raw.z >> 16) * w1.y; y[6] += bf2f(raw.w & 0xffff) * w1.z; y[7] += bf2f(raw.w >> 16) * w1.w; } }
        float ss = 0.f;
#pragma unroll
        for (int j = 0; j < 8; ++j) { y[j] = siluf_(y[j]); ss += y[j] * y[j]; }
        ss += __shfl_xor(ss, 1); ss += __shfl_xor(ss, 2); ss += __shfl_xor(ss, 4); ss += __shfl_xor(ss, 8);
        const float be = gb[i], eG = gb[128 + i], kds = gb[192 + i];
        if (which == 0) { const float sc = rsqrtf(ss + EPS) * 0.08838834764831845f;
            v4u o; o.x = pk2(y[0] * sc, y[1] * sc); o.y = pk2(y[2] * sc, y[3] * sc); o.z = pk2(y[4] * sc, y[5] * sc); o.w = pk2(y[6] * sc, y[7] * sc);
            *(LAS v4u*)(qN + i * 136 + cg * 8) = o;
            const float s2 = sc * eG; v4u o2; o2.x = pk2(y[0] * s2, y[1] * s2); o2.y = pk2(y[2] * s2, y[3] * s2); o2.z = pk2(y[4] * s2, y[5] * s2); o2.w = pk2(y[6] * s2, y[7] * s2);
            *(v4u*)(gQD + i * 128 + cg * 8) = o2;
        } else if (which == 1) { const float sc = rsqrtf(ss + EPS);
            v4u o; o.x = pk2(y[0] * sc, y[1] * sc); o.y = pk2(y[2] * sc, y[3] * sc); o.z = pk2(y[4] * sc, y[5] * sc); o.w = pk2(y[6] * sc, y[7] * sc);
            *(LAS v4u*)(kN + i * 136 + cg * 8) = o;
            const float s1 = sc * be * eG, s2 = sc * kds;
#pragma unroll
            for (int j = 0; j < 8; ++j) { rhsT[(128 + cg * 8 + j) * 72 + i] = (bf16)f2bf(y[j] * s1); kdT[(cg * 8 + j) * 72 + i] = (bf16)f2bf(y[j] * s2); }
        } else {
#pragma unroll
            for (int j = 0; j < 8; ++j) rhsT[(cg * 8 + j) * 72 + i] = (bf16)f2bf(y[j] * be);
        }
    }
    __syncthreads();
    for (int t = w; t < 16; t += 8) { const int mt = t >> 2, nt = t & 3;
        const f32x4 a = tile_mma<128>(kN, 136, kN, 136, mt * 16, nt * 16, lane, (f32x4){0.f, 0.f, 0.f, 0.f});
        const int j = nt * 16 + r; const float Gj = gb[64 + j];
#pragma unroll
        for (int x = 0; x < 4; ++x) { const int i = mt * 16 + q4 + x; Lm[i * 68 + j] = (i > j) ? gb[i] * a[x] * __expf(gb[64 + i] - Gj) : 0.f; }
    }
    for (int t = w; t < 16; t += 8) { const int jt = t >> 2, itl = t & 3;
        const f32x4 a = tile_mma<128>(kN, 136, qN, 136, jt * 16, itl * 16, lane, (f32x4){0.f, 0.f, 0.f, 0.f});
        const int i = itl * 16 + r; const float Gi = gb[64 + i]; f32x4 o;
#pragma unroll
        for (int x = 0; x < 4; ++x) { const int j = jt * 16 + q4 + x; o[x] = (j <= i) ? a[x] * __expf(Gi - gb[64 + j]) : 0.f; }
        *(v2u*)(gQK + i * 64 + jt * 16 + q4) = pk4(o);
    }
    __syncthreads();
    if (w == 0) {
        float t[64];
#pragma unroll
        for (int i = 0; i < 64; ++i) {
            float s = (lane == i) ? 1.f : 0.f;
#pragma unroll
            for (int j4 = 0; j4 < (i + 3) / 4; ++j4) { const f32x4 l = *(const LAS f32x4*)(Lm + i * 68 + j4 * 4);
                if (j4 * 4 + 0 < i) s -= l.x * t[j4 * 4 + 0]; if (j4 * 4 + 1 < i) s -= l.y * t[j4 * 4 + 1]; if (j4 * 4 + 2 < i) s -= l.z * t[j4 * 4 + 2]; if (j4 * 4 + 3 < i) s -= l.w * t[j4 * 4 + 3]; }
            t[i] = s; Tm[i * 72 + lane] = (bf16)f2bf(s);
        }
    }
    __syncthreads();
    for (int t = w; t < 64; t += 8) { const int mt = t & 3, nt = t >> 2;
        const f32x4 a = tile_mma<64>(Tm, 72, rhsT, 72, mt * 16, nt * 16, lane, (f32x4){0.f, 0.f, 0.f, 0.f});
        *(LAS v2u*)(solT + (nt * 16 + r) * 72 + mt * 16 + q4) = pk4(a);
    }
    for (int t = w; t < 32; t += 8) { const int mt = t & 7, nt = t >> 3;
        const f32x4 a = tile_mma<64>(rhsT + 128 * 72, 72, Tm, 72, mt * 16, nt * 16, lane, (f32x4){0.f, 0.f, 0.f, 0.f});
        *(v2u*)(gKC + (nt * 16 + r) * 128 + mt * 16 + q4) = pk4(a);
    }
    __syncthreads();
    for (int t = w; t < 64; t += 8) { const int mt = t & 7, nt = t >> 3;
        f32x4 a = tile_mma<64>(solT + 128 * 72, 72, kdT, 72, mt * 16, nt * 16, lane, (f32x4){0.f, 0.f, 0.f, 0.f});
        a = -a; *(v2u*)(gMp + (nt * 16 + r) * 128 + mt * 16 + q4) = pk4(a);
    }
    for (int t = w; t < 64; t += 8) { const int mt = t & 7, nt = t >> 3;
        const f32x4 a = tile_mma<64>(kdT, 72, solT, 72, mt * 16, nt * 16, lane, (f32x4){0.f, 0.f, 0.f, 0.f});
        *(f32x4*)(gUT + (nt * 16 + r) * 128 + mt * 16 + q4) = a;
    }
    for (int c = F.tid; c < 1024; c += NTHR) { const int row = c >> 3, pc = c & 7; *(v4u*)(gWT + row * 64 + pc * 8) = *(const LAS v4u*)(solT + row * 72 + pc * 8); }
}

#define DNS_LOAD(MR, UR, nn) do { const bf16* m1_ = gMp + (size_t)(nn) * 16384; const float* u1_ = gUT + (size_t)(nn) * 16384; \
    _Pragma("unroll") for (int x = 0; x < 4; ++x) { const int c = F.tid + 512 * x, row = c >> 4, pc = c & 15; MR[x] = *(const v4u*)(m1_ + row * 128 + pc * 8); } \
    _Pragma("unroll") for (int j = 0; j < 4; ++j) UR[j] = *(const f32x4*)(u1_ + (c0 + 16 * j + r) * 128 + 16 * w + q4); } while (0)
#define DNS_STEP(nn, MRc, URc, MRo, URo) do { \
    if ((nn) + 2 < 64) DNS_LOAD(MRo, URo, (nn) + 2); \
    const LAS bf16* STc = ST + ((nn) & 1) * (64 * 136); const LAS bf16* MPc = MP + ((nn) & 1) * (128 * 136); \
    LAS bf16* STn = ST + (((nn) + 1) & 1) * (64 * 136); LAS bf16* MPn = MP + (((nn) + 1) & 1) * (128 * 136); \
    const float sd = sdl[(nn)]; bf16x8_t a_[4]; \
    _Pragma("unroll") for (int s_ = 0; s_ < 4; ++s_) a_[s_] = *(const LAS bf16x8_t*)(MPc + (16 * w + r) * 136 + kq + 32 * s_); \
    _Pragma("unroll") for (int j = 0; j < 4; ++j) acc[j] = acc[j] * sd + u[j]; \
    _Pragma("unroll") for (int s_ = 0; s_ < 4; ++s_) { _Pragma("unroll") for (int j = 0; j < 4; ++j) { const bf16x8_t bb = *(const LAS bf16x8_t*)(STc + (16 * j + r) * 136 + kq + 32 * s_); \
        acc[j] = __builtin_amdgcn_mfma_f32_16x16x32_bf16(a_[s_], bb, acc[j], 0, 0, 0); } } \
    if ((nn) + 1 < 64) { bf16* gs = gST + (size_t)((nn) + 1) * 16384; \
        _Pragma("unroll") for (int j = 0; j < 4; ++j) { const v2u pv = pk4(acc[j]); *(LAS v2u*)(STn + (16 * j + r) * 136 + 16 * w + q4) = pv; *(v2u*)(gs + (c0 + 16 * j + r) * 128 + 16 * w + q4) = pv; } \
        _Pragma("unroll") for (int x = 0; x < 4; ++x) { const int c = F.tid + 512 * x, row = c >> 4, pc = c & 15; *(LAS v4u*)(MPn + row * 136 + pc * 8) = MRc[x]; } \
        _Pragma("unroll") for (int j = 0; j < 4; ++j) u[j] = URc[j]; } \
    __syncthreads(); } while (0)
__device__ __forceinline__ void dn_scan(Frame& F, int bh, int half) {
    LAS bf16* ST = (LAS bf16*)(F.lds);
    LAS bf16* MP = (LAS bf16*)(F.lds + 34816);
    LAS float* sdl = (LAS float*)(F.lds + 104448);
    const int ch0 = bh * 64, c0 = half * 64, lane = F.lane, w = F.wave, r = lane & 15, q4 = (lane >> 4) * 4, kq = (lane >> 4) * 8;
    const bf16* gMp = (const bf16*)(F.ws + WS_DN_MP) + (size_t)ch0 * 16384; const float* gUT = (const float*)(F.ws + WS_DN_UT) + (size_t)ch0 * 16384;
    bf16* gST = (bf16*)(F.ws + WS_DN_ST) + (size_t)ch0 * 16384;
    __syncthreads();
    for (int i = F.tid; i < 64 * 136 / 2; i += NTHR) ((LAS unsigned*)ST)[i] = 0u;
    for (int c = F.tid; c < 1024; c += NTHR) { const int row = c >> 4, pc = c & 15; *(v4u*)(gST + (c0 + row) * 128 + pc * 8) = (v4u){0u, 0u, 0u, 0u}; }
    if (F.tid < 64) sdl[F.tid] = ((const float*)(F.ws + WS_DN_SD))[ch0 + F.tid];
    v4u mA[4], mB[4]; f32x4 uA[4], uB[4], u[4], acc[4];
    DNS_LOAD(mA, u, 0);
#pragma unroll
    for (int x = 0; x < 4; ++x) { const int c = F.tid + 512 * x, row = c >> 4, pc = c & 15; *(LAS v4u*)(MP + row * 136 + pc * 8) = mA[x]; }
#pragma unroll
    for (int j = 0; j < 4; ++j) acc[j] = (f32x4){0.f, 0.f, 0.f, 0.f};
    DNS_LOAD(mA, uA, 1);
    __syncthreads();
#pragma unroll 1
    for (int n = 0; n < 64; n += 2) {
        DNS_STEP(n, mA, uA, mB, uB);
        DNS_STEP(n + 1, mB, uB, mA, uA);
    }
}

__device__ __forceinline__ void dn_out(Frame& F, int ch) {
    const int bh = ch >> 6, n = ch & 63, b = bh >> 2, h = bh & 3;
    const size_t row0 = (size_t)b * SEQ + n * 64;
    LAS bf16* kc = (LAS bf16*)(F.lds + 0);
    LAS bf16* wT = (LAS bf16*)(F.lds + 17408);
    LAS float* ob = (LAS float*)(F.lds + 0);
    LAS bf16* qd = (LAS bf16*)(F.lds + 35840);
    LAS bf16* qk = (LAS bf16*)(F.lds + 53248);
    LAS bf16* ST = (LAS bf16*)(F.lds + 62464);
    LAS bf16* vnT = (LAS bf16*)(F.lds + 97280);
    const bf16* gKC = (const bf16*)(F.ws + WS_DN_KC) + (size_t)ch * 8192; const bf16* gWT = (const bf16*)(F.ws + WS_DN_WT) + (size_t)ch * 8192;
    const bf16* gQD = (const bf16*)(F.ws + WS_DN_QD) + (size_t)ch * 8192; const bf16* gQK = (const bf16*)(F.ws + WS_DN_QK) + (size_t)ch * 4096;
    const bf16* gST = (const bf16*)(F.ws + WS_DN_ST) + (size_t)ch * 16384;
    const int lane = F.lane, w = F.wave, r = lane & 15, q4 = (lane >> 4) * 4;
    __syncthreads();
    for (int c = F.tid; c < 1024; c += NTHR) { const int row = c >> 4, pc = c & 15; *(LAS v4u*)(kc + row * 136 + pc * 8) = *(const v4u*)(gKC + row * 128 + pc * 8); *(LAS v4u*)(qd + row * 136 + pc * 8) = *(const v4u*)(gQD + row * 128 + pc * 8); }
    for (int c = F.tid; c < 2048; c += NTHR) { const int row = c >> 4, pc = c & 15; *(LAS v4u*)(ST + row * 136 + pc * 8) = *(const v4u*)(gST + row * 128 + pc * 8); }
    for (int c = F.tid; c < 1024; c += NTHR) { const int row = c >> 3, pc = c & 7; *(LAS v4u*)(wT + row * 72 + pc * 8) = *(const v4u*)(gWT + row * 64 + pc * 8); }
    { const int c = F.tid, row = c >> 3, pc = c & 7; *(LAS v4u*)(qk + row * 72 + pc * 8) = *(const v4u*)(gQK + row * 64 + pc * 8); }
    __syncthreads();
    for (int t = w; t < 32; t += 8) { const int mt = t & 3, nt = t >> 2;
        const f32x4 a = tile_mma<128>(kc, 136, ST, 136, mt * 16, nt * 16, lane, (f32x4){0.f, 0.f, 0.f, 0.f});
        const int e = nt * 16 + r; const v2u wv = *(const LAS v2u*)(wT + e * 72 + mt * 16 + q4);
        f32x4 vn; vn.x = bf2f(wv.x & 0xffff) - a.x; vn.y = bf2f(wv.x >> 16) - a.y; vn.z = bf2f(wv.y & 0xffff) - a.z; vn.w = bf2f(wv.y >> 16) - a.w;
        *(LAS v2u*)(vnT + e * 72 + mt * 16 + q4) = pk4(vn);
    }
    __syncthreads();
    for (int t = w; t < 32; t += 8) { const int mt = t & 3, nt = t >> 2;
        f32x4 a = tile_mma<128>(qd, 136, ST, 136, mt * 16, nt * 16, lane, (f32x4){0.f, 0.f, 0.f, 0.f});
        a = tile_mma<64>(qk, 72, vnT, 72, mt * 16, nt * 16, lane, a);
        const int e = nt * 16 + r;
#pragma unroll
        for (int x = 0; x < 4; ++x) ob[(mt * 16 + q4 + x) * 132 + e] = a[x];
    }
    __syncthreads();
    const bf16* proj = (const bf16*)(F.ws + WS_PROJ); bf16* mix = (bf16*)(F.ws + WS_MIX); const float* dnn = F.in[I_DNNORM];
    for (int rr = 0; rr < 8; ++rr) { const int i = w * 8 + rr;
        const float o0 = ob[i * 132 + 2 * lane], o1 = ob[i * 132 + 2 * lane + 1];
        const float rstd = rsqrtf(wave_sum(o0 * o0 + o1 * o1) * (1.f / 128.f) + EPS);
        const unsigned z = *(const unsigned*)(proj + (row0 + i) * NMAIN + MC_DNZ + h * 128 + 2 * lane);
        const float y0 = o0 * rstd * dnn[2 * lane] * siluf_(bf2f(z & 0xffff)), y1 = o1 * rstd * dnn[2 * lane + 1] * siluf_(bf2f(z >> 16));
        *(unsigned*)(mix + (row0 + i) * D + h * 128 + 2 * lane) = pk2(y0, y1);
    }
}

__device__ __forceinline__ void ml_prep(Frame& F, int ch) {
    const int bh = ch >> 6, n = ch & 63, b = bh >> 2, h = bh & 3;
    const size_t row0 = (size_t)b * SEQ + n * 64;
    LAS bf16* kwT = (LAS bf16*)(F.lds + 0);
    LAS bf16* vT = (LAS bf16*)(F.lds + 9216);
    LAS float* gsc = (LAS float*)(F.lds + 27648);
    const bf16* proj = (const bf16*)(F.ws + WS_PROJ); const float* g16 = (const float*)(F.ws + WS_G16); const float* cw = F.in[I_MLCONV];
    float* gUp = (float*)(F.ws + WS_ML_UPT) + (size_t)ch * 8192; bf16* gQC = (bf16*)(F.ws + WS_ML_QC) + (size_t)ch * 4096; bf16* gKC = (bf16*)(F.ws + WS_ML_KC) + (size_t)ch * 4096;
    float* aux = (float*)(F.ws + WS_ML_AUX);
    const int lane = F.lane, w = F.wave, r = lane & 15, q4 = (lane >> 4) * 4;
    __syncthreads();
    if (w == 0) {
        const float* g = g16 + (row0 + lane) * 16;
        const float ip = g[8 + h] + F.in[I_MLIB][h]; float bc = logsigmoidf_(g[12 + h] + F.in[I_MLFB][h]);
#pragma unroll
        for (int o = 1; o < 64; o <<= 1) { const float v = __shfl_up(bc, o); if (lane >= o) bc += v; }
        const float bl = __shfl(bc, 63), ge = bl - bc + ip; float gm = ge;
#pragma unroll
        for (int o = 1; o < 64; o <<= 1) gm = fmaxf(gm, __shfl_xor(gm, o));
        gsc[lane] = __expf(ge - gm);
        if (lane == 0) { aux[131072 + ch * 2] = bl; aux[131072 + ch * 2 + 1] = gm; }
    }
    __syncthreads();
#pragma unroll 1
    for (int it = 0; it < 2; ++it) {
        const int item = it * 512 + F.tid, i = item >> 4, cg = item & 15, isk = cg >> 3, c8 = (cg & 7) * 8, chn = isk * 256 + h * 64 + c8;
        float y[8];
#pragma unroll
        for (int j = 0; j < 8; ++j) y[j] = 0.f;
#pragma unroll
        for (int j = 0; j < 4; ++j) { const int tt = n * 64 + i - 3 + j;
            if (tt >= 0) { const v4u raw = *(const v4u*)(proj + ((size_t)b * SEQ + tt) * NMAIN + MC_MLQ + chn);
                const f32x4 w0 = *(const f32x4*)(cw + j * 512 + chn), w1 = *(const f32x4*)(cw + j * 512 + chn + 4);
                y[0] += bf2f(raw.x & 0xffff) * w0.x; y[1] += bf2f(raw.x >> 16) * w0.y; y[2] += bf2f(raw.y & 0xffff) * w0.z; y[3] += bf2f(raw.y >> 16) * w0.w;
                y[4] += bf2f(raw.z & 0xffff) * w1.x; y[5] += bf2f(raw.z >> 16) * w1.y; y[6] += bf2f(raw.w & 0xffff) * w1.z; y[7] += bf2f(raw.w >> 16) * w1.w; } }
#pragma unroll
        for (int j = 0; j < 8; ++j) y[j] = siluf_(y[j]);
        if (!isk) { v4u o; o.x = pk2(y[0] * 0.125f, y[1] * 0.125f); o.y = pk2(y[2] * 0.125f, y[3] * 0.125f); o.z = pk2(y[4] * 0.125f, y[5] * 0.125f); o.w = pk2(y[6] * 0.125f, y[7] * 0.125f);
            *(v4u*)(gQC + i * 64 + c8) = o; }
        else { v4u o; o.x = pk2(y[0], y[1]); o.y = pk2(y[2], y[3]); o.z = pk2(y[4], y[5]); o.w = pk2(y[6], y[7]); *(v4u*)(gKC + i * 64 + c8) = o;
            const float sc = gsc[i];
#pragma unroll
            for (int j = 0; j < 8; ++j) kwT[(c8 + j) * 72 + i] = (bf16)f2bf(y[j] * sc); }
    }
#pragma unroll 1
    for (int it = 0; it < 2; ++it) {
        const int item = it * 512 + F.tid, i = item >> 4, cg = item & 15;
        const v4u raw = *(const v4u*)(proj + (row0 + i) * NMAIN + MC_MLV + h * 128 + cg * 8);
        LAS bf16* d = vT + (cg * 8) * 72 + i;
        d[0] = (bf16)(raw.x & 0xffff); d[72] = (bf16)(raw.x >> 16); d[144] = (bf16)(raw.y & 0xffff); d[216] = (bf16)(raw.y >> 16);
        d[288] = (bf16)(raw.z & 0xffff); d[360] = (bf16)(raw.z >> 16); d[432] = (bf16)(raw.w & 0xffff); d[504] = (bf16)(raw.w >> 16);
    }
    __syncthreads();
    for (int t = w; t < 32; t += 8) { const int mt = t & 3, nt = t >> 2;
        const f32x4 a = tile_mma<64>(kwT, 72, vT, 72, mt * 16, nt * 16, lane, (f32x4){0.f, 0.f, 0.f, 0.f});
        *(f32x4*)(gUp + (nt * 16 + r) * 64 + mt * 16 + q4) = a;
    }
    if (F.tid < 64) { float s = 0.f; for (int x = 0; x < 64; ++x) s += bf2f(kwT[F.tid * 72 + x]); aux[ch * 64 + F.tid] = s; }
}

__device__ __forceinline__ void ml_scan(Frame& F, int bh) {
    const int ch0 = bh * 64;
    const float* gUp = (const float*)(F.ws + WS_ML_UPT) + (size_t)ch0 * 8192; bf16* gCT = (bf16*)(F.ws + WS_ML_CT) + (size_t)ch0 * 8192;
    float* aux = (float*)(F.ws + WS_ML_AUX);
    LAS float* sl = (LAS float*)F.lds;
    __syncthreads();
    if (F.tid < 128) sl[F.tid] = aux[131072 + ch0 * 2 + F.tid];
    for (int i = F.tid; i < 4096; i += NTHR) sl[128 + i] = aux[ch0 * 64 + i];
    __syncthreads();
    f32x4 C[4], uA[4], uB[4]; float nv = 0.f, m = 0.f;
#pragma unroll
    for (int x = 0; x < 4; ++x) { C[x] = (f32x4){0.f, 0.f, 0.f, 0.f}; uA[x] = *(const f32x4*)(gUp + x * 2048 + F.tid * 4); uB[x] = *(const f32x4*)(gUp + 8192 + x * 2048 + F.tid * 4); }
#define MLS_STEP(nn, UC) do { const int ch = ch0 + (nn); \
        _Pragma("unroll") for (int x = 0; x < 4; ++x) *(v2u*)(gCT + (size_t)(nn) * 8192 + x * 2048 + F.tid * 4) = pk4(C[x]); \
        if (F.tid < 64) aux[65536 + ch * 64 + F.tid] = nv; \
        if (F.tid == 0) aux[133120 + ch] = m; \
        const float bl = sl[2 * (nn)], gm = sl[2 * (nn) + 1]; \
        const float m1 = fmaxf(bl + m, gm), keep = __expf(bl + m - m1), sc = __expf(gm - m1); \
        _Pragma("unroll") for (int x = 0; x < 4; ++x) C[x] = C[x] * keep + UC[x] * sc; \
        nv = nv * keep + sl[128 + (nn) * 64 + (F.tid & 63)] * sc; m = m1; \
        if ((nn) + 2 < 64) { _Pragma("unroll") for (int x = 0; x < 4; ++x) UC[x] = *(const f32x4*)(gUp + (size_t)((nn) + 2) * 8192 + x * 2048 + F.tid * 4); } } while (0)
#pragma unroll 1
    for (int n = 0; n < 64; n += 2) { MLS_STEP(n, uA); MLS_STEP(n + 1, uB); }
#undef MLS_STEP
}

__device__ __forceinline__ void ml_out(Frame& F, int ch) {
    const int bh = ch >> 6, n = ch & 63, b = bh >> 2, h = bh & 3;
    const size_t row0 = (size_t)b * SEQ + n * 64;
    LAS bf16* qI = (LAS bf16*)(F.lds + 0);
    LAS bf16* qS = (LAS bf16*)(F.lds + 9216);
    LAS bf16* kS = (LAS bf16*)(F.lds + 18432);
    LAS bf16* pM = (LAS bf16*)(F.lds + 27648);
    LAS bf16* vT = (LAS bf16*)(F.lds + 36864);
    LAS bf16* cT = (LAS bf16*)(F.lds + 57600);
    LAS float* hb = (LAS float*)(F.lds + 78336);
    LAS float* gg = (LAS float*)(F.lds + 116224);
    const bf16* proj = (const bf16*)(F.ws + WS_PROJ); const float* g16 = (const float*)(F.ws + WS_G16);
    const bf16* gQC = (const bf16*)(F.ws + WS_ML_QC) + (size_t)ch * 4096; const bf16* gKC = (const bf16*)(F.ws + WS_ML_KC) + (size_t)ch * 4096;
    const bf16* gCT = (const bf16*)(F.ws + WS_ML_CT) + (size_t)ch * 8192; const float* aux = (const float*)(F.ws + WS_ML_AUX);
    const int lane = F.lane, w = F.wave, r = lane & 15, q4 = (lane >> 4) * 4;
    __syncthreads();
    if (w == 0) {
        const float* g = g16 + (row0 + lane) * 16;
        const float ip = g[8 + h] + F.in[I_MLIB][h]; float bc = logsigmoidf_(g[12 + h] + F.in[I_MLFB][h]);
#pragma unroll
        for (int o = 1; o < 64; o <<= 1) { const float v = __shfl_up(bc, o); if (lane >= o) bc += v; }
        const float rj = ip - bc; float pm = rj;
#pragma unroll
        for (int o = 1; o < 64; o <<= 1) { const float v = __shfl_up(pm, o); if (lane >= o) pm = fmaxf(pm, v); }
        const float ms = aux[133120 + ch], mt = fmaxf(bc + ms, bc + pm);
        gg[lane] = bc; gg[64 + lane] = rj; gg[128 + lane] = mt; gg[192 + lane] = __expf(bc + ms - mt);
    }
    for (int i = F.tid; i < 16 * 72; i += NTHR) { const bf16 one = (bf16)0x3f80; vT[128 * 72 + i] = (i < 64) ? one : (bf16)0; cT[128 * 72 + i] = (bf16)0; }
    __syncthreads();
    { const int c = F.tid, row = c >> 3, pc = c & 7;
        const v4u qv = *(const v4u*)(gQC + row * 64 + pc * 8); *(LAS v4u*)(qS + row * 72 + pc * 8) = qv; *(LAS v4u*)(kS + row * 72 + pc * 8) = *(const v4u*)(gKC + row * 64 + pc * 8);
        const float in = gg[192 + row]; v4u o;
        o.x = pk2(bf2f(qv.x & 0xffff) * in, bf2f(qv.x >> 16) * in); o.y = pk2(bf2f(qv.y & 0xffff) * in, bf2f(qv.y >> 16) * in);
        o.z = pk2(bf2f(qv.z & 0xffff) * in, bf2f(qv.z >> 16) * in); o.w = pk2(bf2f(qv.w & 0xffff) * in, bf2f(qv.w >> 16) * in);
        *(LAS v4u*)(qI + row * 72 + pc * 8) = o; }
    for (int c = F.tid; c < 1024; c += NTHR) { const int row = c >> 3, pc = c & 7; *(LAS v4u*)(cT + row * 72 + pc * 8) = *(const v4u*)(gCT + row * 64 + pc * 8); }
    if (F.tid < 64) cT[128 * 72 + F.tid] = (bf16)f2bf(aux[65536 + ch * 64 + F.tid]);
#pragma unroll 1
    for (int it = 0; it < 2; ++it) {
        const int item = it * 512 + F.tid, i = item >> 4, cg = item & 15;
        const v4u raw = *(const v4u*)(proj + (row0 + i) * NMAIN + MC_MLV + h * 128 + cg * 8);
        LAS bf16* d = vT + (cg * 8) * 72 + i;
        d[0] = (bf16)(raw.x & 0xffff); d[72] = (bf16)(raw.x >> 16); d[144] = (bf16)(raw.y & 0xffff); d[216] = (bf16)(raw.y >> 16);
        d[288] = (bf16)(raw.z & 0xffff); d[360] = (bf16)(raw.z >> 16); d[432] = (bf16)(raw.w & 0xffff); d[504] = (bf16)(raw.w >> 16);
    }
    __syncthreads();
    for (int t = w; t < 16; t += 8) { const int jt = t >> 2, itl = t & 3;
        const f32x4 a = tile_mma<64>(kS, 72, qS, 72, jt * 16, itl * 16, lane, (f32x4){0.f, 0.f, 0.f, 0.f});
        const int i = itl * 16 + r; const float e0 = gg[i] - gg[128 + i]; f32x4 o;
#pragma unroll
        for (int x = 0; x < 4; ++x) { const int j = jt * 16 + q4 + x; o[x] = (j <= i) ? a[x] * __expf(e0 + gg[64 + j]) : 0.f; }
        *(LAS v2u*)(pM + i * 72 + jt * 16 + q4) = pk4(o);
    }
    __syncthreads();
    for (int t = w; t < 36; t += 8) { const int mt = t & 3, nt = t >> 2;
        f32x4 a = tile_mma<64>(qI, 72, cT, 72, mt * 16, nt * 16, lane, (f32x4){0.f, 0.f, 0.f, 0.f});
        a = tile_mma<64>(pM, 72, vT, 72, mt * 16, nt * 16, lane, a);
        const int e = nt * 16 + r;
#pragma unroll
        for (int x = 0; x < 4; ++x) hb[(mt * 16 + q4 + x) * 148 + e] = a[x];
    }
    __syncthreads();
    bf16* mix = (bf16*)(F.ws + WS_MIX); const float* mln = F.in[I_MLNORM];
    for (int rr = 0; rr < 8; ++rr) { const int i = w * 8 + rr;
        const float dd = fmaxf(fabsf(hb[i * 148 + 128]), __expf(-gg[128 + i]));
        const float o0 = hb[i * 148 + 2 * lane] / dd, o1 = hb[i * 148 + 2 * lane + 1] / dd;
        const float rstd = rsqrtf(wave_sum(o0 * o0 + o1 * o1) * (1.f / 128.f) + EPS);
        const unsigned z = *(const unsigned*)(proj + (row0 + i) * NMAIN + MC_MLO + h * 128 + 2 * lane);
        const float y0 = o0 * rstd * mln[h * 128 + 2 * lane] * sigmoidf_(bf2f(z & 0xffff)), y1 = o1 * rstd * mln[h * 128 + 2 * lane + 1] * sigmoidf_(bf2f(z >> 16));
        *(unsigned*)(mix + (row0 + i) * D + 512 + h * 128 + 2 * lane) = pk2(y0, y1);
    }
}

template <int J0> __device__ __forceinline__ void p4_mixnorm(Frame& F) {
    const float* raw = (const float*)(F.ws + WS_RAW); const bf16* proj = (const bf16*)(F.ws + WS_PROJ); bf16* mix = (bf16*)(F.ws + WS_MIX);
    const float* dnn = F.in[I_DNNORM]; const float* mln = F.in[I_MLNORM];
    const int gw = F.vb * NWAVES + F.wave, NGW = F.G * NWAVES;
    for (int row = gw; row < T; row += NGW) {
        const f32x4* rr = (const f32x4*)(raw + (size_t)row * D) + F.lane;
        v2u* o8 = (v2u*)(mix + (size_t)row * D) + F.lane;
#pragma unroll
        for (int j = J0; j < 4; ++j) {
            f32x4 v = rr[64 * j]; float ss = (v.x * v.x + v.y * v.y) + (v.z * v.z + v.w * v.w);
#pragma unroll
            for (int o = 1; o < 32; o <<= 1) ss += __shfl_xor(ss, o);
            const float rstd = rsqrtf(ss * (1.f / 128.f) + EPS);
            const int k = 256 * j + F.lane * 4;
            f32x4 w, gt;
            if (j < 2) { w = *(const f32x4*)(dnn + (k & 127)); const v2u z = *(const v2u*)(proj + (size_t)row * NMAIN + MC_DNZ + k);
                gt.x = siluf_(bf2f(z.x & 0xffff)); gt.y = siluf_(bf2f(z.x >> 16)); gt.z = siluf_(bf2f(z.y & 0xffff)); gt.w = siluf_(bf2f(z.y >> 16)); }
            else { w = *(const f32x4*)(mln + (k - 512)); const v2u z = *(const v2u*)(proj + (size_t)row * NMAIN + MC_MLO + (k - 512));
                gt.x = sigmoidf_(bf2f(z.x & 0xffff)); gt.y = sigmoidf_(bf2f(z.x >> 16)); gt.z = sigmoidf_(bf2f(z.y & 0xffff)); gt.w = sigmoidf_(bf2f(z.y >> 16)); }
            v = v * rstd * w * gt;
            v2u o; o.x = pk2(v.x, v.y); o.y = pk2(v.z, v.w); o8[64 * j] = o;
        }
    }
}

__device__ __forceinline__ void p6_router(Frame& F, int rep) {
    LAS float* wr = (LAS float*)F.lds;
    LAS float* lg = (LAS float*)(F.lds + L_EXTRA);
    { const char* src = (const char*)(F.ws + WS_WRT);
#pragma unroll
        for (int it = 0; it < 16; ++it) { const int chunk = it * 8 + F.wave;
            __builtin_amdgcn_global_load_lds((const unsigned*)(src + chunk * 1024 + F.lane * 16), (LAS unsigned*)(F.lds + chunk * 1024), 16, 0, 0); }
        asm volatile("s_waitcnt vmcnt(0)" ::: "memory"); }
    __syncthreads();
    const float* x1 = (const float*)(F.ws + WS_X1); const float* nw = F.in[I_NFFN]; const float* mod = (const float*)(F.ws + WS_MOD);
    bf16* h2 = (bf16*)(F.ws + WS_H); const float* br = F.in[I_BR];
    int* tok_e = (int*)(F.ws + WS_TOKE); int* tok_r = (int*)(F.ws + WS_TOKR); float* tok_w = (float*)(F.ws + WS_TOKW); int* slot_tok = (int*)(F.ws + WS_SLOTTOK);
    unsigned* gcnt = (unsigned*)(F.ws + WS_CTL) + CW_CNT;
    if (rep > 0) { tok_e = (int*)(F.ws + WS_RAW); tok_r = tok_e + 65536; tok_w = (float*)(tok_r + 65536); slot_tok = tok_r + 131072; gcnt += 16384 - CW_CNT; }
    for (int blk = F.vb; blk < T / 64; blk += F.G) {
        for (int rr = 0; rr < 8; ++rr) {
            const int lr = F.wave * 8 + rr, row = blk * 64 + lr, b = row / SEQ;
            const f32x4* xr = (const f32x4*)(x1 + (size_t)row * D) + F.lane;
            f32x4 v[4]; float ss = 0.f;
#pragma unroll
            for (int j = 0; j < 4; ++j) { v[j] = xr[64 * j]; ss += (v[j].x * v[j].x + v[j].y * v[j].y) + (v[j].z * v[j].z + v[j].w * v[j].w); }
            const float rstd = rsqrtf(wave_sum(ss) * (1.f / D) + EPS);
            const float* sh = mod + b * 6144 + 3072; const float* sc = sh + 1024;
#pragma unroll
            for (int j = 0; j < 4; ++j) { const int k = 256 * j + F.lane * 4;
                const f32x4 w = *(const f32x4*)(nw + k), s1 = *(const f32x4*)(sc + k), s0 = *(const f32x4*)(sh + k);
                v[j] = (v[j] * rstd * w) * (1.0f + s1) + s0; }
            v2u* o8 = (v2u*)(h2 + (size_t)row * D) + F.lane;
#pragma unroll
            for (int j = 0; j < 4; ++j) { v2u o; o.x = pk2(v[j].x, v[j].y); o.y = pk2(v[j].z, v[j].w); o8[64 * j] = o; }
            float acc[32];
#pragma unroll
            for (int e = 0; e < 32; ++e) { float a = 0.f;
#pragma unroll
                for (int j = 0; j < 4; ++j) { const f32x4 w = *(const LAS f32x4*)(wr + e * 1024 + 256 * j + F.lane * 4); a += (v[j].x * w.x + v[j].y * w.y) + (v[j].z * w.z + v[j].w * w.w); }
                acc[e] = a; if (e & 1) asm volatile("" ::: "memory"); }
            const float r = multi_reduce<32>(acc, F.lane);
            if ((F.lane & 1) == 0) lg[lr * 33 + (F.lane >> 1)] = r + br[F.lane >> 1];
        }
        __syncthreads();
        if (F.wave == 0) {
            const int row = blk * 64 + F.lane;
            float l[32];
#pragma unroll
            for (int e = 0; e < 32; ++e) l[e] = lg[F.lane * 33 + e];
            int te[4]; float tl[4];
#pragma unroll
            for (int k = 0; k < 4; ++k) { float best = -3.0e38f; int bi = 0;
#pragma unroll
                for (int e = 0; e < 32; ++e) { if (l[e] > best) { best = l[e]; bi = e; } }
                te[k] = bi; tl[k] = best;
#pragma unroll
                for (int e = 0; e < 32; ++e) if (e == bi) l[e] = -3.0e38f; }
            float w0 = 1.f, w1 = __expf(tl[1] - tl[0]), w2 = __expf(tl[2] - tl[0]), w3 = __expf(tl[3] - tl[0]); const float inv = 1.f / (w0 + w1 + w2 + w3);
            w0 *= inv; w1 *= inv; w2 *= inv; w3 *= inv;
            int mycount = 0;
#pragma unroll
            for (int k = 0; k < 4; ++k) {
#pragma unroll 1
                for (int e = 0; e < 32; ++e) { const unsigned long long mk = __ballot(te[k] == e); if (F.lane == e) mycount += __popcll(mk); } }
            int base = 0; if (F.lane < 32) base = (int)__hip_atomic_fetch_add(gcnt + 64 * F.lane, (unsigned)mycount, __ATOMIC_RELAXED, __HIP_MEMORY_SCOPE_AGENT);
            int run = 0;
            int rk[4];
#pragma unroll
            for (int k = 0; k < 4; ++k) { rk[k] = 0;
#pragma unroll 1
                for (int e = 0; e < 32; ++e) { const unsigned long long mk = __ballot(te[k] == e);
                    const int be = __shfl(base, e), re = __shfl(run, e);
                    if (te[k] == e) rk[k] = be + re + __popcll(mk & ((1ull << F.lane) - 1ull));
                    if (F.lane == e) run += __popcll(mk); } }
            const float ww[4] = {w0, w1, w2, w3};
#pragma unroll
            for (int k = 0; k < 4; ++k) { tok_e[row * 4 + k] = te[k]; tok_r[row * 4 + k] = rk[k]; tok_w[row * 4 + k] = ww[k]; if (rk[k] < ECAP) slot_tok[te[k] * ECAP + rk[k]] = row; }
        }
        __syncthreads();
    }
}

__device__ __forceinline__ void p9_final(Frame& F) {
    build_expert_tables(F);
    const LAS int* tst = (const LAS int*)(F.lds + L_TST);
    const float* x1 = (const float*)(F.ws + WS_X1); const bf16* y = (const bf16*)(F.ws + WS_Y);
    const float* mod = (const float*)(F.ws + WS_MOD); const float* modf = (const float*)(F.ws + WS_MODF); const float* nf = F.in[I_NFIN];
    const int* tok_e = (const int*)(F.ws + WS_TOKE); const int* tok_r = (const int*)(F.ws + WS_TOKR); const float* tok_w = (const float*)(F.ws + WS_TOKW);
    const int gw = F.vb * NWAVES + F.wave, NGW = F.G * NWAVES;
    for (int row = gw; row < T; row += NGW) {
        const int b = row / SEQ;
        const f32x4* xr = (const f32x4*)(x1 + (size_t)row * D) + F.lane;
        f32x4 v[4], m[4];
#pragma unroll
        for (int j = 0; j < 4; ++j) { v[j] = xr[64 * j]; m[j] = (f32x4){0.f, 0.f, 0.f, 0.f}; }
#pragma unroll
        for (int k = 0; k < 4; ++k) { const int e = tok_e[row * 4 + k], r = tok_r[row * 4 + k]; const float w = tok_w[row * 4 + k];
            const size_t cs = (size_t)tst[e] * 256 + r;
            const v2u* yr = (const v2u*)(y + cs * D) + F.lane;
#pragma unroll
            for (int j = 0; j < 4; ++j) { const v2u z = yr[64 * j];
                m[j].x += w * bf2f(z.x & 0xffff); m[j].y += w * bf2f(z.x >> 16); m[j].z += w * bf2f(z.y & 0xffff); m[j].w += w * bf2f(z.y >> 16); } }
        const float* g2 = mod + b * 6144 + 5120; float ss = 0.f;
#pragma unroll
        for (int j = 0; j < 4; ++j) { const f32x4 g = *(const f32x4*)(g2 + 256 * j + F.lane * 4); v[j] = v[j] + g * m[j];
            ss += (v[j].x * v[j].x + v[j].y * v[j].y) + (v[j].z * v[j].z + v[j].w * v[j].w); }
        const float rstd = rsqrtf(wave_sum(ss) * (1.f / D) + EPS);
        const float* sh = modf + b * 2048; const float* sc = sh + 1024;
        f32x4* orow = (f32x4*)(F.out + (size_t)row * D) + F.lane;
#pragma unroll
        for (int j = 0; j < 4; ++j) { const int k = 256 * j + F.lane * 4;
            const f32x4 w = *(const f32x4*)(nf + k), s1 = *(const f32x4*)(sc + k), s0 = *(const f32x4*)(sh + k);
            orow[64 * j] = (v[j] * rstd * w) * (1.0f + s1) + s0; }
    }
}

constexpr int NPH = 11;
__global__ void __launch_bounds__(NTHR, 2) fwd(Args args) {
    extern __shared__ __attribute__((aligned(16))) unsigned char lds_raw[];
    Frame F;
    F.lds = (LAS unsigned char*)lds_raw; F.ws = args.ws; F.out = args.out;
#pragma unroll
    for (int i = 0; i < 25; ++i) F.in[i] = args.in[i];
    F.tid = threadIdx.x; F.lane = F.tid & 63; F.wave = __builtin_amdgcn_readfirstlane(F.tid >> 6);
    F.G = gridDim.x; F.vb = blockIdx.x;
    for (int u = F.tid; u < (LDS_BYTES - LDSCTL_OFF) / 4; u += NTHR) ((LAS unsigned*)(F.lds + LDSCTL_OFF))[u] = 0u;
    __syncthreads();
    unsigned* ctl = (unsigned*)(F.ws + WS_CTL);
    const int lo = args.ph_lo, hi = args.ph_hi;
    XcdBarrier bar; bar.bar = ctl + CW_BAR; bar.x = 0; bar.st = nullptr;
    if (hi - lo > 1) bar = xcd_barrier_post(ctl + CW_BAR, (volatile LAS unsigned*)(F.lds + L_MISC) + 8);
#ifndef REPMASK
#define REPMASK 0
#endif
#define NREP(k) (((REPMASK >> (k)) & 1) ? 2 : 1)
#ifndef XBARS
#define XBARS 0
#endif
#ifndef PHMASK
#define PHMASK 0x7ff
#endif
#define IN(k) (((PHMASK >> (k)) & 1) && lo <= (k) && (k) < hi)
#define SEAM(k) do { if (IN(k) && IN((k) + 1)) xcd_barrier(bar); } while (0)

    if (IN(0)) _Pragma("unroll") for (int rep_ = 0; rep_ < NREP(0); ++rep_) { p0_prologue(F); } SEAM(0);
    if (IN(1)) _Pragma("unroll") for (int rep_ = 0; rep_ < NREP(1); ++rep_) { p1_norm1(F); } SEAM(1);
    if (IN(2)) _Pragma("unroll") for (int rep_ = 0; rep_ < NREP(2); ++rep_) {
        pg8::Gemm g{(const bf16*)(F.ws + WS_H), D}; pg8::DenseOrder S; S.init(T, NMAIN, D, (const bf16*)(F.ws + WS_BTIN), F.G, F.vb);
        EpiProj E{(bf16*)(F.ws + WS_PROJ), NMAIN};
        pg8::gemm_phase<EpiProj, pg8::DenseOrder, true, true>(F.lds, g, S, E);
    } SEAM(2);
    if (IN(3)) _Pragma("unroll") for (int rep_ = 0; rep_ < NREP(3); ++rep_) { for (int it = F.vb; it < 2048; it += F.G) { if (it < 1024) dn_prep(F, it); else ml_prep(F, it - 1024); } } SEAM(3);
    if (IN(4)) _Pragma("unroll") for (int rep_ = 0; rep_ < NREP(4); ++rep_) { if (F.vb < 32) dn_scan(F, F.vb >> 1, F.vb & 1); else if (F.vb < 48) ml_scan(F, F.vb - 32); else convert_moe(F, F.vb - 48, F.G - 48); } SEAM(4);
    if (IN(5)) _Pragma("unroll") for (int rep_ = 0; rep_ < NREP(5); ++rep_) { for (int it = F.vb; it < 2048; it += F.G) { if (it < 1024) dn_out(F, it); else ml_out(F, it - 1024); } } SEAM(5);
    if (IN(6)) _Pragma("unroll") for (int rep_ = 0; rep_ < NREP(6); ++rep_) {
        pg8::Gemm g{(const bf16*)(F.ws + WS_MIX), D}; pg8::DenseOrder S; S.init(T, D, D, (const bf16*)(F.ws + WS_BTOUT), F.G, F.vb);
        EpiRes E{F.in[I_X], (float*)(F.ws + WS_X1), (const float*)(F.ws + WS_MOD)};
        pg8::gemm_phase<EpiRes, pg8::DenseOrder, false, true>(F.lds, g, S, E);
    } SEAM(6);
    if (IN(7)) _Pragma("unroll") for (int rep_ = 0; rep_ < NREP(7); ++rep_) { p6_router(F, rep_); } SEAM(7);
    if (IN(8)) _Pragma("unroll") for (int rep_ = 0; rep_ < NREP(8); ++rep_) {
        const int nmt = build_expert_tables(F);
        GroupedOrder<4, 8, true> S; S.G = F.G; S.c = F.vb; S.nmt = nmt; S.K = D; S.tileE = (const LAS int*)(F.lds + L_TILEE); S.tst = (const LAS int*)(F.lds + L_TST); S.cnt = (const LAS int*)(F.lds + L_CNT);
        S.slot_tok = (const int*)(F.ws + WS_SLOTTOK); S.Bt = (const bf16*)(F.ws + WS_BTGU); S.bexp = (size_t)2048 * D;
        pg8::Gemm g{(const bf16*)(F.ws + WS_H), D};
        EpiGU E{(bf16*)(F.ws + WS_ACT), F.in[I_BGU]};
        pg8::gemm_phase<EpiGU, GroupedOrder<4, 8, true>, true, true>(F.lds, g, S, E);
    } SEAM(8);
    if (IN(9)) _Pragma("unroll") for (int rep_ = 0; rep_ < NREP(9); ++rep_) {
        const int nmt = build_expert_tables(F);
        GroupedOrder<8, 4, false> S; S.G = F.G; S.c = F.vb; S.nmt = nmt; S.K = D; S.tileE = (const LAS int*)(F.lds + L_TILEE); S.tst = (const LAS int*)(F.lds + L_TST); S.cnt = (const LAS int*)(F.lds + L_CNT);
        S.slot_tok = nullptr; S.Bt = (const bf16*)(F.ws + WS_BTDN); S.bexp = (size_t)D * D;
        pg8::Gemm g{(const bf16*)(F.ws + WS_ACT), D};
        EpiDown E{(bf16*)(F.ws + WS_Y), F.in[I_BDN]};
        pg8::gemm_phase<EpiDown, GroupedOrder<8, 4, false>, true, true>(F.lds, g, S, E);
    } SEAM(9);
    for (int xb_ = 0; xb_ < XBARS; ++xb_) xcd_barrier(bar);
    if (IN(10)) _Pragma("unroll") for (int rep_ = 0; rep_ < NREP(10); ++rep_) { p9_final(F); }
#undef IN
#undef SEAM
}

extern "C" void kernel_launch(void* const* d_in, const int* in_sizes, int n_in, void* d_out, int out_size, void* d_ws, size_t ws_size, hipStream_t stream) {
    static int grid = 0;
    if (grid == 0) {
        if (n_in != 25 || in_sizes[0] != T * D || out_size != T * D || ws_size < WS_END) { fprintf(stderr, "kernel_launch: unexpected shapes (n_in %d, ws %zu)\n", n_in, ws_size); grid = -1; return; }
        int dev = 0, cus = 0, per_cu = 0;
        if (hipGetDevice(&dev) != hipSuccess || hipDeviceGetAttribute(&cus, hipDeviceAttributeMultiprocessorCount, dev) != hipSuccess) { grid = -1; return; }
        if (hipFuncSetAttribute((const void*)fwd, hipFuncAttributeMaxDynamicSharedMemorySize, LDS_BYTES) != hipSuccess) { fprintf(stderr, "kernel_launch: hipFuncSetAttribute failed\n"); grid = -1; return; }
        if (hipOccupancyMaxActiveBlocksPerMultiprocessor(&per_cu, (const void*)fwd, NTHR, LDS_BYTES) != hipSuccess || per_cu < 1) { fprintf(stderr, "kernel_launch: occupancy query says %d\n", per_cu); }
        (void)hipGetLastError();
        grid = cus;
    }
    if (grid < 0) return;
    hipMemsetAsync((char*)d_ws + WS_CTL, 0, CTL_ZERO_BYTES, stream);
    Args a{};
    for (int i = 0; i < 25; ++i) a.in[i] = (const float*)d_in[i];
    a.out = (float*)d_out; a.ws = (unsigned char*)d_ws;
#if MK_ONE_LAUNCH
    a.ph_lo = 0; a.ph_hi = NPH;
    hipLaunchKernelGGL(fwd, dim3(grid), dim3(NTHR), LDS_BYTES, stream, a);
#else
    for (int p = 0; p < NPH; ++p) { a.ph_lo = p; a.ph_hi = p + 1; hipLaunchKernelGGL(fwd, dim3(grid), dim3(NTHR), LDS_BYTES, stream, a); }
#endif
}
```

```cpp
#include <hip/hip_runtime.h>
#include <cstdio>
#include <cstdint>

#ifndef TP_A
#define TP_A -1
#endif
#ifndef TP_B
#define TP_B 0
#endif
#ifndef TP_SCALE
#define TP_SCALE 1
#endif
#define STAMP(id, blk) do { if (TP_A >= 0 && (int)blockIdx.x == (blk) && threadIdx.x == 0) ((unsigned long long*)(F.ws + WS_CTL + 131072))[(id)] = wall_clock64(); } while (0)
#ifndef MK_ONE_LAUNCH
#define MK_ONE_LAUNCH 1
#endif

namespace pg8 {
#define PG8_LAS __attribute__((address_space(3)))
typedef unsigned short bf16_t;
typedef short bf16x8 __attribute__((ext_vector_type(8)));
typedef float f32x4 __attribute__((ext_vector_type(4)));
typedef unsigned u32x4 __attribute__((ext_vector_type(4)));
constexpr int BM = 256, BK = 64, HALF = 128, HTB = HALF * BK * 2, STAGE_BYTES = 8 * HTB, NXCD = 8, WGM = 8;

__host__ __device__ __forceinline__ int lds_byte(int r, int c) { const int st = (r >> 4) * 2 + (c >> 5), rr = r & 15, cc = c & 31, ob = rr * 64 + cc * 2; return st * 1024 + (ob ^ (((ob >> 9) & 1) << 5)); }
__host__ __device__ __forceinline__ void stage_rc(int b, int& R, int& C) { const int st = b / 1024, sb = b % 1024, swz = sb ^ (((sb >> 9) & 1) << 5); R = (st >> 1) * 16 + swz / 64; C = (st & 1) * 32 + (swz % 64) / 2; }
__host__ __device__ __forceinline__ int perm32(int rho) { const int n = rho >> 4, i = rho & 15; return 8 * (i >> 2) + 4 * n + (i & 3); }

struct Unit { int pm, pn, e; };
struct Gemm { const bf16_t* A; int K; };

struct DenseOrder {
    int nM, nN, nwg, G, c, K; const bf16_t* Bt;
    __device__ void init(int M, int N, int K_, const bf16_t* Bt_, int G_, int c_) { nM = M / BM; nN = N / BM; nwg = nM * nN; G = G_; c = c_; K = K_; Bt = Bt_; }
    __device__ bool next(int i, Unit& u) const {
        const long L = (long)i * G + c; if (L >= nwg) return false;
        int wgid = (int)L; { const int q = nwg / NXCD, r = nwg % NXCD, xcd = wgid % NXCD, off = wgid / NXCD; wgid = (xcd < r ? xcd * (q + 1) : r * (q + 1) + (xcd - r) * q) + off; }
        const int nig = WGM * nN, gid = wgid / nig, fm = gid * WGM, gsz = (nM - fm) < WGM ? (nM - fm) : WGM;
        u.pm = fm + ((wgid % nig) % gsz); u.pn = (wgid % nig) / gsz; u.e = 0; return true;
    }
    __device__ __forceinline__ void a_voff(const Unit& u, const int (&R)[2], const int (&C)[2], unsigned (&vo)[2][2]) const {
#pragma unroll
        for (int h = 0; h < 2; ++h)
#pragma unroll
            for (int i = 0; i < 2; ++i) vo[h][i] = (unsigned)((u.pm * BM + h * HALF + R[i]) * K + C[i]) * 2u;
    }
    __device__ __forceinline__ void a_raw(const Unit& u, const int (&R)[2], const int (&C)[2], unsigned (&vo)[2][2]) const { a_voff(u, R, C, vo); }
    __device__ __forceinline__ void a_fin(const unsigned (&raw)[2][2], const int (&C)[2], unsigned (&vo)[2][2]) const { vo[0][0] = raw[0][0]; vo[0][1] = raw[0][1]; vo[1][0] = raw[1][0]; vo[1][1] = raw[1][1]; }
    __device__ __forceinline__ const char* b_ptr(const Unit& u) const { return (const char*)Bt + (size_t)u.pn * BM * K * 2; }
};

__device__ __forceinline__ unsigned cvt_pk_bf16(float lo, float hi) { unsigned r; asm volatile("v_cvt_pk_bf16_f32 %0, %1, %2" : "=v"(r) : "v"(lo), "v"(hi)); return r; }

template <class Epi, class Sched, bool ALIGN_EPI = false, bool SP2 = false>
__device__ __forceinline__ void gemm_phase(PG8_LAS unsigned char* lds, const Gemm g, const Sched& S, const Epi& E) {
    const int tid = threadIdx.x, wid = __builtin_amdgcn_readfirstlane(tid >> 6), lane = tid & 63, wr = wid >> 2, wc = wid & 3, fr = lane & 15, fq = lane >> 4;
    const int K = g.K, nt = K / BK;
    int RA[2], CA[2]; unsigned voffB[2];
#pragma unroll
    for (int i = 0; i < 2; ++i) { int R, C; stage_rc(tid * 16 + i * 8192, R, C); const int Rb = Epi::PERM ? ((R & ~31) + perm32(R & 31)) : R;
        RA[i] = R; CA[i] = C; voffB[i] = (unsigned)(Rb * K + C) * 2u; }
    const size_t kstep = (size_t)(BK * 2);
    const size_t hstep = (size_t)HALF * K * 2;
    const unsigned ldsw = (unsigned)wid * 1024u;
    const int aoff = lds_byte(wr * 64 + fr, fq * 8), boff = lds_byte(wc * 32 + fr, fq * 8);
#define PG8_SA(b, h) (((b) * 2 + (h)) * HTB)
#define PG8_SB(b, h) ((4 + (b) * 2 + (h)) * HTB)
#define PG8_STAGE(bufoff, gbase, voff) do { _Pragma("unroll") for (int _i = 0; _i < 2; ++_i) \
        __builtin_amdgcn_global_load_lds((const unsigned*)((const char*)(gbase) + (voff)[_i]), (PG8_LAS unsigned*)(lds + (bufoff) + ldsw + _i * 8192), 16, 0, 0); } while (0)
#define PG8_LDA(dst, b, h) do { _Pragma("unroll") for (int m = 0; m < 4; ++m) _Pragma("unroll") for (int k = 0; k < 2; ++k) dst[m][k] = *(const PG8_LAS bf16x8*)(lds + PG8_SA(b, h) + aoff + m * 2048 + k * 1024); } while (0)
#define PG8_LDB(dst, b, h) do { _Pragma("unroll") for (int n = 0; n < 2; ++n) _Pragma("unroll") for (int k = 0; k < 2; ++k) dst[n][k] = *(const PG8_LAS bf16x8*)(lds + PG8_SB(b, h) + boff + n * 2048 + k * 1024); } while (0)
#define PG8_MMA(ai, bj, At, Bt) do { __builtin_amdgcn_s_setprio(1); _Pragma("unroll") for (int m = 0; m < 4; ++m) _Pragma("unroll") for (int n = 0; n < 2; ++n) _Pragma("unroll") for (int k = 0; k < 2; ++k) \
        acc[ai][bj][m][n] = __builtin_amdgcn_mfma_f32_16x16x32_bf16(Bt[n][k], At[m][k], acc[ai][bj][m][n], 0, 0, 0); __builtin_amdgcn_s_setprio(0); } while (0)
#define PG8_WAIT_V(n) asm volatile("s_waitcnt vmcnt(" #n ")" ::: "memory")
#define PG8_WAIT_L(n) asm volatile("s_waitcnt lgkmcnt(" #n ")" ::: "memory")
#define PG8_BAR __builtin_amdgcn_s_barrier()
#define PG8_SCHED __builtin_amdgcn_sched_barrier(0)
    Unit cur, nxt; int ui = 0;
    if (!S.next(0, cur)) return;
    f32x4 acc[2][2][4][2];
#pragma unroll
    for (int a = 0; a < 2; ++a)
#pragma unroll
        for (int b = 0; b < 2; ++b)
#pragma unroll
            for (int m = 0; m < 4; ++m)
#pragma unroll
                for (int n = 0; n < 2; ++n) acc[a][b][m][n] = (f32x4){0.f, 0.f, 0.f, 0.f};
    bf16x8 At[4][2], B0[2][2], B1[2][2];
    unsigned cvo[2][2], nvo[2][2];
    S.a_voff(cur, RA, CA, cvo);
    const char* const Ab = (const char*)g.A;
    const char* cB = S.b_ptr(cur);
    if constexpr (SP2) {
        PG8_STAGE(PG8_SB(0, 0), cB, voffB); PG8_STAGE(PG8_SB(0, 1), cB + hstep, voffB); PG8_STAGE(PG8_SA(0, 0), Ab, cvo[0]); PG8_STAGE(PG8_SA(0, 1), Ab, cvo[1]);
        if (wr == 1) PG8_BAR;
        PG8_WAIT_V(2); PG8_BAR;
        PG8_STAGE(PG8_SB(1, 0), cB + kstep, voffB); PG8_STAGE(PG8_SA(1, 0), Ab + kstep, cvo[0]); PG8_STAGE(PG8_SB(1, 1), cB + hstep + kstep, voffB);
        PG8_WAIT_V(6); PG8_BAR;
    } else {
        PG8_STAGE(PG8_SB(0, 0), cB, voffB); PG8_STAGE(PG8_SA(0, 0), Ab, cvo[0]); PG8_STAGE(PG8_SB(0, 1), cB + hstep, voffB); PG8_STAGE(PG8_SA(0, 1), Ab, cvo[1]);
        if (wr == 1) PG8_BAR;
        PG8_WAIT_V(4); PG8_BAR;
        PG8_STAGE(PG8_SB(1, 0), cB + kstep, voffB); PG8_STAGE(PG8_SA(1, 0), Ab + kstep, cvo[0]); PG8_STAGE(PG8_SB(1, 1), cB + hstep + kstep, voffB);
        PG8_WAIT_V(6); PG8_BAR;
    }
    for (;;) {
        const bool has_next = S.next(ui + 1, nxt);
        const char* nB = cB;
        unsigned nraw[2][2];
        if (has_next) { nB = S.b_ptr(nxt); S.a_raw(nxt, RA, CA, nraw); }
        else { nraw[0][0] = 0u; nraw[0][1] = 0u; nraw[1][0] = 0u; nraw[1][1] = 0u; }
        for (int t = 0; t < nt; t += 2) {
            const bool last = (t == nt - 2);
            const char* a1 = Ab + (size_t)(t + 1) * kstep;
            const char* a2 = last ? Ab : Ab + (size_t)(t + 2) * kstep; const char* b2 = last ? nB : cB + (size_t)(t + 2) * kstep;
            const char* a3 = a2 + kstep; const char* b3 = b2 + kstep;
            unsigned v2[2][2];
            if (last) { asm volatile("" : "+v"(nraw[0][0]), "+v"(nraw[0][1]), "+v"(nraw[1][0]), "+v"(nraw[1][1]));
                if (has_next) S.a_fin(nraw, CA, nvo); else { nvo[0][0] = cvo[0][0]; nvo[0][1] = cvo[0][1]; nvo[1][0] = cvo[1][0]; nvo[1][1] = cvo[1][1]; }
                v2[0][0] = nvo[0][0]; v2[0][1] = nvo[0][1]; v2[1][0] = nvo[1][0]; v2[1][1] = nvo[1][1]; }
            else { v2[0][0] = cvo[0][0]; v2[0][1] = cvo[0][1]; v2[1][0] = cvo[1][0]; v2[1][1] = cvo[1][1]; }
            if constexpr (SP2) {
            PG8_LDB(B0, 0, 0); PG8_LDB(B1, 0, 1); PG8_SCHED; PG8_LDA(At, 0, 0); PG8_STAGE(PG8_SA(1, 1), a1, cvo[1]);
            PG8_WAIT_V(8); PG8_WAIT_L(0); PG8_BAR; PG8_MMA(0, 0, At, B0); PG8_MMA(0, 1, At, B1); PG8_BAR; PG8_SCHED;
            PG8_LDA(At, 0, 1); PG8_STAGE(PG8_SB(0, 0), b2, voffB); PG8_STAGE(PG8_SB(0, 1), b2 + hstep, voffB); PG8_STAGE(PG8_SA(0, 0), a2, v2[0]);
            PG8_WAIT_V(8); PG8_WAIT_L(0); PG8_BAR; PG8_MMA(1, 0, At, B0); PG8_MMA(1, 1, At, B1); PG8_BAR; PG8_SCHED;
            PG8_LDB(B0, 1, 0); PG8_LDB(B1, 1, 1); PG8_SCHED; PG8_LDA(At, 1, 0); PG8_STAGE(PG8_SA(0, 1), a2, v2[1]);
            PG8_WAIT_V(8); PG8_WAIT_L(0); PG8_BAR; PG8_MMA(0, 0, At, B0); PG8_MMA(0, 1, At, B1); PG8_BAR; PG8_SCHED;
            PG8_LDA(At, 1, 1); PG8_STAGE(PG8_SB(1, 0), b3, voffB); PG8_STAGE(PG8_SB(1, 1), b3 + hstep, voffB); PG8_STAGE(PG8_SA(1, 0), a3, v2[0]);
            PG8_WAIT_V(8); PG8_WAIT_L(0); PG8_BAR; PG8_MMA(1, 0, At, B0); PG8_MMA(1, 1, At, B1); PG8_BAR; PG8_SCHED;
            } else {
            PG8_LDB(B0, 0, 0); PG8_SCHED; PG8_LDA(At, 0, 0); PG8_STAGE(PG8_SA(1, 1), a1, cvo[1]);
            PG8_WAIT_L(8); PG8_BAR; PG8_WAIT_L(0); PG8_MMA(0, 0, At, B0); PG8_BAR; PG8_SCHED;
            PG8_LDB(B1, 0, 1); PG8_STAGE(PG8_SB(0, 0), b2, voffB);
            PG8_BAR; PG8_WAIT_L(0); PG8_MMA(0, 1, At, B1); PG8_BAR;
            PG8_LDA(At, 0, 1); PG8_STAGE(PG8_SA(0, 0), a2, v2[0]);
            PG8_BAR; PG8_WAIT_L(0); PG8_MMA(1, 0, At, B0); PG8_BAR; PG8_SCHED;
            PG8_STAGE(PG8_SB(0, 1), b2 + hstep, voffB);
            PG8_WAIT_V(6); PG8_BAR; PG8_MMA(1, 1, At, B1); PG8_BAR;
            PG8_LDB(B0, 1, 0); PG8_SCHED; PG8_LDA(At, 1, 0); PG8_STAGE(PG8_SA(0, 1), a2, v2[1]);
            PG8_WAIT_L(8); PG8_BAR; PG8_WAIT_L(0); PG8_MMA(0, 0, At, B0); PG8_BAR; PG8_SCHED;
            PG8_LDB(B1, 1, 1); PG8_STAGE(PG8_SB(1, 0), b3, voffB);
            PG8_BAR; PG8_WAIT_L(0); PG8_MMA(0, 1, At, B1); PG8_BAR;
            PG8_LDA(At, 1, 1); PG8_STAGE(PG8_SA(1, 0), a3, v2[0]);
            PG8_BAR; PG8_WAIT_L(0); PG8_MMA(1, 0, At, B0); PG8_BAR; PG8_SCHED;
            PG8_STAGE(PG8_SB(1, 1), b3 + hstep, voffB);
            PG8_WAIT_V(6); PG8_BAR; PG8_MMA(1, 1, At, B1); PG8_BAR;
            }
        }
        if constexpr (ALIGN_EPI) { if (wr == 0) PG8_BAR; }
        E(acc, cur, wr, wc, fr, fq);
        if (!has_next) break;
#pragma unroll
        for (int a = 0; a < 2; ++a)
#pragma unroll
            for (int b = 0; b < 2; ++b)
#pragma unroll
                for (int m = 0; m < 4; ++m)
#pragma unroll
                    for (int n = 0; n < 2; ++n) acc[a][b][m][n] = (f32x4){0.f, 0.f, 0.f, 0.f};
        cur = nxt; cB = nB; ++ui;
        cvo[0][0] = nvo[0][0]; cvo[0][1] = nvo[0][1]; cvo[1][0] = nvo[1][0]; cvo[1][1] = nvo[1][1];
        if constexpr (ALIGN_EPI) { if (wr == 1) PG8_BAR; }
    }
    PG8_WAIT_V(0);
    if constexpr (!ALIGN_EPI) { if (wr == 0) PG8_BAR; }
    PG8_BAR;
#undef PG8_SA
#undef PG8_SB
#undef PG8_STAGE
#undef PG8_LDA
#undef PG8_LDB
#undef PG8_MMA
#undef PG8_WAIT_V
#undef PG8_WAIT_L
#undef PG8_BAR
#undef PG8_SCHED
}
}

constexpr int NWAVES = 8, NTHR = 512;
constexpr int T = 16384, D = 1024, SEQ = 4096, NB = 4;
constexpr int DIN = 3600, NMAIN = 3584;
constexpr int NE = 32, TOPK = 4, ECAP = 16384, MAXMT = 288;
constexpr float EPS = 1e-6f;
constexpr int MC_DNQ = 0, MC_DNK = 512, MC_DNV = 1024, MC_DNZ = 1536, MC_MLQ = 2048, MC_MLK = 2304, MC_MLV = 2560, MC_MLO = 3072;

constexpr size_t MiB = 1u << 20;
constexpr size_t WS_CTL = 0, CTL_ZERO_BYTES = 1 * MiB;
constexpr size_t WS_MOD = 1 * MiB;
constexpr size_t WS_MODF = WS_MOD + 128 * 1024;
constexpr size_t WS_WRT = WS_MOD + 256 * 1024;
constexpr size_t WS_WGT = WS_MOD + 384 * 1024;
constexpr size_t WS_BTIN = 2 * MiB;
constexpr size_t WS_BTOUT = 9 * MiB;
constexpr size_t WS_G16 = 11 * MiB;
constexpr size_t WS_TOKE = 12 * MiB;
constexpr size_t WS_TOKR = WS_TOKE + 256 * 1024;
constexpr size_t WS_TOKW = WS_TOKE + 512 * 1024;
constexpr size_t WS_SLOTTOK = 13 * MiB;
constexpr size_t WS_H = 16 * MiB;
constexpr size_t WS_MIX = 48 * MiB;
constexpr size_t WS_X1 = 80 * MiB;
constexpr size_t WS_BTGU = 144 * MiB;
constexpr size_t WS_BTDN = 272 * MiB;
constexpr size_t WS_PROJ = 336 * MiB;
constexpr size_t WS_RAW = 448 * MiB;
constexpr size_t WS_ACT = 336 * MiB;
constexpr size_t WS_Y = 480 * MiB;
constexpr size_t WS_DN_MP = 512 * MiB;
constexpr size_t WS_DN_UT = 544 * MiB;
constexpr size_t WS_DN_KC = 608 * MiB;
constexpr size_t WS_DN_WT = 624 * MiB;
constexpr size_t WS_DN_QD = 640 * MiB;
constexpr size_t WS_DN_QK = 656 * MiB;
constexpr size_t WS_DN_SD = 664 * MiB;
constexpr size_t WS_DN_ST = 666 * MiB;
constexpr size_t WS_ML_UPT = 698 * MiB;
constexpr size_t WS_ML_QC = 730 * MiB;
constexpr size_t WS_ML_KC = 738 * MiB;
constexpr size_t WS_ML_CT = 746 * MiB;
constexpr size_t WS_ML_AUX = 762 * MiB;
constexpr size_t WS_END = 764 * MiB;
constexpr int CW_BAR = 8192;
constexpr int CW_CNT = 1024;
constexpr int CW_CONV = 4096;

constexpr int RING_BYTES = 131072;
constexpr int LDSCTL_OFF = RING_BYTES;
constexpr int L_MISC = LDSCTL_OFF;
constexpr int L_CNT = LDSCTL_OFF + 256;
constexpr int L_TST = LDSCTL_OFF + 384;
constexpr int L_TILEE = LDSCTL_OFF + 576;
constexpr int L_EXTRA = LDSCTL_OFF + 2048;
constexpr int LDS_BYTES = 147456;

#define LAS __attribute__((address_space(3)))
typedef unsigned short bf16;
typedef unsigned v4u __attribute__((ext_vector_type(4)));
typedef unsigned v2u __attribute__((ext_vector_type(2)));
typedef float f32x4 __attribute__((ext_vector_type(4)));
#define LDS_WAIT() asm volatile("s_waitcnt lgkmcnt(0)" ::: "memory")
#define LDS_BARRIER() do { asm volatile("s_waitcnt lgkmcnt(0)" ::: "memory"); __builtin_amdgcn_s_barrier(); asm volatile("" ::: "memory"); } while (0)
__device__ __forceinline__ unsigned f2bf(float f) { unsigned u = __builtin_bit_cast(unsigned, f); return (u + 0x7fffu + ((u >> 16) & 1u)) >> 16; }
__device__ __forceinline__ unsigned pk2(float lo, float hi) { return f2bf(lo) | (f2bf(hi) << 16); }
__device__ __forceinline__ float bf2f(unsigned short b) { return __builtin_bit_cast(float, ((unsigned)b) << 16); }
__device__ __forceinline__ float sigmoidf_(float x) { return 1.0f / (1.0f + __expf(-x)); }
__device__ __forceinline__ float siluf_(float x) { return x / (1.0f + __expf(-x)); }
__device__ __forceinline__ float softplusf_(float x) { return x > 20.f ? x : log1pf(__expf(x)); }
__device__ __forceinline__ float logsigmoidf_(float x) { return x < 0.f ? x - log1pf(__expf(x)) : -log1pf(__expf(-x)); }

#define XB_TMO      128
#define XB_XCNT(j)  (256  + 64 * (j))
#define XB_XSUB(j)  (1280 + 64 * (j))
#define XB_XGEN(j)  (2304 + 64 * (j))
#define XB_TOP      3328
#define XB_TOPGEN   3392
#define XCD_BAR_WORDS 3456
#define XB_SPIN_CAP (1u << 18)
__device__ __forceinline__ unsigned xb_ld(unsigned* p)              { return __hip_atomic_load(p, __ATOMIC_RELAXED, __HIP_MEMORY_SCOPE_AGENT); }
__device__ __forceinline__ unsigned xb_add(unsigned* p, unsigned v) { return __hip_atomic_fetch_add(p, v, __ATOMIC_RELAXED, __HIP_MEMORY_SCOPE_AGENT); }
__device__ __forceinline__ unsigned xb_xcc_id() { return (unsigned)__builtin_amdgcn_s_getreg((3 << 11) | 20) & 0xFu; }
#define XB_SPIN(cond, bar) do { unsigned _sp = 0; while (cond) { __builtin_amdgcn_s_sleep(1); \
    if ((++_sp & 255u) == 0u) { if (xb_ld(&(bar)[XB_TMO])) break; if (_sp > XB_SPIN_CAP) { atomicAdd(&(bar)[XB_TMO], 1u); break; } } } } while (0)
struct XcdBarrier { unsigned* bar; unsigned x; volatile LAS unsigned* st; };
__device__ __forceinline__ XcdBarrier xcd_barrier_post(unsigned* bar, volatile LAS unsigned* st) {
    XcdBarrier b; b.bar = bar; b.x = xb_xcc_id(); b.st = st;
    if (threadIdx.x == 0) (void)xb_add(&bar[XB_XCNT(b.x)], 1u);
    return b;
}
__device__ __forceinline__ void xcd_barrier_complete(unsigned* bar, unsigned x, unsigned& nloc, unsigned& nx) {
    const unsigned G = gridDim.x * gridDim.y * gridDim.z;
    unsigned sum, cnt, mine, sp = 0u;
    for (;;) {
        sum = 0u; cnt = 0u; mine = 0u;
#pragma unroll
        for (unsigned j = 0; j < 16; ++j) { const unsigned c = xb_ld(&bar[XB_XCNT(j)]); sum += c; cnt += (c > 0u) ? 1u : 0u; mine = (j == x) ? c : mine; }
        if (sum == G) break;
        __builtin_amdgcn_s_sleep(1);
        if ((++sp & 255u) == 0u) { if (xb_ld(&bar[XB_TMO])) break; if (sp > XB_SPIN_CAP) { atomicAdd(&bar[XB_TMO], 1u); break; } }
    }
    nloc = mine > 0u ? mine : 1u; nx = cnt > 0u ? cnt : 1u;
}
__device__ __forceinline__ void xcd_barrier(const XcdBarrier& b) {
    asm volatile("s_waitcnt vmcnt(0)" ::: "memory");
    __syncthreads();
    if (threadIdx.x == 0) {
        unsigned* bar = b.bar;
        __builtin_amdgcn_s_waitcnt(0);
        unsigned nloc = b.st[0], nx = b.st[1];
        if (nloc == 0u) { xcd_barrier_complete(bar, b.x, nloc, nx); b.st[0] = nloc; b.st[1] = nx; }
        const unsigned old = xb_add(&bar[XB_XSUB(b.x)], 1u);
        const unsigned gen = old / nloc;
        if (old + 1u == (gen + 1u) * nloc) {
            __builtin_amdgcn_fence(__ATOMIC_RELEASE, "agent");
            asm volatile("s_waitcnt vmcnt(0)" ::: "memory");
            const unsigned og = xb_add(&bar[XB_TOP], 1u);
            const unsigned tg = og / nx;
            if (og + 1u == (tg + 1u) * nx) xb_add(&bar[XB_TOPGEN], 1u);
            else XB_SPIN(xb_ld(&bar[XB_TOPGEN]) == tg, bar);
            __builtin_amdgcn_fence(__ATOMIC_ACQUIRE, "agent");
            xb_add(&bar[XB_XGEN(b.x)], 1u);
            asm volatile("s_waitcnt vmcnt(0)" ::: "memory");
        } else {
            XB_SPIN(xb_ld(&bar[XB_XGEN(b.x)]) == gen, bar);
            __builtin_amdgcn_fence(__ATOMIC_ACQUIRE, "agent");
            asm volatile("s_waitcnt vmcnt(0)" ::: "memory");
        }
    }
    __syncthreads();
}

struct Args { const float* in[25]; float* out; unsigned char* ws; int ph_lo, ph_hi; };
struct InPtrs { const float* const* p; __device__ __forceinline__ const float* operator[](int i) const { const float* const* q = p; asm volatile("" : "+s"(q)); return q[i]; } };
struct Frame {
    LAS unsigned char* lds; unsigned char* ws; InPtrs in; float* out;
    int tid, lane, wave, vb, G;
};
enum { I_X = 0, I_C, I_WADA, I_BADA, I_NMIX, I_WIN, I_DNCONV, I_DNALOG, I_DNDT, I_DNNORM, I_MLCONV, I_MLIB, I_MLFB, I_MLNORM, I_WOUT, I_NFFN, I_WR, I_BR, I_WGU, I_BGU, I_WDN, I_BDN, I_WADAF, I_BADAF, I_NFIN };

__device__ __forceinline__ float wave_sum(float v) {
#pragma unroll
    for (int o = 1; o < 64; o <<= 1) v += __shfl_xor(v, o);
    return v;
}

__device__ __forceinline__ void transpose_item(const float* W, int ldw, int K, bf16* WT, int k0, int src_n0, int dst_n0, LAS float* scr, int lane) {
    float tv[32];
#pragma unroll
    for (int i = 0; i < 32; ++i) { const int kk = 2 * i + (lane >> 5); tv[i] = W[(size_t)(k0 + kk) * ldw + src_n0 + (lane & 31)]; }
#pragma unroll
    for (int i = 0; i < 32; ++i) { const int kk = 2 * i + (lane >> 5); scr[kk * 33 + (lane & 31)] = tv[i]; }
    LDS_WAIT(); asm volatile("" ::: "memory");
    const int c = lane & 7;
#pragma unroll
    for (int j = 0; j < 4; ++j) { const int n = (lane >> 3) + 8 * j; const LAS float* s = scr + (8 * c) * 33 + n;
        v4u o; o.x = pk2(s[0 * 33], s[1 * 33]); o.y = pk2(s[2 * 33], s[3 * 33]); o.z = pk2(s[4 * 33], s[5 * 33]); o.w = pk2(s[6 * 33], s[7 * 33]);
        *(v4u*)(WT + (size_t)(dst_n0 + n) * K + k0 + 8 * c) = o; }
    LDS_WAIT(); asm volatile("" ::: "memory");
}
__device__ __forceinline__ void p0_prologue(Frame& F) {
    __syncthreads();
    {
        LAS float* cond = (LAS float*)F.lds;
        LAS float* part = (LAS float*)(F.lds + 16384);
        const float* c = F.in[I_C];
        for (int i = F.tid; i < NB * D; i += NTHR) cond[i] = siluf_(c[i]);
        __syncthreads();
        for (int cb = F.vb; cb < 256; cb += F.G) {
            const int j0 = cb * 32; const bool fin = j0 >= 6144;
            const float* W = fin ? F.in[I_WADAF] : F.in[I_WADA]; const int ld = fin ? 2048 : 6144; const int jc = fin ? j0 - 6144 : j0;
            const float* bias = fin ? F.in[I_BADAF] : F.in[I_BADA];
            float* out = fin ? (float*)(F.ws + WS_MODF) : (float*)(F.ws + WS_MOD);
            const int s = F.tid >> 5, jj = F.tid & 31;
            float a0 = 0.f, a1 = 0.f, a2 = 0.f, a3 = 0.f;
            for (int k = s * 64; k < s * 64 + 64; ++k) { const float w = W[(size_t)k * ld + jc + jj]; a0 += cond[k] * w; a1 += cond[1024 + k] * w; a2 += cond[2048 + k] * w; a3 += cond[3072 + k] * w; }
            part[(s * 4 + 0) * 32 + jj] = a0; part[(s * 4 + 1) * 32 + jj] = a1; part[(s * 4 + 2) * 32 + jj] = a2; part[(s * 4 + 3) * 32 + jj] = a3;
            __syncthreads();
            if (F.tid < 128) { const int b = F.tid >> 5, j = F.tid & 31; float sum = 0.f;
                for (int q = 0; q < 16; ++q) sum += part[(q * 4 + b) * 32 + j];
                out[b * ld + jc + j] = sum + bias[jc + j]; }
            __syncthreads();
        }
    }
    {
        const int gt = F.vb * NTHR + F.tid, NGT = F.G * NTHR;
        float* wrT = (float*)(F.ws + WS_WRT); const float* wr = F.in[I_WR];
        for (int i = gt; i < NE * D; i += NGT) { const int e = i >> 10, k = i & 1023; wrT[i] = wr[k * NE + e]; }
        float* wgT = (float*)(F.ws + WS_WGT); const float* win = F.in[I_WIN];
        for (int i = gt; i < 16 * D; i += NGT) { const int g = i >> 10, k = i & 1023; const int col = g < 8 ? 2048 + g : 3592 + (g - 8); wgT[i] = win[(size_t)k * DIN + col]; }
    }
    {
        LAS float* scr = (LAS float*)(F.lds + F.wave * 16384);
        const int gw = F.vb * NWAVES + F.wave, NGW = F.G * NWAVES;
        constexpr int I_IN = 16 * (NMAIN / 32), I_OUT = 16 * 32;
        for (int it = gw; it < I_IN + I_OUT; it += NGW) {
            int r = it;
            if (r < I_IN) { const int nblk = NMAIN / 32, kb = r / nblk, nb = r % nblk; const int dn0 = nb * 32, sn0 = dn0 < 2048 ? dn0 : dn0 + 8;
                transpose_item(F.in[I_WIN], DIN, D, (bf16*)(F.ws + WS_BTIN), kb * 64, sn0, dn0, scr, F.lane); continue; }
            r -= I_IN;
            { const int kb = r / 32, nb = r % 32; transpose_item(F.in[I_WOUT], D, D, (bf16*)(F.ws + WS_BTOUT), kb * 64, nb * 32, nb * 32, scr, F.lane); }
        }
    }
}
__device__ __forceinline__ void convert_moe(Frame& F) {
    LAS float* scr = (LAS float*)(F.lds + F.wave * 16384);
    volatile LAS int* claim = (volatile LAS int*)(F.lds + L_MISC) + 16;
    unsigned* ctr = (unsigned*)(F.ws + WS_CTL) + CW_CONV;
    constexpr int I_GU1 = 16 * 64, I_DN1 = 16 * 32, NITEMS = NE * (I_GU1 + I_DN1);
    for (;;) {
        __syncthreads();
        if (F.tid == 0) claim[0] = (int)__hip_atomic_fetch_add(ctr, 64u, __ATOMIC_RELAXED, __HIP_MEMORY_SCOPE_AGENT);
        __syncthreads();
        const int base = claim[0];
        if (base >= NITEMS) break;
#pragma unroll 1
        for (int q8 = 0; q8 < 8; ++q8) {
            int r = base + q8 * 8 + F.wave;
            if (r < NE * I_GU1) { const int e = r / I_GU1, q = r % I_GU1, kb = q / 64, nb = q % 64; const int dn0 = nb * 32;
                const int sn0 = ((dn0 & 255) >> 7) * 1024 + (dn0 >> 8) * 128 + (dn0 & 127);
                transpose_item(F.in[I_WGU] + (size_t)e * D * 2048, 2048, D, (bf16*)(F.ws + WS_BTGU) + (size_t)e * 2048 * D, kb * 64, sn0, dn0, scr, F.lane); continue; }
            r -= NE * I_GU1;
            { const int e = r / I_DN1, q = r % I_DN1, kb = q / 32, nb = q % 32;
                transpose_item(F.in[I_WDN] + (size_t)e * D * D, D, D, (bf16*)(F.ws + WS_BTDN) + (size_t)e * D * D, kb * 64, nb * 32, nb * 32, scr, F.lane); }
        }
    }
}

#define MR_STEP(n, bit) { const bool hi = (lane & (bit)) != 0; _Pragma("unroll") for (int i = 0; i < (n) / 2; ++i) { const float send = hi ? v[i] : v[i + (n) / 2]; const float keep = hi ? v[i + (n) / 2] : v[i]; v[i] = keep + __shfl_xor(send, (bit)); } }
template <int N> __device__ __forceinline__ float multi_reduce(float (&v)[N], int lane) {
    float r;
    if constexpr (N == 32) { MR_STEP(32, 32) MR_STEP(16, 16) MR_STEP(8, 8) MR_STEP(4, 4) MR_STEP(2, 2) r = v[0]; r += __shfl_xor(r, 1); }
    else { MR_STEP(16, 32) MR_STEP(8, 16) MR_STEP(4, 8) MR_STEP(2, 4) r = v[0]; r += __shfl_xor(r, 2); r += __shfl_xor(r, 1); }
    return r;
}

__device__ __forceinline__ void p1_norm1(Frame& F) {
    LAS float* wg = (LAS float*)F.lds;
    { const float* src = (const float*)(F.ws + WS_WGT); for (int i = F.tid; i < 16 * D / 4; i += NTHR) ((LAS f32x4*)wg)[i] = ((const f32x4*)src)[i]; }
    __syncthreads();
    const float* x = F.in[I_X]; const float* nw = F.in[I_NMIX]; const float* mod = (const float*)(F.ws + WS_MOD);
    bf16* h1 = (bf16*)(F.ws + WS_H); float* g16 = (float*)(F.ws + WS_G16);
    const int gw = F.vb * NWAVES + F.wave, NGW = F.G * NWAVES;
    for (int row = gw; row < T; row += NGW) {
        const int b = row / SEQ;
        const f32x4* xr = (const f32x4*)(x + (size_t)row * D) + F.lane;
        f32x4 v[4]; float ss = 0.f;
#pragma unroll
        for (int j = 0; j < 4; ++j) { v[j] = xr[64 * j]; ss += (v[j].x * v[j].x + v[j].y * v[j].y) + (v[j].z * v[j].z + v[j].w * v[j].w); }
        const float rstd = rsqrtf(wave_sum(ss) * (1.f / D) + EPS);
        const float* sh = mod + b * 6144; const float* sc = sh + 1024;
#pragma unroll
        for (int j = 0; j < 4; ++j) { const int k = 256 * j + F.lane * 4;
            const f32x4 w = *(const f32x4*)(nw + k), s1 = *(const f32x4*)(sc + k), s0 = *(const f32x4*)(sh + k);
            v[j] = (v[j] * rstd * w) * (1.0f + s1) + s0; }
        v2u* o8 = (v2u*)(h1 + (size_t)row * D) + F.lane;
#pragma unroll
        for (int j = 0; j < 4; ++j) { v2u o; o.x = pk2(v[j].x, v[j].y); o.y = pk2(v[j].z, v[j].w); o8[64 * j] = o; }
        float acc[16];
#pragma unroll
        for (int g = 0; g < 16; ++g) { float a = 0.f;
#pragma unroll
            for (int j = 0; j < 4; ++j) { const f32x4 w = *(const LAS f32x4*)(wg + g * 1024 + 256 * j + F.lane * 4); a += (v[j].x * w.x + v[j].y * w.y) + (v[j].z * w.z + v[j].w * w.w); }
            acc[g] = a; if (g & 1) asm volatile("" ::: "memory"); }
        const float r = multi_reduce<16>(acc, F.lane);
        if ((F.lane & 3) == 0) g16[(size_t)row * 16 + (F.lane >> 2)] = r;
    }
}

struct EpiProj {
    static constexpr bool PERM = true;
    bf16* O; int ldc;
    __device__ __forceinline__ void operator()(const pg8::f32x4 (&acc)[2][2][4][2], const pg8::Unit& u, int wr, int wc, int fr, int fq) const {
        const int row0 = u.pm * 256 + wr * 64 + fr, col0 = u.pn * 256 + wc * 32 + 8 * fq;
#pragma unroll
        for (int ai = 0; ai < 2; ++ai)
#pragma unroll
            for (int m = 0; m < 4; ++m) { bf16* rowp = O + (size_t)(row0 + ai * 128 + m * 16) * ldc + col0;
#pragma unroll
                for (int bj = 0; bj < 2; ++bj) { const pg8::f32x4 v0 = acc[ai][bj][m][0], v1 = acc[ai][bj][m][1];
                    v4u w; w.x = pg8::cvt_pk_bf16(v0[0], v0[1]); w.y = pg8::cvt_pk_bf16(v0[2], v0[3]); w.z = pg8::cvt_pk_bf16(v1[0], v1[1]); w.w = pg8::cvt_pk_bf16(v1[2], v1[3]);
                    *(v4u*)(rowp + bj * 128) = w; } }
    }
};
struct EpiRes {
    static constexpr bool PERM = false;
    const float* X; float* O; const float* mod;
    __device__ __forceinline__ void operator()(const pg8::f32x4 (&acc)[2][2][4][2], const pg8::Unit& u, int wr, int wc, int fr, int fq) const {
        const int row0 = u.pm * 256 + wr * 64 + fr, col0 = u.pn * 256 + wc * 32 + 4 * fq;
        const int b = (u.pm * 256) / SEQ; const float* g1 = mod + b * 6144 + 2048;
        pg8::f32x4 gv[2][2];
#pragma unroll
        for (int bj = 0; bj < 2; ++bj)
#pragma unroll
            for (int n = 0; n < 2; ++n) gv[bj][n] = *(const pg8::f32x4*)(g1 + col0 + bj * 128 + n * 16);
#pragma unroll
        for (int ai = 0; ai < 2; ++ai)
#pragma unroll
            for (int m = 0; m < 4; ++m) { const size_t off = (size_t)(row0 + ai * 128 + m * 16) * D + col0;
#pragma unroll
                for (int bj = 0; bj < 2; ++bj)
#pragma unroll
                    for (int n = 0; n < 2; ++n) { const pg8::f32x4 xv = *(const pg8::f32x4*)(X + off + bj * 128 + n * 16);
                        *(pg8::f32x4*)(O + off + bj * 128 + n * 16) = xv + gv[bj][n] * acc[ai][bj][m][n]; }
                asm volatile("" ::: "memory"); }
    }
};
struct EpiGU {
    static constexpr bool PERM = true;
    bf16* O; const float* bgu;
    __device__ __forceinline__ void operator()(const pg8::f32x4 (&acc)[2][2][4][2], const pg8::Unit& u, int wr, int wc, int fr, int fq) const {
        const int row0 = u.pm * 256 + wr * 64 + fr, cc = u.pn * 128 + wc * 32 + 8 * fq;
        const float* bg = bgu + (size_t)u.e * 2048 + cc; const float* bu = bg + 1024;
        pg8::f32x4 bgv[2], buv[2];
#pragma unroll
        for (int n = 0; n < 2; ++n) { bgv[n] = *(const pg8::f32x4*)(bg + 4 * n); buv[n] = *(const pg8::f32x4*)(bu + 4 * n); }
#pragma unroll
        for (int ai = 0; ai < 2; ++ai)
#pragma unroll
            for (int m = 0; m < 4; ++m) { bf16* rowp = O + (size_t)(row0 + ai * 128 + m * 16) * D + cc;
                float r[8];
#pragma unroll
                for (int n = 0; n < 2; ++n)
#pragma unroll
                    for (int j = 0; j < 4; ++j) { float gt = acc[ai][0][m][n][j] + bgv[n][j], up = acc[ai][1][m][n][j] + buv[n][j];
                        gt = fminf(gt, 7.0f); up = fminf(fmaxf(up, -7.0f), 7.0f);
                        r[n * 4 + j] = (up + 1.0f) * gt * sigmoidf_(1.702f * gt); }
                v4u w; w.x = pg8::cvt_pk_bf16(r[0], r[1]); w.y = pg8::cvt_pk_bf16(r[2], r[3]); w.z = pg8::cvt_pk_bf16(r[4], r[5]); w.w = pg8::cvt_pk_bf16(r[6], r[7]);
                *(v4u*)rowp = w; }
    }
};
struct EpiDown {
    static constexpr bool PERM = true;
    bf16* O; const float* bdn;
    __device__ __forceinline__ void operator()(const pg8::f32x4 (&acc)[2][2][4][2], const pg8::Unit& u, int wr, int wc, int fr, int fq) const {
        const int row0 = u.pm * 256 + wr * 64 + fr, col0 = u.pn * 256 + wc * 32 + 8 * fq;
        const float* bb = bdn + (size_t)u.e * D + col0;
        pg8::f32x4 bv[2][2];
#pragma unroll
        for (int bj = 0; bj < 2; ++bj)
#pragma unroll
            for (int n = 0; n < 2; ++n) bv[bj][n] = *(const pg8::f32x4*)(bb + bj * 128 + 4 * n);
#pragma unroll
        for (int ai = 0; ai < 2; ++ai)
#pragma unroll
            for (int m = 0; m < 4; ++m) { bf16* rowp = O + (size_t)(row0 + ai * 128 + m * 16) * D + col0;
#pragma unroll
                for (int bj = 0; bj < 2; ++bj) { const pg8::f32x4 v0 = acc[ai][bj][m][0] + bv[bj][0], v1 = acc[ai][bj][m][1] + bv[bj][1];
                    v4u w; w.x = pg8::cvt_pk_bf16(v0[0], v0[1]); w.y = pg8::cvt_pk_bf16(v0[2], v0[3]); w.z = pg8::cvt_pk_bf16(v1[0], v1[1]); w.w = pg8::cvt_pk_bf16(v1[2], v1[3]);
                    *(v4u*)(rowp + bj * 128) = w; } }
    }
};

template <int MB, int NBK, bool GATHER> struct GroupedOrder {
    int G, c, nmt, K; const LAS int* tileE; const LAS int* tst; const LAS int* cnt; const int* slot_tok; const bf16* Bt; size_t bexp; LAS unsigned* tokbuf;
    __device__ bool next(int i, pg8::Unit& u) const {
        const int nwg = nmt * NBK; const long L = (long)i * G + c; if (L >= nwg) return false;
        int U = (int)L; { const int q = nwg / 8, r = nwg % 8, xcd = U % 8, off = U / 8; U = (xcd < r ? xcd * (q + 1) : r * (q + 1) + (xcd - r) * q) + off; }
        const int nig = MB * NBK, gid = U / nig, fm = gid * MB, gsz = (nmt - fm) < MB ? (nmt - fm) : MB;
        u.pm = fm + ((U % nig) % gsz); u.pn = (U % nig) / gsz; u.e = tileE[u.pm]; return true;
    }
    __device__ __forceinline__ void a_voff(const pg8::Unit& u, const int (&R)[2], const int (&C)[2], unsigned (&vo)[2][2]) const {
        if (GATHER) {
            const int r0 = (u.pm - tst[u.e]) * 256, ce = cnt[u.e];
#pragma unroll
            for (int h = 0; h < 2; ++h)
#pragma unroll
                for (int i = 0; i < 2; ++i) { int rk = r0 + h * 128 + R[i]; rk = rk < ce ? rk : ce - 1; const int tok = slot_tok[u.e * ECAP + rk];
                    vo[h][i] = (unsigned)(tok * K + C[i]) * 2u; }
        } else {
#pragma unroll
            for (int h = 0; h < 2; ++h)
#pragma unroll
                for (int i = 0; i < 2; ++i) vo[h][i] = (unsigned)((u.pm * 256 + h * 128 + R[i]) * K + C[i]) * 2u;
        }
    }
    __device__ __forceinline__ void a_raw(const pg8::Unit& u, const int (&R)[2], const int (&C)[2], unsigned (&raw)[2][2]) const {
        if (GATHER) {
            const int r0 = (u.pm - tst[u.e]) * 256, ce = cnt[u.e];
#pragma unroll
            for (int h = 0; h < 2; ++h)
#pragma unroll
                for (int i = 0; i < 2; ++i) { int rk = r0 + h * 128 + R[i]; rk = rk < ce ? rk : ce - 1; raw[h][i] = 0u;
                    __builtin_amdgcn_global_load_lds((const unsigned*)(slot_tok + u.e * ECAP + rk), (LAS unsigned*)(tokbuf + (h * 2 + i) * 64), 4, 0, 0); }
        } else a_voff(u, R, C, raw);
    }
    __device__ __forceinline__ void a_fin(const unsigned (&raw)[2][2], const int (&C)[2], unsigned (&vo)[2][2]) const {
#pragma unroll
        for (int h = 0; h < 2; ++h)
#pragma unroll
            for (int i = 0; i < 2; ++i) vo[h][i] = GATHER ? (tokbuf[(h * 2 + i) * 64 + (threadIdx.x & 63)] * (unsigned)K + (unsigned)C[i]) * 2u : raw[h][i];
    }
    __device__ __forceinline__ const char* b_ptr(const pg8::Unit& u) const { return (const char*)(Bt + (size_t)u.e * bexp + (size_t)u.pn * 256 * K); }
};

__device__ __forceinline__ int build_expert_tables(Frame& F) {
    LAS int* lc = (LAS int*)(F.lds + L_CNT); LAS int* lt = (LAS int*)(F.lds + L_TST); LAS int* le = (LAS int*)(F.lds + L_TILEE);
    const unsigned* gc = (const unsigned*)(F.ws + WS_CTL) + CW_CNT;
    __syncthreads();
    if (F.tid < 64) {
        int c = 0; if (F.lane < NE) { c = (int)__hip_atomic_load(gc + 64 * F.lane, __ATOMIC_RELAXED, __HIP_MEMORY_SCOPE_AGENT); if (c > ECAP) c = ECAP; }
        const int nt = (c + 255) >> 8; int incl = nt;
#pragma unroll
        for (int o = 1; o < 32; o <<= 1) { const int v = __shfl_up(incl, o); if (F.lane >= o) incl += v; }
        const int excl = incl - nt;
        if (F.lane < NE) { lc[F.lane] = c; lt[F.lane] = excl; for (int i = 0; i < nt; ++i) le[excl + i] = F.lane; }
        if (F.lane == NE - 1) lt[NE] = incl;
    }
    __syncthreads();
    return lt[NE];
}

__device__ __forceinline__ void p3_naive_dn(Frame& F, int bh) {
    const int b = bh >> 2, h = bh & 3;
    LAS float* qs_ = (LAS float*)F.lds;
    LAS float* ks_ = qs_ + 64 * 128;
    LAS float* vs_ = ks_ + 64 * 128;
    LAS float* qsc = vs_ + 64 * 128;
    LAS float* ksc = qsc + 64; LAS float* bet = ksc + 64; LAS float* ade = bet + 64;
    const bf16* proj = (const bf16*)(F.ws + WS_PROJ); const float* g16 = (const float*)(F.ws + WS_G16);
    const float* cw = F.in[I_DNCONV]; float* raw = (float*)(F.ws + WS_RAW);
    const float Aexp = __expf(F.in[I_DNALOG][h]), dtb = F.in[I_DNDT][h];
    const int e = F.tid >> 2, ds = F.tid & 3, d0 = ds * 32;
    float S[32];
#pragma unroll
    for (int i = 0; i < 32; ++i) S[i] = 0.f;
    for (int n = 0; n < 64; ++n) {
        __syncthreads();
        for (int idx = F.tid; idx < 64 * 384; idx += NTHR) {
            const int i = idx / 384, c = idx % 384, which = c >> 7, cc = c & 127, col = which * 512 + h * 128 + cc;
            const int t = n * 64 + i; float a = 0.f;
#pragma unroll
            for (int j = 0; j < 4; ++j) { const int tt = t - 3 + j; if (tt >= 0) a += bf2f(proj[(size_t)(b * SEQ + tt) * NMAIN + col]) * cw[j * 1536 + col]; }
            (which == 0 ? qs_ : which == 1 ? ks_ : vs_)[i * 128 + cc] = siluf_(a);
        }
        if (F.tid < 64) { const size_t row = (size_t)b * SEQ + n * 64 + F.tid;
            bet[F.tid] = sigmoidf_(g16[row * 16 + h]); ade[F.tid] = __expf(-Aexp * softplusf_(g16[row * 16 + 4 + h] + dtb)); }
        __syncthreads();
        if (F.tid < 128) { const int i = F.tid & 63, which = F.tid >> 6; const LAS float* p = (which ? ks_ : qs_) + i * 128; float ss = 0.f;
            for (int c = 0; c < 128; ++c) ss += p[c] * p[c];
            const float sc = rsqrtf(ss + EPS); if (which) ksc[i] = sc; else qsc[i] = sc * 0.08838834764831845f; }
        __syncthreads();
        for (int i = 0; i < 64; ++i) {
            const float kscale = ksc[i], qscale = qsc[i], be = bet[i], a = ade[i];
            const LAS float* kp = ks_ + i * 128 + d0; const LAS float* qp = qs_ + i * 128 + d0;
            float kv[32]; float p = 0.f;
#pragma unroll
            for (int d = 0; d < 32; ++d) { kv[d] = kp[d] * kscale; p += kv[d] * S[d]; }
            p += __shfl_xor(p, 1); p += __shfl_xor(p, 2);
            const float uu = be * (vs_[i * 128 + e] - a * p);
            float o = 0.f;
#pragma unroll
            for (int d = 0; d < 32; ++d) { S[d] = a * S[d] + kv[d] * uu; o += qp[d] * S[d]; }
            o *= qscale; o += __shfl_xor(o, 1); o += __shfl_xor(o, 2);
            if (ds == 0) raw[((size_t)b * SEQ + n * 64 + i) * D + h * 128 + e] = o;
        }
    }
}
__device__ __forceinline__ void p3_naive_ml(Frame& F, int bh) {
    const int b = bh >> 2, h = bh & 3;
    LAS float* qs_ = (LAS float*)F.lds;
    LAS float* ks_ = qs_ + 64 * 64;
    LAS float* vs_ = ks_ + 64 * 64;
    LAS float* ipr = vs_ + 64 * 128; LAS float* lgf = ipr + 64;
    const bf16* proj = (const bf16*)(F.ws + WS_PROJ); const float* g16 = (const float*)(F.ws + WS_G16);
    const float* cw = F.in[I_MLCONV]; float* raw = (float*)(F.ws + WS_RAW);
    const float ib = F.in[I_MLIB][h], fb = F.in[I_MLFB][h];
    const int e = F.tid >> 2, ds = F.tid & 3, d0 = ds * 16;
    float C[16], nn[16]; float m = 0.f;
#pragma unroll
    for (int i = 0; i < 16; ++i) { C[i] = 0.f; nn[i] = 0.f; }
    for (int n = 0; n < 64; ++n) {
        __syncthreads();
        for (int idx = F.tid; idx < 64 * 128; idx += NTHR) {
            const int i = idx >> 7, c = idx & 127, which = c >> 6, cc = c & 63, ch = which * 256 + h * 64 + cc;
            const int t = n * 64 + i; float a = 0.f;
#pragma unroll
            for (int j = 0; j < 4; ++j) { const int tt = t - 3 + j; if (tt >= 0) a += bf2f(proj[(size_t)(b * SEQ + tt) * NMAIN + MC_MLQ + ch]) * cw[j * 512 + ch]; }
            const float y = siluf_(a);
            if (which == 0) qs_[i * 64 + cc] = y * 0.125f; else ks_[i * 64 + cc] = y;
        }
        for (int idx = F.tid; idx < 64 * 128; idx += NTHR) { const int i = idx >> 7, c = idx & 127;
            vs_[idx] = bf2f(proj[(size_t)(b * SEQ + n * 64 + i) * NMAIN + MC_MLV + h * 128 + c]); }
        if (F.tid < 64) { const size_t row = (size_t)b * SEQ + n * 64 + F.tid;
            ipr[F.tid] = g16[row * 16 + 8 + h] + ib; lgf[F.tid] = logsigmoidf_(g16[row * 16 + 12 + h] + fb); }
        __syncthreads();
        for (int i = 0; i < 64; ++i) {
            const float lf = lgf[i], ip = ipr[i];
            const float mn = fmaxf(lf + m, ip), fp = __expf(lf + m - mn), iq = __expf(ip - mn); m = mn;
            const LAS float* kp = ks_ + i * 64 + d0; const LAS float* qp = qs_ + i * 64 + d0;
            const float vv = vs_[i * 128 + e] * iq;
            float num = 0.f, den = 0.f;
#pragma unroll
            for (int d = 0; d < 16; ++d) { const float kk = kp[d], qq = qp[d]; C[d] = fp * C[d] + kk * vv; nn[d] = fp * nn[d] + iq * kk; num += qq * C[d]; den += qq * nn[d]; }
            num += __shfl_xor(num, 1); num += __shfl_xor(num, 2); den += __shfl_xor(den, 1); den += __shfl_xor(den, 2);
            const float hh = num / fmaxf(fabsf(den), __expf(-m));
            if (ds == 0) raw[((size_t)b * SEQ + n * 64 + i) * D + 512 + h * 128 + e] = hh;
        }
    }
}

typedef short bf16x8_t __attribute__((ext_vector_type(8)));
template <int K> __device__ __forceinline__ f32x4 tile_mma(const LAS bf16* A, int lda, const LAS bf16* Bt, int ldb, int m0, int n0, int lane, f32x4 acc) {
    const int r = lane & 15, kq = (lane >> 4) * 8;
    const LAS bf16* ap = A + (m0 + r) * lda + kq; const LAS bf16* bp = Bt + (n0 + r) * ldb + kq;
#pragma unroll
    for (int k = 0; k < K; k += 32) { const bf16x8_t a = *(const LAS bf16x8_t*)(ap + k); const bf16x8_t b = *(const LAS bf16x8_t*)(bp + k);
        acc = __builtin_amdgcn_mfma_f32_16x16x32_bf16(a, b, acc, 0, 0, 0); }
    return acc;
}
__device__ __forceinline__ v2u pk4(f32x4 v) { v2u o; o.x = pk2(v.x, v.y); o.y = pk2(v.z, v.w); return o; }

__device__ __forceinline__ void dn_prep(Frame& F, int ch) {
    const int bh = ch >> 6, n = ch & 63, b = bh >> 2, h = bh & 3;
    const size_t row0 = (size_t)b * SEQ + n * 64;
    LAS bf16* kN = (LAS bf16*)(F.lds + 0);
    LAS bf16* qN = (LAS bf16*)(F.lds + 17408);
    LAS bf16* solT = (LAS bf16*)(F.lds + 0);
    LAS bf16* rhsT = (LAS bf16*)(F.lds + 36864);
    LAS bf16* kdT = (LAS bf16*)(F.lds + 73728);
    LAS bf16* Tm = (LAS bf16*)(F.lds + 92160);
    LAS float* Lm = (LAS float*)(F.lds + 101376);
    LAS float* gb = (LAS float*)(F.lds + 118784);
    LAS bf16* vN = (LAS bf16*)(F.lds + 101376);
    LAS float* cwL = (LAS float*)(F.lds + 119808);
    const bf16* proj = (const bf16*)(F.ws + WS_PROJ); const float* g16 = (const float*)(F.ws + WS_G16); const float* cw = F.in[I_DNCONV];
    bf16* gMp = (bf16*)(F.ws + WS_DN_MP) + (size_t)ch * 16384; bf16* gUT = (bf16*)(F.ws + WS_DN_UT) + (size_t)ch * 16384;
    bf16* gKC = (bf16*)(F.ws + WS_DN_KC) + (size_t)ch * 8192; bf16* gWT = (bf16*)(F.ws + WS_DN_WT) + (size_t)ch * 8192;
    bf16* gQD = (bf16*)(F.ws + WS_DN_QD) + (size_t)ch * 8192; bf16* gQK = (bf16*)(F.ws + WS_DN_QK) + (size_t)ch * 4096;
    const int lane = F.lane, w = F.wave, r = lane & 15, q4 = (lane >> 4) * 4;
    LDS_BARRIER();
    if (w == 0) {
        const float* g = g16 + (row0 + lane) * 16;
        const float be = sigmoidf_(g[h]); float G = -__expf(F.in[I_DNALOG][h]) * softplusf_(g[4 + h] + F.in[I_DNDT][h]);
#pragma unroll
        for (int o = 1; o < 64; o <<= 1) { const float v = __shfl_up(G, o); if (lane >= o) G += v; }
        const float Gl = __shfl(G, 63);
        gb[lane] = be; gb[64 + lane] = G; gb[128 + lane] = __expf(G); gb[192 + lane] = __expf(Gl - G);
        if (lane == 0) ((float*)(F.ws + WS_DN_SD))[ch] = __expf(Gl);
    }
    for (int idx = F.tid; idx < 1536; idx += NTHR) { const int j = idx / 384, c = idx % 384; cwL[idx] = cw[j * 1536 + (c >> 7) * 512 + h * 128 + (c & 127)]; }
    LDS_BARRIER();
#pragma unroll 1
    for (int which = 0; which < 3; ++which) {
        v4u raw[2][4];
#pragma unroll
        for (int i2 = 0; i2 < 2; ++i2) { const int item = i2 * 512 + F.tid, i = item >> 4, cg = item & 15, col = which * 512 + h * 128 + cg * 8;
#pragma unroll
            for (int j = 0; j < 4; ++j) { const int tt = n * 64 + i - 3 + j; raw[i2][j] = (v4u){0u, 0u, 0u, 0u};
                if (tt >= 0) raw[i2][j] = *(const v4u*)(proj + ((size_t)b * SEQ + tt) * NMAIN + col); } }
        LAS bf16* dstN = (which == 0 ? qN : which == 1 ? kN : vN);
#pragma unroll
        for (int i2 = 0; i2 < 2; ++i2) { const int item = i2 * 512 + F.tid, i = item >> 4, cg = item & 15;
            float y[8];
#pragma unroll
            for (int e = 0; e < 8; ++e) y[e] = 0.f;
#pragma unroll
            for (int j = 0; j < 4; ++j) { const v4u rw = raw[i2][j];
                const f32x4 w0 = *(const LAS f32x4*)(cwL + j * 384 + which * 128 + cg * 8), w1 = *(const LAS f32x4*)(cwL + j * 384 + which * 128 + cg * 8 + 4);
                y[0] += bf2f(rw.x & 0xffff) * w0.x; y[1] += bf2f(rw.x >> 16) * w0.y; y[2] += bf2f(rw.y & 0xffff) * w0.z; y[3] += bf2f(rw.y >> 16) * w0.w;
                y[4] += bf2f(rw.z & 0xffff) * w1.x; y[5] += bf2f(rw.z >> 16) * w1.y; y[6] += bf2f(rw.w & 0xffff) * w1.z; y[7] += bf2f(rw.w >> 16) * w1.w; }
            float ss = 0.f;
#pragma unroll
            for (int e = 0; e < 8; ++e) { y[e] = siluf_(y[e]); ss += y[e] * y[e]; }
            ss += __shfl_xor(ss, 1); ss += __shfl_xor(ss, 2); ss += __shfl_xor(ss, 4); ss += __shfl_xor(ss, 8);
            float sc = 1.0f; if (which == 0) sc = rsqrtf(ss + EPS) * 0.08838834764831845f; if (which == 1) sc = rsqrtf(ss + EPS);
            v4u o; o.x = pk2(y[0] * sc, y[1] * sc); o.y = pk2(y[2] * sc, y[3] * sc); o.z = pk2(y[4] * sc, y[5] * sc); o.w = pk2(y[6] * sc, y[7] * sc);
            *(LAS v4u*)(dstN + i * 136 + cg * 8) = o;
            if (which == 0) { const float s2 = sc * gb[128 + i]; v4u o2; o2.x = pk2(y[0] * s2, y[1] * s2); o2.y = pk2(y[2] * s2, y[3] * s2); o2.z = pk2(y[4] * s2, y[5] * s2); o2.w = pk2(y[6] * s2, y[7] * s2);
                *(v4u*)(gQD + i * 128 + cg * 8) = o2; }
        }
    }
    LDS_BARRIER();
    {
        const int c = F.tid & 127, tq = F.tid >> 7;
#pragma unroll
        for (int g4 = 0; g4 < 4; ++g4) { const int i0 = tq * 16 + g4 * 4;
            const f32x4 be = *(const LAS f32x4*)(gb + i0), eG = *(const LAS f32x4*)(gb + 128 + i0), kd = *(const LAS f32x4*)(gb + 192 + i0);
            f32x4 kv, vv;
#pragma unroll
            for (int x = 0; x < 4; ++x) { kv[x] = bf2f(kN[(i0 + x) * 136 + c]); vv[x] = bf2f(vN[(i0 + x) * 136 + c]); }
            *(LAS v2u*)(rhsT + (128 + c) * 72 + i0) = pk4(kv * be * eG);
            *(LAS v2u*)(kdT + c * 72 + i0) = pk4(kv * kd);
            *(LAS v2u*)(rhsT + c * 72 + i0) = pk4(vv * be);
        }
    }
    LDS_BARRIER();
    for (int t = w; t < 16; t += 8) { const int mt = t >> 2, nt = t & 3;
        const f32x4 a = tile_mma<128>(kN, 136, kN, 136, mt * 16, nt * 16, lane, (f32x4){0.f, 0.f, 0.f, 0.f});
        const int j = nt * 16 + r; const float Gj = gb[64 + j];
#pragma unroll
        for (int x = 0; x < 4; ++x) { const int i = mt * 16 + q4 + x; Lm[i * 68 + j] = (i > j) ? gb[i] * a[x] * __expf(gb[64 + i] - Gj) : 0.f; }
    }
    for (int t = w; t < 16; t += 8) { const int jt = t >> 2, itl = t & 3;
        const f32x4 a = tile_mma<128>(kN, 136, qN, 136, jt * 16, itl * 16, lane, (f32x4){0.f, 0.f, 0.f, 0.f});
        const int i = itl * 16 + r; const float Gi = gb[64 + i]; f32x4 o;
#pragma unroll
        for (int x = 0; x < 4; ++x) { const int j = jt * 16 + q4 + x; o[x] = (j <= i) ? a[x] * __expf(Gi - gb[64 + j]) : 0.f; }
        *(v2u*)(gQK + i * 64 + jt * 16 + q4) = pk4(o);
    }
    LDS_BARRIER();
    if (w == 0) {
        unsigned lbase; asm volatile("v_mov_b32 %0, %1" : "=v"(lbase) : "s"((unsigned)(size_t)Lm));
        const LAS float* Lv = (const LAS float*)(size_t)lbase;
        float t[64];
#define INV_ROWS(I0) _Pragma("unroll") for (int i = (I0); i < (I0) + 16; ++i) { \
            float s0 = (lane == i) ? 1.f : 0.f, s1 = 0.f; \
            {   f32x4 la[8]; \
                _Pragma("unroll") for (int j4 = 0; j4 < 8; ++j4) if (j4 < (i + 3) / 4) la[j4] = *(const LAS f32x4*)(Lv + i * 68 + j4 * 4); \
                _Pragma("unroll") for (int j4 = 0; j4 < 8; ++j4) if (j4 < (i + 3) / 4) { \
                    if (j4 * 4 + 0 < i) s0 -= la[j4].x * t[j4 * 4 + 0]; if (j4 * 4 + 1 < i) s1 -= la[j4].y * t[j4 * 4 + 1]; \
                    if (j4 * 4 + 2 < i) s0 -= la[j4].z * t[j4 * 4 + 2]; if (j4 * 4 + 3 < i) s1 -= la[j4].w * t[j4 * 4 + 3]; } } \
            if (i > 32) { f32x4 lb[8]; \
                _Pragma("unroll") for (int j4 = 8; j4 < 16; ++j4) if (j4 < (i + 3) / 4) lb[j4 - 8] = *(const LAS f32x4*)(Lv + i * 68 + j4 * 4); \
                _Pragma("unroll") for (int j4 = 8; j4 < 16; ++j4) if (j4 < (i + 3) / 4) { \
                    if (j4 * 4 + 0 < i) s0 -= lb[j4 - 8].x * t[j4 * 4 + 0]; if (j4 * 4 + 1 < i) s1 -= lb[j4 - 8].y * t[j4 * 4 + 1]; \
                    if (j4 * 4 + 2 < i) s0 -= lb[j4 - 8].z * t[j4 * 4 + 2]; if (j4 * 4 + 3 < i) s1 -= lb[j4 - 8].w * t[j4 * 4 + 3]; } } \
            t[i] = s0 + s1; Tm[i * 72 + lane] = (bf16)f2bf(t[i]); }
        INV_ROWS(0) INV_ROWS(16) INV_ROWS(32) INV_ROWS(48)
#undef INV_ROWS
    }
    LDS_BARRIER();
    for (int t = w; t < 64; t += 8) { const int mt = t & 3, nt = t >> 2;
        const f32x4 a = tile_mma<64>(Tm, 72, rhsT, 72, mt * 16, nt * 16, lane, (f32x4){0.f, 0.f, 0.f, 0.f});
        *(LAS v2u*)(solT + (nt * 16 + r) * 72 + mt * 16 + q4) = pk4(a);
    }
    for (int t = w; t < 32; t += 8) { const int mt = t & 7, nt = t >> 3;
        const f32x4 a = tile_mma<64>(rhsT + 128 * 72, 72, Tm, 72, mt * 16, nt * 16, lane, (f32x4){0.f, 0.f, 0.f, 0.f});
        *(v2u*)(gKC + (nt * 16 + r) * 128 + mt * 16 + q4) = pk4(a);
    }
    LDS_BARRIER();
    for (int t = w; t < 64; t += 8) { const int mt = t & 7, nt = t >> 3;
        f32x4 a = tile_mma<64>(solT + 128 * 72, 72, kdT, 72, mt * 16, nt * 16, lane, (f32x4){0.f, 0.f, 0.f, 0.f});
        a = -a; *(v2u*)(gMp + (nt * 16 + r) * 128 + mt * 16 + q4) = pk4(a);
    }
    for (int t = w; t < 64; t += 8) { const int mt = t & 7, nt = t >> 3;
        const f32x4 a = tile_mma<64>(kdT, 72, solT, 72, mt * 16, nt * 16, lane, (f32x4){0.f, 0.f, 0.f, 0.f});
        *(v2u*)(gUT + (nt * 16 + r) * 128 + mt * 16 + q4) = pk4(a);
    }
    for (int c = F.tid; c < 1024; c += NTHR) { const int row = c >> 3, pc = c & 7; *(v4u*)(gWT + row * 64 + pc * 8) = *(const LAS v4u*)(solT + row * 72 + pc * 8); }
}

#define DNS_LOAD(MR, UR, nn) do { const bf16* m1_ = gMp + (size_t)(nn) * 16384; const bf16* u1_ = gUT + (size_t)(nn) * 16384; \
    _Pragma("unroll") for (int x = 0; x < 4; ++x) { const int c = F.tid + 512 * x, row = c >> 4, pc = c & 15; MR[x] = *(const v4u*)(m1_ + row * 128 + pc * 8); } \
    _Pragma("unroll") for (int j = 0; j < NT; ++j) UR[j] = *(const v2u*)(u1_ + (c0 + 16 * j + r) * 128 + 16 * w + q4); } while (0)
#define UBF(v) ((f32x4){bf2f((v).x & 0xffff), bf2f((v).x >> 16), bf2f((v).y & 0xffff), bf2f((v).y >> 16)})
#define DNS_STEP(nn, MRc, URc, MRo, URo) do { \
    if ((nn) + 4 < 64) DNS_LOAD(MRo, URo, (nn) + 4); \
    const LAS bf16* STc = ST + ((nn) & 1) * (NT * 16 * 136); const LAS bf16* MPc = MP + ((nn) & 1) * (128 * 136); \
    LAS bf16* STn = ST + (((nn) + 1) & 1) * (NT * 16 * 136); LAS bf16* MPn = MP + (((nn) + 1) & 1) * (128 * 136); \
    const float sd = sdl[(nn)]; bf16x8_t a_[4]; \
    _Pragma("unroll") for (int s_ = 0; s_ < 4; ++s_) a_[s_] = *(const LAS bf16x8_t*)(MPc + (16 * w + r) * 136 + kq + 32 * s_); \
    _Pragma("unroll") for (int j = 0; j < NT; ++j) acc[j] = acc[j] * sd + UBF(u[j]); \
    _Pragma("unroll") for (int s_ = 0; s_ < 4; ++s_) { _Pragma("unroll") for (int j = 0; j < NT; ++j) { const bf16x8_t bb = *(const LAS bf16x8_t*)(STc + (16 * j + r) * 136 + kq + 32 * s_); \
        acc[j] = __builtin_amdgcn_mfma_f32_16x16x32_bf16(a_[s_], bb, acc[j], 0, 0, 0); } } \
    if ((nn) + 1 < 64) { bf16* gs = gST + (size_t)((nn) + 1) * 16384; \
        _Pragma("unroll") for (int j = 0; j < NT; ++j) { const v2u pv = pk4(acc[j]); *(LAS v2u*)(STn + (16 * j + r) * 136 + 16 * w + q4) = pv; *(v2u*)(gs + (c0 + 16 * j + r) * 128 + 16 * w + q4) = pv; } \
        _Pragma("unroll") for (int x = 0; x < 4; ++x) { const int c = F.tid + 512 * x, row = c >> 4, pc = c & 15; *(LAS v4u*)(MPn + row * 136 + pc * 8) = MRc[x]; } \
        _Pragma("unroll") for (int j = 0; j < NT; ++j) u[j] = URc[j]; } \
    LDS_BARRIER(); } while (0)
template <int NT> __device__ __forceinline__ void dn_scan(Frame& F, int bh, int part) {
    LAS bf16* ST = (LAS bf16*)(F.lds);
    LAS bf16* MP = (LAS bf16*)(F.lds + 2 * NT * 16 * 136 * 2);
    LAS float* sdl = (LAS float*)(F.lds + 2 * NT * 16 * 136 * 2 + 69632);
    const int ch0 = bh * 64, c0 = part * NT * 16, lane = F.lane, w = F.wave, r = lane & 15, q4 = (lane >> 4) * 4, kq = (lane >> 4) * 8;
    const bf16* gMp = (const bf16*)(F.ws + WS_DN_MP) + (size_t)ch0 * 16384; const bf16* gUT = (const bf16*)(F.ws + WS_DN_UT) + (size_t)ch0 * 16384;
    bf16* gST = (bf16*)(F.ws + WS_DN_ST) + (size_t)ch0 * 16384;
    LDS_BARRIER();
    for (int i = F.tid; i < NT * 16 * 136 / 2; i += NTHR) ((LAS unsigned*)ST)[i] = 0u;
    for (int c = F.tid; c < NT * 256; c += NTHR) { const int row = c >> 4, pc = c & 15; *(v4u*)(gST + (c0 + row) * 128 + pc * 8) = (v4u){0u, 0u, 0u, 0u}; }
    if (F.tid < 64) sdl[F.tid] = ((const float*)(F.ws + WS_DN_SD))[ch0 + F.tid];
    v4u m0[4], m1[4], m2[4], m3[4]; v2u u0[NT], u1[NT], u2[NT], u3[NT], u[NT]; f32x4 acc[NT];
    DNS_LOAD(m0, u, 0);
#pragma unroll
    for (int x = 0; x < 4; ++x) { const int c = F.tid + 512 * x, row = c >> 4, pc = c & 15; *(LAS v4u*)(MP + row * 136 + pc * 8) = m0[x]; }
#pragma unroll
    for (int j = 0; j < NT; ++j) acc[j] = (f32x4){0.f, 0.f, 0.f, 0.f};
    DNS_LOAD(m1, u1, 1); DNS_LOAD(m2, u2, 2); DNS_LOAD(m3, u3, 3);
    LDS_BARRIER();
#pragma unroll 1
    for (int n = 0; n < 64; n += 4) {
        DNS_STEP(n, m1, u1, m0, u0);
        DNS_STEP(n + 1, m2, u2, m1, u1);
        DNS_STEP(n + 2, m3, u3, m2, u2);
        DNS_STEP(n + 3, m0, u0, m3, u3);
    }
}

__device__ __forceinline__ void dn_out(Frame& F, int ch) {
    const int bh = ch >> 6, n = ch & 63, b = bh >> 2, h = bh & 3;
    const size_t row0 = (size_t)b * SEQ + n * 64;
    LAS bf16* kc = (LAS bf16*)(F.lds + 0);
    LAS bf16* wT = (LAS bf16*)(F.lds + 17408);
    LAS float* ob = (LAS float*)(F.lds + 0);
    LAS bf16* qd = (LAS bf16*)(F.lds + 35840);
    LAS bf16* qk = (LAS bf16*)(F.lds + 53248);
    LAS bf16* ST = (LAS bf16*)(F.lds + 62464);
    LAS bf16* vnT = (LAS bf16*)(F.lds + 97280);
    const bf16* gKC = (const bf16*)(F.ws + WS_DN_KC) + (size_t)ch * 8192; const bf16* gWT = (const bf16*)(F.ws + WS_DN_WT) + (size_t)ch * 8192;
    const bf16* gQD = (const bf16*)(F.ws + WS_DN_QD) + (size_t)ch * 8192; const bf16* gQK = (const bf16*)(F.ws + WS_DN_QK) + (size_t)ch * 4096;
    const bf16* gST = (const bf16*)(F.ws + WS_DN_ST) + (size_t)ch * 16384;
    const int lane = F.lane, w = F.wave, r = lane & 15, q4 = (lane >> 4) * 4;
    LDS_BARRIER();
    for (int c = F.tid; c < 1024; c += NTHR) { const int row = c >> 4, pc = c & 15; *(LAS v4u*)(kc + row * 136 + pc * 8) = *(const v4u*)(gKC + row * 128 + pc * 8); *(LAS v4u*)(qd + row * 136 + pc * 8) = *(const v4u*)(gQD + row * 128 + pc * 8); }
    for (int c = F.tid; c < 2048; c += NTHR) { const int row = c >> 4, pc = c & 15; *(LAS v4u*)(ST + row * 136 + pc * 8) = *(const v4u*)(gST + row * 128 + pc * 8); }
    for (int c = F.tid; c < 1024; c += NTHR) { const int row = c >> 3, pc = c & 7; *(LAS v4u*)(wT + row * 72 + pc * 8) = *(const v4u*)(gWT + row * 64 + pc * 8); }
    { const int c = F.tid, row = c >> 3, pc = c & 7; *(LAS v4u*)(qk + row * 72 + pc * 8) = *(const v4u*)(gQK + row * 64 + pc * 8); }
    LDS_BARRIER();
    for (int t = w; t < 32; t += 8) { const int mt = t & 3, nt = t >> 2;
        const f32x4 a = tile_mma<128>(kc, 136, ST, 136, mt * 16, nt * 16, lane, (f32x4){0.f, 0.f, 0.f, 0.f});
        const int e = nt * 16 + r; const v2u wv = *(const LAS v2u*)(wT + e * 72 + mt * 16 + q4);
        f32x4 vn; vn.x = bf2f(wv.x & 0xffff) - a.x; vn.y = bf2f(wv.x >> 16) - a.y; vn.z = bf2f(wv.y & 0xffff) - a.z; vn.w = bf2f(wv.y >> 16) - a.w;
        *(LAS v2u*)(vnT + e * 72 + mt * 16 + q4) = pk4(vn);
    }
    LDS_BARRIER();
    for (int t = w; t < 32; t += 8) { const int mt = t & 3, nt = t >> 2;
        f32x4 a = tile_mma<128>(qd, 136, ST, 136, mt * 16, nt * 16, lane, (f32x4){0.f, 0.f, 0.f, 0.f});
        a = tile_mma<64>(qk, 72, vnT, 72, mt * 16, nt * 16, lane, a);
        const int e = nt * 16 + r;
#pragma unroll
        for (int x = 0; x < 4; ++x) ob[(mt * 16 + q4 + x) * 132 + e] = a[x];
    }
    LDS_BARRIER();
    const bf16* proj = (const bf16*)(F.ws + WS_PROJ); bf16* mix = (bf16*)(F.ws + WS_MIX); const float* dnn = F.in[I_DNNORM];
    for (int rr = 0; rr < 8; ++rr) { const int i = w * 8 + rr;
        const float o0 = ob[i * 132 + 2 * lane], o1 = ob[i * 132 + 2 * lane + 1];
        const float rstd = rsqrtf(wave_sum(o0 * o0 + o1 * o1) * (1.f / 128.f) + EPS);
        const unsigned z = *(const unsigned*)(proj + (row0 + i) * NMAIN + MC_DNZ + h * 128 + 2 * lane);
        const float y0 = o0 * rstd * dnn[2 * lane] * siluf_(bf2f(z & 0xffff)), y1 = o1 * rstd * dnn[2 * lane + 1] * siluf_(bf2f(z >> 16));
        *(unsigned*)(mix + (row0 + i) * D + h * 128 + 2 * lane) = pk2(y0, y1);
    }
}

__device__ __forceinline__ void ml_prep(Frame& F, int ch) {
    const int bh = ch >> 6, n = ch & 63, b = bh >> 2, h = bh & 3;
    const size_t row0 = (size_t)b * SEQ + n * 64;
    LAS bf16* kwT = (LAS bf16*)(F.lds + 0);
    LAS bf16* vT = (LAS bf16*)(F.lds + 9216);
    LAS float* gsc = (LAS float*)(F.lds + 27648);
    const bf16* proj = (const bf16*)(F.ws + WS_PROJ); const float* g16 = (const float*)(F.ws + WS_G16); const float* cw = F.in[I_MLCONV];
    float* gUp = (float*)(F.ws + WS_ML_UPT) + (size_t)ch * 8192; bf16* gQC = (bf16*)(F.ws + WS_ML_QC) + (size_t)ch * 4096; bf16* gKC = (bf16*)(F.ws + WS_ML_KC) + (size_t)ch * 4096;
    float* aux = (float*)(F.ws + WS_ML_AUX);
    const int lane = F.lane, w = F.wave, r = lane & 15, q4 = (lane >> 4) * 4;
    LDS_BARRIER();
    if (w == 0) {
        const float* g = g16 + (row0 + lane) * 16;
        const float ip = g[8 + h] + F.in[I_MLIB][h]; float bc = logsigmoidf_(g[12 + h] + F.in[I_MLFB][h]);
#pragma unroll
        for (int o = 1; o < 64; o <<= 1) { const float v = __shfl_up(bc, o); if (lane >= o) bc += v; }
        const float bl = __shfl(bc, 63), ge = bl - bc + ip; float gm = ge;
#pragma unroll
        for (int o = 1; o < 64; o <<= 1) gm = fmaxf(gm, __shfl_xor(gm, o));
        gsc[lane] = __expf(ge - gm);
        if (lane == 0) { aux[131072 + ch * 2] = bl; aux[131072 + ch * 2 + 1] = gm; }
    }
    LDS_BARRIER();
#pragma unroll 1
    for (int it = 0; it < 2; ++it) {
        const int item = it * 512 + F.tid, i = item >> 4, cg = item & 15, isk = cg >> 3, c8 = (cg & 7) * 8, chn = isk * 256 + h * 64 + c8;
        float y[8];
#pragma unroll
        for (int j = 0; j < 8; ++j) y[j] = 0.f;
#pragma unroll
        for (int j = 0; j < 4; ++j) { const int tt = n * 64 + i - 3 + j;
            if (tt >= 0) { const v4u raw = *(const v4u*)(proj + ((size_t)b * SEQ + tt) * NMAIN + MC_MLQ + chn);
                const f32x4 w0 = *(const f32x4*)(cw + j * 512 + chn), w1 = *(const f32x4*)(cw + j * 512 + chn + 4);
                y[0] += bf2f(raw.x & 0xffff) * w0.x; y[1] += bf2f(raw.x >> 16) * w0.y; y[2] += bf2f(raw.y & 0xffff) * w0.z; y[3] += bf2f(raw.y >> 16) * w0.w;
                y[4] += bf2f(raw.z & 0xffff) * w1.x; y[5] += bf2f(raw.z >> 16) * w1.y; y[6] += bf2f(raw.w & 0xffff) * w1.z; y[7] += bf2f(raw.w >> 16) * w1.w; } }
#pragma unroll
        for (int j = 0; j < 8; ++j) y[j] = siluf_(y[j]);
        if (!isk) { v4u o; o.x = pk2(y[0] * 0.125f, y[1] * 0.125f); o.y = pk2(y[2] * 0.125f, y[3] * 0.125f); o.z = pk2(y[4] * 0.125f, y[5] * 0.125f); o.w = pk2(y[6] * 0.125f, y[7] * 0.125f);
            *(v4u*)(gQC + i * 64 + c8) = o; }
        else { v4u o; o.x = pk2(y[0], y[1]); o.y = pk2(y[2], y[3]); o.z = pk2(y[4], y[5]); o.w = pk2(y[6], y[7]); *(v4u*)(gKC + i * 64 + c8) = o;
            const float sc = gsc[i];
#pragma unroll
            for (int j = 0; j < 8; ++j) kwT[(c8 + j) * 72 + i] = (bf16)f2bf(y[j] * sc); }
    }
#pragma unroll 1
    for (int it = 0; it < 2; ++it) {
        const int item = it * 512 + F.tid, i = item >> 4, cg = item & 15;
        const v4u raw = *(const v4u*)(proj + (row0 + i) * NMAIN + MC_MLV + h * 128 + cg * 8);
        LAS bf16* d = vT + (cg * 8) * 72 + i;
        d[0] = (bf16)(raw.x & 0xffff); d[72] = (bf16)(raw.x >> 16); d[144] = (bf16)(raw.y & 0xffff); d[216] = (bf16)(raw.y >> 16);
        d[288] = (bf16)(raw.z & 0xffff); d[360] = (bf16)(raw.z >> 16); d[432] = (bf16)(raw.w & 0xffff); d[504] = (bf16)(raw.w >> 16);
    }
    LDS_BARRIER();
    for (int t = w; t < 32; t += 8) { const int mt = t & 3, nt = t >> 2;
        const f32x4 a = tile_mma<64>(kwT, 72, vT, 72, mt * 16, nt * 16, lane, (f32x4){0.f, 0.f, 0.f, 0.f});
        *(f32x4*)(gUp + (nt * 16 + r) * 64 + mt * 16 + q4) = a;
    }
    if (F.tid < 64) { float s = 0.f; for (int x = 0; x < 64; ++x) s += bf2f(kwT[F.tid * 72 + x]); aux[ch * 64 + F.tid] = s; }
}

__device__ __forceinline__ void ml_scan(Frame& F, int bh) {
    const int ch0 = bh * 64;
    const float* gUp = (const float*)(F.ws + WS_ML_UPT) + (size_t)ch0 * 8192; bf16* gCT = (bf16*)(F.ws + WS_ML_CT) + (size_t)ch0 * 8192;
    float* aux = (float*)(F.ws + WS_ML_AUX);
    LAS float* sl = (LAS float*)F.lds;
    LDS_BARRIER();
    if (F.tid < 128) sl[F.tid] = aux[131072 + ch0 * 2 + F.tid];
    for (int i = F.tid; i < 4096; i += NTHR) sl[128 + i] = aux[ch0 * 64 + i];
    LDS_BARRIER();
    f32x4 C[4], uA[4], uB[4]; float nv = 0.f, m = 0.f;
#pragma unroll
    for (int x = 0; x < 4; ++x) { C[x] = (f32x4){0.f, 0.f, 0.f, 0.f}; uA[x] = *(const f32x4*)(gUp + x * 2048 + F.tid * 4); uB[x] = *(const f32x4*)(gUp + 8192 + x * 2048 + F.tid * 4); }
#define MLS_STEP(nn, UC) do { const int ch = ch0 + (nn); \
        _Pragma("unroll") for (int x = 0; x < 4; ++x) *(v2u*)(gCT + (size_t)(nn) * 8192 + x * 2048 + F.tid * 4) = pk4(C[x]); \
        if (F.tid < 64) aux[65536 + ch * 64 + F.tid] = nv; \
        if (F.tid == 0) aux[133120 + ch] = m; \
        const float bl = sl[2 * (nn)], gm = sl[2 * (nn) + 1]; \
        const float m1 = fmaxf(bl + m, gm), keep = __expf(bl + m - m1), sc = __expf(gm - m1); \
        _Pragma("unroll") for (int x = 0; x < 4; ++x) C[x] = C[x] * keep + UC[x] * sc; \
        nv = nv * keep + sl[128 + (nn) * 64 + (F.tid & 63)] * sc; m = m1; \
        if ((nn) + 2 < 64) { _Pragma("unroll") for (int x = 0; x < 4; ++x) UC[x] = *(const f32x4*)(gUp + (size_t)((nn) + 2) * 8192 + x * 2048 + F.tid * 4); } } while (0)
#pragma unroll 1
    for (int n = 0; n < 64; n += 2) { MLS_STEP(n, uA); MLS_STEP(n + 1, uB); }
#undef MLS_STEP
}

__device__ __forceinline__ void ml_out(Frame& F, int ch) {
    const int bh = ch >> 6, n = ch & 63, b = bh >> 2, h = bh & 3;
    const size_t row0 = (size_t)b * SEQ + n * 64;
    LAS bf16* qI = (LAS bf16*)(F.lds + 0);
    LAS bf16* qS = (LAS bf16*)(F.lds + 9216);
    LAS bf16* kS = (LAS bf16*)(F.lds + 18432);
    LAS bf16* pM = (LAS bf16*)(F.lds + 27648);
    LAS bf16* vT = (LAS bf16*)(F.lds + 36864);
    LAS bf16* cT = (LAS bf16*)(F.lds + 57600);
    LAS float* hb = (LAS float*)(F.lds + 78336);
    LAS float* gg = (LAS float*)(F.lds + 116224);
    const bf16* proj = (const bf16*)(F.ws + WS_PROJ); const float* g16 = (const float*)(F.ws + WS_G16);
    const bf16* gQC = (const bf16*)(F.ws + WS_ML_QC) + (size_t)ch * 4096; const bf16* gKC = (const bf16*)(F.ws + WS_ML_KC) + (size_t)ch * 4096;
    const bf16* gCT = (const bf16*)(F.ws + WS_ML_CT) + (size_t)ch * 8192; const float* aux = (const float*)(F.ws + WS_ML_AUX);
    const int lane = F.lane, w = F.wave, r = lane & 15, q4 = (lane >> 4) * 4;
    LDS_BARRIER();
    if (w == 0) {
        const float* g = g16 + (row0 + lane) * 16;
        const float ip = g[8 + h] + F.in[I_MLIB][h]; float bc = logsigmoidf_(g[12 + h] + F.in[I_MLFB][h]);
#pragma unroll
        for (int o = 1; o < 64; o <<= 1) { const float v = __shfl_up(bc, o); if (lane >= o) bc += v; }
        const float rj = ip - bc; float pm = rj;
#pragma unroll
        for (int o = 1; o < 64; o <<= 1) { const float v = __shfl_up(pm, o); if (lane >= o) pm = fmaxf(pm, v); }
        const float ms = aux[133120 + ch], mt = fmaxf(bc + ms, bc + pm);
        gg[lane] = bc; gg[64 + lane] = rj; gg[128 + lane] = mt; gg[192 + lane] = __expf(bc + ms - mt);
    }
    for (int i = F.tid; i < 16 * 72; i += NTHR) { const bf16 one = (bf16)0x3f80; vT[128 * 72 + i] = (i < 64) ? one : (bf16)0; cT[128 * 72 + i] = (bf16)0; }
    LDS_BARRIER();
    { const int c = F.tid, row = c >> 3, pc = c & 7;
        const v4u qv = *(const v4u*)(gQC + row * 64 + pc * 8); *(LAS v4u*)(qS + row * 72 + pc * 8) = qv; *(LAS v4u*)(kS + row * 72 + pc * 8) = *(const v4u*)(gKC + row * 64 + pc * 8);
        const float in = gg[192 + row]; v4u o;
        o.x = pk2(bf2f(qv.x & 0xffff) * in, bf2f(qv.x >> 16) * in); o.y = pk2(bf2f(qv.y & 0xffff) * in, bf2f(qv.y >> 16) * in);
        o.z = pk2(bf2f(qv.z & 0xffff) * in, bf2f(qv.z >> 16) * in); o.w = pk2(bf2f(qv.w & 0xffff) * in, bf2f(qv.w >> 16) * in);
        *(LAS v4u*)(qI + row * 72 + pc * 8) = o; }
    for (int c = F.tid; c < 1024; c += NTHR) { const int row = c >> 3, pc = c & 7; *(LAS v4u*)(cT + row * 72 + pc * 8) = *(const v4u*)(gCT + row * 64 + pc * 8); }
    if (F.tid < 64) cT[128 * 72 + F.tid] = (bf16)f2bf(aux[65536 + ch * 64 + F.tid]);
#pragma unroll 1
    for (int it = 0; it < 2; ++it) {
        const int item = it * 512 + F.tid, i = item >> 4, cg = item & 15;
        const v4u raw = *(const v4u*)(proj + (row0 + i) * NMAIN + MC_MLV + h * 128 + cg * 8);
        LAS bf16* d = vT + (cg * 8) * 72 + i;
        d[0] = (bf16)(raw.x & 0xffff); d[72] = (bf16)(raw.x >> 16); d[144] = (bf16)(raw.y & 0xffff); d[216] = (bf16)(raw.y >> 16);
        d[288] = (bf16)(raw.z & 0xffff); d[360] = (bf16)(raw.z >> 16); d[432] = (bf16)(raw.w & 0xffff); d[504] = (bf16)(raw.w >> 16);
    }
    LDS_BARRIER();
    for (int t = w; t < 16; t += 8) { const int jt = t >> 2, itl = t & 3;
        const f32x4 a = tile_mma<64>(kS, 72, qS, 72, jt * 16, itl * 16, lane, (f32x4){0.f, 0.f, 0.f, 0.f});
        const int i = itl * 16 + r; const float e0 = gg[i] - gg[128 + i]; f32x4 o;
#pragma unroll
        for (int x = 0; x < 4; ++x) { const int j = jt * 16 + q4 + x; o[x] = (j <= i) ? a[x] * __expf(e0 + gg[64 + j]) : 0.f; }
        *(LAS v2u*)(pM + i * 72 + jt * 16 + q4) = pk4(o);
    }
    LDS_BARRIER();
    for (int t = w; t < 36; t += 8) { const int mt = t & 3, nt = t >> 2;
        f32x4 a = tile_mma<64>(qI, 72, cT, 72, mt * 16, nt * 16, lane, (f32x4){0.f, 0.f, 0.f, 0.f});
        a = tile_mma<64>(pM, 72, vT, 72, mt * 16, nt * 16, lane, a);
        const int e = nt * 16 + r;
#pragma unroll
        for (int x = 0; x < 4; ++x) hb[(mt * 16 + q4 + x) * 148 + e] = a[x];
    }
    LDS_BARRIER();
    bf16* mix = (bf16*)(F.ws + WS_MIX); const float* mln = F.in[I_MLNORM];
    for (int rr = 0; rr < 8; ++rr) { const int i = w * 8 + rr;
        const float dd = fmaxf(fabsf(hb[i * 148 + 128]), __expf(-gg[128 + i]));
        const float o0 = hb[i * 148 + 2 * lane] / dd, o1 = hb[i * 148 + 2 * lane + 1] / dd;
        const float rstd = rsqrtf(wave_sum(o0 * o0 + o1 * o1) * (1.f / 128.f) + EPS);
        const unsigned z = *(const unsigned*)(proj + (row0 + i) * NMAIN + MC_MLO + h * 128 + 2 * lane);
        const float y0 = o0 * rstd * mln[h * 128 + 2 * lane] * sigmoidf_(bf2f(z & 0xffff)), y1 = o1 * rstd * mln[h * 128 + 2 * lane + 1] * sigmoidf_(bf2f(z >> 16));
        *(unsigned*)(mix + (row0 + i) * D + 512 + h * 128 + 2 * lane) = pk2(y0, y1);
    }
}

template <int J0> __device__ __forceinline__ void p4_mixnorm(Frame& F) {
    const float* raw = (const float*)(F.ws + WS_RAW); const bf16* proj = (const bf16*)(F.ws + WS_PROJ); bf16* mix = (bf16*)(F.ws + WS_MIX);
    const float* dnn = F.in[I_DNNORM]; const float* mln = F.in[I_MLNORM];
    const int gw = F.vb * NWAVES + F.wave, NGW = F.G * NWAVES;
    for (int row = gw; row < T; row += NGW) {
        const f32x4* rr = (const f32x4*)(raw + (size_t)row * D) + F.lane;
        v2u* o8 = (v2u*)(mix + (size_t)row * D) + F.lane;
#pragma unroll
        for (int j = J0; j < 4; ++j) {
            f32x4 v = rr[64 * j]; float ss = (v.x * v.x + v.y * v.y) + (v.z * v.z + v.w * v.w);
#pragma unroll
            for (int o = 1; o < 32; o <<= 1) ss += __shfl_xor(ss, o);
            const float rstd = rsqrtf(ss * (1.f / 128.f) + EPS);
            const int k = 256 * j + F.lane * 4;
            f32x4 w, gt;
            if (j < 2) { w = *(const f32x4*)(dnn + (k & 127)); const v2u z = *(const v2u*)(proj + (size_t)row * NMAIN + MC_DNZ + k);
                gt.x = siluf_(bf2f(z.x & 0xffff)); gt.y = siluf_(bf2f(z.x >> 16)); gt.z = siluf_(bf2f(z.y & 0xffff)); gt.w = siluf_(bf2f(z.y >> 16)); }
            else { w = *(const f32x4*)(mln + (k - 512)); const v2u z = *(const v2u*)(proj + (size_t)row * NMAIN + MC_MLO + (k - 512));
                gt.x = sigmoidf_(bf2f(z.x & 0xffff)); gt.y = sigmoidf_(bf2f(z.x >> 16)); gt.z = sigmoidf_(bf2f(z.y & 0xffff)); gt.w = sigmoidf_(bf2f(z.y >> 16)); }
            v = v * rstd * w * gt;
            v2u o; o.x = pk2(v.x, v.y); o.y = pk2(v.z, v.w); o8[64 * j] = o;
        }
    }
}

__device__ __forceinline__ void p6_router(Frame& F, int rep) {
    LAS float* wr = (LAS float*)F.lds;
    LAS float* lg = (LAS float*)(F.lds + L_EXTRA);
    const float* x1 = (const float*)(F.ws + WS_X1);
    f32x4 vn[4];
    { const f32x4* xr0 = (const f32x4*)(x1 + (size_t)(F.vb * 64 + F.wave * 8) * D) + F.lane;
#pragma unroll
      for (int j = 0; j < 4; ++j) vn[j] = xr0[64 * j]; }
    { const char* src = (const char*)(F.ws + WS_WRT);
#pragma unroll
        for (int it = 0; it < 16; ++it) { const int chunk = it * 8 + F.wave;
            __builtin_amdgcn_global_load_lds((const unsigned*)(src + chunk * 1024 + F.lane * 16), (LAS unsigned*)(F.lds + chunk * 1024), 16, 0, 0); }
        asm volatile("s_waitcnt vmcnt(0)" ::: "memory"); }
    __syncthreads(); const float* nw = F.in[I_NFFN]; const float* mod = (const float*)(F.ws + WS_MOD);
    bf16* h2 = (bf16*)(F.ws + WS_H); const float* br = F.in[I_BR];
    int* tok_e = (int*)(F.ws + WS_TOKE); int* tok_r = (int*)(F.ws + WS_TOKR); float* tok_w = (float*)(F.ws + WS_TOKW); int* slot_tok = (int*)(F.ws + WS_SLOTTOK);
    unsigned* gcnt = (unsigned*)(F.ws + WS_CTL) + CW_CNT;
    if (rep > 0) { tok_e = (int*)(F.ws + WS_RAW); tok_r = tok_e + 65536; tok_w = (float*)(tok_r + 65536); slot_tok = tok_r + 131072; gcnt += 16384 - CW_CNT; }
    for (int blk = F.vb; blk < T / 64; blk += F.G) {
        for (int rr = 0; rr < 8; ++rr) {
            const int lr = F.wave * 8 + rr, row = blk * 64 + lr, b = row / SEQ;
            f32x4 v[4]; float ss = 0.f;
#pragma unroll
            for (int j = 0; j < 4; ++j) { v[j] = vn[j]; ss += (v[j].x * v[j].x + v[j].y * v[j].y) + (v[j].z * v[j].z + v[j].w * v[j].w); }
            { const int nrow = (rr + 1 < 8) ? row + 1 : row;
              const f32x4* xr = (const f32x4*)(x1 + (size_t)nrow * D) + F.lane;
#pragma unroll
              for (int j = 0; j < 4; ++j) vn[j] = xr[64 * j]; }
            const float rstd = rsqrtf(wave_sum(ss) * (1.f / D) + EPS);
            const float* sh = mod + b * 6144 + 3072; const float* sc = sh + 1024;
#pragma unroll
            for (int j = 0; j < 4; ++j) { const int k = 256 * j + F.lane * 4;
                const f32x4 w = *(const f32x4*)(nw + k), s1 = *(const f32x4*)(sc + k), s0 = *(const f32x4*)(sh + k);
                v[j] = (v[j] * rstd * w) * (1.0f + s1) + s0; }
            v2u* o8 = (v2u*)(h2 + (size_t)row * D) + F.lane;
#pragma unroll
            for (int j = 0; j < 4; ++j) { v2u o; o.x = pk2(v[j].x, v[j].y); o.y = pk2(v[j].z, v[j].w); o8[64 * j] = o; }
            float acc[32];
#pragma unroll
            for (int e = 0; e < 32; ++e) { float a = 0.f;
#pragma unroll
                for (int j = 0; j < 4; ++j) { const f32x4 w = *(const LAS f32x4*)(wr + e * 1024 + 256 * j + F.lane * 4); a += (v[j].x * w.x + v[j].y * w.y) + (v[j].z * w.z + v[j].w * w.w); }
                acc[e] = a; if (e & 1) asm volatile("" ::: "memory"); }
            const float r = multi_reduce<32>(acc, F.lane);
            if ((F.lane & 1) == 0) lg[lr * 33 + (F.lane >> 1)] = r + br[F.lane >> 1];
        }
        __syncthreads();
        if (F.wave == 0) {
            const int row = blk * 64 + F.lane;
            float l[32];
#pragma unroll
            for (int e = 0; e < 32; ++e) l[e] = lg[F.lane * 33 + e];
            int te[4]; float tl[4];
#pragma unroll
            for (int k = 0; k < 4; ++k) { float best = -3.0e38f; int bi = 0;
#pragma unroll
                for (int e = 0; e < 32; ++e) { if (l[e] > best) { best = l[e]; bi = e; } }
                te[k] = bi; tl[k] = best;
#pragma unroll
                for (int e = 0; e < 32; ++e) if (e == bi) l[e] = -3.0e38f; }
            float w0 = 1.f, w1 = __expf(tl[1] - tl[0]), w2 = __expf(tl[2] - tl[0]), w3 = __expf(tl[3] - tl[0]); const float inv = 1.f / (w0 + w1 + w2 + w3);
            w0 *= inv; w1 *= inv; w2 *= inv; w3 *= inv;
            int mycount = 0;
#pragma unroll
            for (int k = 0; k < 4; ++k) {
#pragma unroll 1
                for (int e = 0; e < 32; ++e) { const unsigned long long mk = __ballot(te[k] == e); if (F.lane == e) mycount += __popcll(mk); } }
            int base = 0; if (F.lane < 32) base = (int)__hip_atomic_fetch_add(gcnt + 64 * F.lane, (unsigned)mycount, __ATOMIC_RELAXED, __HIP_MEMORY_SCOPE_AGENT);
            int run = 0;
            int rk[4];
#pragma unroll
            for (int k = 0; k < 4; ++k) { rk[k] = 0;
#pragma unroll 1
                for (int e = 0; e < 32; ++e) { const unsigned long long mk = __ballot(te[k] == e);
                    const int be = __shfl(base, e), re = __shfl(run, e);
                    if (te[k] == e) rk[k] = be + re + __popcll(mk & ((1ull << F.lane) - 1ull));
                    if (F.lane == e) run += __popcll(mk); } }
            const float ww[4] = {w0, w1, w2, w3};
#pragma unroll
            for (int k = 0; k < 4; ++k) { tok_e[row * 4 + k] = te[k]; tok_r[row * 4 + k] = rk[k]; tok_w[row * 4 + k] = ww[k]; if (rk[k] < ECAP) slot_tok[te[k] * ECAP + rk[k]] = row; }
        }
        __syncthreads();
    }
}

__device__ __forceinline__ void p9_final(Frame& F) {
    build_expert_tables(F);
    const LAS int* tst = (const LAS int*)(F.lds + L_TST);
    const float* x1 = (const float*)(F.ws + WS_X1); const bf16* y = (const bf16*)(F.ws + WS_Y);
    const float* mod = (const float*)(F.ws + WS_MOD); const float* modf = (const float*)(F.ws + WS_MODF); const float* nf = F.in[I_NFIN];
    const int* tok_e = (const int*)(F.ws + WS_TOKE); const int* tok_r = (const int*)(F.ws + WS_TOKR); const float* tok_w = (const float*)(F.ws + WS_TOKW);
    const int gw = F.vb * NWAVES + F.wave, NGW = F.G * NWAVES;
    for (int row = gw; row < T; row += NGW) {
        const int b = row / SEQ;
        const f32x4* xr = (const f32x4*)(x1 + (size_t)row * D) + F.lane;
        f32x4 v[4], m[4];
#pragma unroll
        for (int j = 0; j < 4; ++j) { v[j] = xr[64 * j]; m[j] = (f32x4){0.f, 0.f, 0.f, 0.f}; }
#pragma unroll
        for (int k = 0; k < 4; ++k) { const int e = tok_e[row * 4 + k], r = tok_r[row * 4 + k]; const float w = tok_w[row * 4 + k];
            const size_t cs = (size_t)tst[e] * 256 + r;
            const v2u* yr = (const v2u*)(y + cs * D) + F.lane;
#pragma unroll
            for (int j = 0; j < 4; ++j) { const v2u z = yr[64 * j];
                m[j].x += w * bf2f(z.x & 0xffff); m[j].y += w * bf2f(z.x >> 16); m[j].z += w * bf2f(z.y & 0xffff); m[j].w += w * bf2f(z.y >> 16); } }
        const float* g2 = mod + b * 6144 + 5120; float ss = 0.f;
#pragma unroll
        for (int j = 0; j < 4; ++j) { const f32x4 g = *(const f32x4*)(g2 + 256 * j + F.lane * 4); v[j] = v[j] + g * m[j];
            ss += (v[j].x * v[j].x + v[j].y * v[j].y) + (v[j].z * v[j].z + v[j].w * v[j].w); }
        const float rstd = rsqrtf(wave_sum(ss) * (1.f / D) + EPS);
        const float* sh = modf + b * 2048; const float* sc = sh + 1024;
        f32x4* orow = (f32x4*)(F.out + (size_t)row * D) + F.lane;
#pragma unroll
        for (int j = 0; j < 4; ++j) { const int k = 256 * j + F.lane * 4;
            const f32x4 w = *(const f32x4*)(nf + k), s1 = *(const f32x4*)(sc + k), s0 = *(const f32x4*)(sh + k);
            f32x4 ov = (v[j] * rstd * w) * (1.0f + s1) + s0;
            if (TP_A >= 0) { const unsigned long long* st = (const unsigned long long*)(F.ws + WS_CTL + 131072); const float eps = (float)(long long)(st[TP_B] - st[TP_A]) * (float)TP_SCALE * 0.25e-5f; ov = ov * (1.0f + eps); }
            orow[64 * j] = ov; }
    }
}

constexpr int NPH = 11;
__global__ void __launch_bounds__(NTHR, 2) fwd(Args args) {
    extern __shared__ __attribute__((aligned(16))) unsigned char lds_raw[];
    Frame F;
    F.lds = (LAS unsigned char*)lds_raw; F.ws = args.ws; F.out = args.out;
    F.in.p = (const float* const*)__builtin_amdgcn_kernarg_segment_ptr();
    F.tid = threadIdx.x; F.lane = F.tid & 63; F.wave = __builtin_amdgcn_readfirstlane(F.tid >> 6);
    F.G = gridDim.x; F.vb = blockIdx.x;
    for (int u = F.tid; u < (LDS_BYTES - LDSCTL_OFF) / 4; u += NTHR) ((LAS unsigned*)(F.lds + LDSCTL_OFF))[u] = 0u;
    __syncthreads();
    unsigned* ctl = (unsigned*)(F.ws + WS_CTL);
    const int lo = args.ph_lo, hi = args.ph_hi;
    XcdBarrier bar; bar.bar = ctl + CW_BAR; bar.x = 0; bar.st = nullptr;
    if (hi - lo > 1) bar = xcd_barrier_post(ctl + CW_BAR, (volatile LAS unsigned*)(F.lds + L_MISC) + 8);
#ifndef REPMASK
#define REPMASK 0
#endif
#define NREP(k) (((REPMASK >> (k)) & 1) ? 2 : 1)
#ifndef P3MODE
#define P3MODE 0
#endif
#ifndef XBARS
#define XBARS 0
#endif
#ifndef PHMASK
#define PHMASK 0x7ff
#endif
#define IN(k) (((PHMASK >> (k)) & 1) && lo <= (k) && (k) < hi)
#define SEAM(k) do { if (IN(k) && IN((k) + 1)) xcd_barrier(bar); STAMP((k) + 1, 0); } while (0)
    STAMP(0, 0);

    if (IN(0)) _Pragma("unroll") for (int rep_ = 0; rep_ < NREP(0); ++rep_) { p0_prologue(F); } SEAM(0);
    if (IN(1)) _Pragma("unroll") for (int rep_ = 0; rep_ < NREP(1); ++rep_) { p1_norm1(F); } SEAM(1);
    if (IN(2)) _Pragma("unroll") for (int rep_ = 0; rep_ < NREP(2); ++rep_) {
        pg8::Gemm g{(const bf16*)(F.ws + WS_H), D}; pg8::DenseOrder S; S.init(T, NMAIN, D, (const bf16*)(F.ws + WS_BTIN), F.G, F.vb);
        EpiProj E{(bf16*)(F.ws + WS_PROJ), NMAIN};
        pg8::gemm_phase<EpiProj, pg8::DenseOrder, true, true>(F.lds, g, S, E);
    } SEAM(2);
    if (IN(3)) _Pragma("unroll") for (int rep_ = 0; rep_ < NREP(3); ++rep_) { for (int it = F.vb; it < 2048; it += F.G) { if (it < 1024) { dn_prep(F, it); if (P3MODE == 1) dn_prep(F, it); } else { ml_prep(F, it - 1024); if (P3MODE == 2) ml_prep(F, it - 1024); } } } SEAM(3);
    if (IN(4)) _Pragma("unroll") for (int rep_ = 0; rep_ < NREP(4); ++rep_) {
        for (int role = F.vb; role < 144; role += F.G) {
            if (role < 128) dn_scan<1>(F, (role & 7) + 8 * (role >> 6), (role >> 3) & 7);
            else ml_scan(F, role - 128);
        }
        convert_moe(F);
    } SEAM(4);
    if (IN(5)) _Pragma("unroll") for (int rep_ = 0; rep_ < NREP(5); ++rep_) { for (int it = F.vb; it < 2048; it += F.G) { if (it < 1024) { dn_out(F, it); if (P3MODE == 3) dn_out(F, it); } else { ml_out(F, it - 1024); if (P3MODE == 4) ml_out(F, it - 1024); } } } SEAM(5);
    if (IN(6)) _Pragma("unroll") for (int rep_ = 0; rep_ < NREP(6); ++rep_) {
        pg8::Gemm g{(const bf16*)(F.ws + WS_MIX), D}; pg8::DenseOrder S; S.init(T, D, D, (const bf16*)(F.ws + WS_BTOUT), F.G, F.vb);
        EpiRes E{F.in[I_X], (float*)(F.ws + WS_X1), (const float*)(F.ws + WS_MOD)};
        pg8::gemm_phase<EpiRes, pg8::DenseOrder, false, true>(F.lds, g, S, E);
    } SEAM(6);
    if (IN(7)) _Pragma("unroll") for (int rep_ = 0; rep_ < NREP(7); ++rep_) { p6_router(F, rep_); } SEAM(7);
    if (IN(8)) _Pragma("unroll") for (int rep_ = 0; rep_ < NREP(8); ++rep_) {
        const int nmt = build_expert_tables(F);
        GroupedOrder<4, 8, true> S; S.G = F.G; S.c = F.vb; S.nmt = nmt; S.K = D; S.tileE = (const LAS int*)(F.lds + L_TILEE); S.tst = (const LAS int*)(F.lds + L_TST); S.cnt = (const LAS int*)(F.lds + L_CNT);
        S.slot_tok = (const int*)(F.ws + WS_SLOTTOK); S.Bt = (const bf16*)(F.ws + WS_BTGU); S.bexp = (size_t)2048 * D; S.tokbuf = (LAS unsigned*)(F.lds + L_EXTRA) + F.wave * 256;
        pg8::Gemm g{(const bf16*)(F.ws + WS_H), D};
        EpiGU E{(bf16*)(F.ws + WS_ACT), F.in[I_BGU]};
        pg8::gemm_phase<EpiGU, GroupedOrder<4, 8, true>, true, true>(F.lds, g, S, E);
    } SEAM(8);
    if (IN(9)) _Pragma("unroll") for (int rep_ = 0; rep_ < NREP(9); ++rep_) {
        const int nmt = build_expert_tables(F);
        GroupedOrder<8, 4, false> S; S.G = F.G; S.c = F.vb; S.nmt = nmt; S.K = D; S.tileE = (const LAS int*)(F.lds + L_TILEE); S.tst = (const LAS int*)(F.lds + L_TST); S.cnt = (const LAS int*)(F.lds + L_CNT);
        S.slot_tok = nullptr; S.Bt = (const bf16*)(F.ws + WS_BTDN); S.bexp = (size_t)D * D; S.tokbuf = nullptr;
        pg8::Gemm g{(const bf16*)(F.ws + WS_ACT), D};
        EpiDown E{(bf16*)(F.ws + WS_Y), F.in[I_BDN]};
        pg8::gemm_phase<EpiDown, GroupedOrder<8, 4, false>, true, true>(F.lds, g, S, E);
    } SEAM(9);
    for (int xb_ = 0; xb_ < XBARS; ++xb_) xcd_barrier(bar);
    if (IN(10)) _Pragma("unroll") for (int rep_ = 0; rep_ < NREP(10); ++rep_) { p9_final(F); }
#undef IN
#undef SEAM
}

extern "C" void kernel_launch(void* const* d_in, const int* in_sizes, int n_in, void* d_out, int out_size, void* d_ws, size_t ws_size, hipStream_t stream) {
    static int grid = 0;
    if (grid == 0) {
        if (n_in != 25 || in_sizes[0] != T * D || out_size != T * D || ws_size < WS_END) { fprintf(stderr, "kernel_launch: unexpected shapes (n_in %d, ws %zu)\n", n_in, ws_size); grid = -1; return; }
        int dev = 0, cus = 0, per_cu = 0;
        if (hipGetDevice(&dev) != hipSuccess || hipDeviceGetAttribute(&cus, hipDeviceAttributeMultiprocessorCount, dev) != hipSuccess) { grid = -1; return; }
        if (hipFuncSetAttribute((const void*)fwd, hipFuncAttributeMaxDynamicSharedMemorySize, LDS_BYTES) != hipSuccess) { fprintf(stderr, "kernel_launch: hipFuncSetAttribute failed\n"); grid = -1; return; }
        if (hipOccupancyMaxActiveBlocksPerMultiprocessor(&per_cu, (const void*)fwd, NTHR, LDS_BYTES) != hipSuccess || per_cu < 1) { fprintf(stderr, "kernel_launch: occupancy query says %d\n", per_cu); }
        (void)hipGetLastError();
        grid = cus;
    }
    if (grid < 0) return;
    hipMemsetAsync((char*)d_ws + WS_CTL, 0, CTL_ZERO_BYTES, stream);
    Args a{};
    for (int i = 0; i < 25; ++i) a.in[i] = (const float*)d_in[i];
    a.out = (float*)d_out; a.ws = (unsigned char*)d_ws;
#if MK_ONE_LAUNCH
    a.ph_lo = 0; a.ph_hi = NPH;
    hipLaunchKernelGGL(fwd, dim3(grid), dim3(NTHR), LDS_BYTES, stream, a);
#else
    for (int p = 0; p < NPH; ++p) { a.ph_lo = p; a.ph_hi = p + 1; hipLaunchKernelGGL(fwd, dim3(grid), dim3(NTHR), LDS_BYTES, stream, a); }
#endif
}
```

```cpp
#include <hip/hip_runtime.h>
#include <cstdio>
#include <cstdint>

#ifndef TP_A
#define TP_A -1
#endif
#ifndef TP_B
#define TP_B 0
#endif
#ifndef TP_SCALE
#define TP_SCALE 1
#endif
#define STAMP(id, blk) do { if (TP_A >= 0 && (int)blockIdx.x == (blk) && threadIdx.x == 0) ((unsigned long long*)(F.ws + WS_CTL + 131072))[(id)] = wall_clock64(); } while (0)
#ifndef MK_ONE_LAUNCH
#define MK_ONE_LAUNCH 1
#endif

namespace pg8 {
#define PG8_LAS __attribute__((address_space(3)))
typedef unsigned short bf16_t;
typedef short bf16x8 __attribute__((ext_vector_type(8)));
typedef float f32x4 __attribute__((ext_vector_type(4)));
typedef unsigned u32x4 __attribute__((ext_vector_type(4)));
constexpr int BM = 256, BK = 64, HALF = 128, HTB = HALF * BK * 2, STAGE_BYTES = 8 * HTB, NXCD = 8, WGM = 8;

__host__ __device__ __forceinline__ int lds_byte(int r, int c) { const int st = (r >> 4) * 2 + (c >> 5), rr = r & 15, cc = c & 31, ob = rr * 64 + cc * 2; return st * 1024 + (ob ^ (((ob >> 9) & 1) << 5)); }
__host__ __device__ __forceinline__ void stage_rc(int b, int& R, int& C) { const int st = b / 1024, sb = b % 1024, swz = sb ^ (((sb >> 9) & 1) << 5); R = (st >> 1) * 16 + swz / 64; C = (st & 1) * 32 + (swz % 64) / 2; }
__host__ __device__ __forceinline__ int perm32(int rho) { const int n = rho >> 4, i = rho & 15; return 8 * (i >> 2) + 4 * n + (i & 3); }

struct Unit { int pm, pn, e; };
struct Gemm { const bf16_t* A; int K; };

struct DenseOrder {
    int nM, nN, nwg, G, c, K; const bf16_t* Bt;
    __device__ void init(int M, int N, int K_, const bf16_t* Bt_, int G_, int c_) { nM = M / BM; nN = N / BM; nwg = nM * nN; G = G_; c = c_; K = K_; Bt = Bt_; }
    __device__ bool next(int i, Unit& u) const {
        const long L = (long)i * G + c; if (L >= nwg) return false;
        int wgid = (int)L; { const int q = nwg / NXCD, r = nwg % NXCD, xcd = wgid % NXCD, off = wgid / NXCD; wgid = (xcd < r ? xcd * (q + 1) : r * (q + 1) + (xcd - r) * q) + off; }
        const int nig = WGM * nN, gid = wgid / nig, fm = gid * WGM, gsz = (nM - fm) < WGM ? (nM - fm) : WGM;
        u.pm = fm + ((wgid % nig) % gsz); u.pn = (wgid % nig) / gsz; u.e = 0; return true;
    }
    __device__ __forceinline__ void a_voff(const Unit& u, const int (&R)[2], const int (&C)[2], unsigned (&vo)[2][2]) const {
#pragma unroll
        for (int h = 0; h < 2; ++h)
#pragma unroll
            for (int i = 0; i < 2; ++i) vo[h][i] = (unsigned)((u.pm * BM + h * HALF + R[i]) * K + C[i]) * 2u;
    }
    __device__ __forceinline__ void a_raw(const Unit& u, const int (&R)[2], const int (&C)[2], unsigned (&vo)[2][2]) const { a_voff(u, R, C, vo); }
    __device__ __forceinline__ void a_fin(const unsigned (&raw)[2][2], const int (&C)[2], unsigned (&vo)[2][2]) const { vo[0][0] = raw[0][0]; vo[0][1] = raw[0][1]; vo[1][0] = raw[1][0]; vo[1][1] = raw[1][1]; }
    __device__ __forceinline__ const char* b_ptr(const Unit& u) const { return (const char*)Bt + (size_t)u.pn * BM * K * 2; }
};

__device__ __forceinline__ unsigned cvt_pk_bf16(float lo, float hi) { unsigned r; asm volatile("v_cvt_pk_bf16_f32 %0, %1, %2" : "=v"(r) : "v"(lo), "v"(hi)); return r; }

template <class Epi, class Sched, bool ALIGN_EPI = false, bool SP2 = false>
__device__ __forceinline__ void gemm_phase(PG8_LAS unsigned char* lds, const Gemm g, const Sched& S, const Epi& E) {
    const int tid = threadIdx.x, wid = __builtin_amdgcn_readfirstlane(tid >> 6), lane = tid & 63, wr = wid >> 2, wc = wid & 3, fr = lane & 15, fq = lane >> 4;
    const int K = g.K, nt = K / BK;
    int RA[2], CA[2]; unsigned voffB[2];
#pragma unroll
    for (int i = 0; i < 2; ++i) { int R, C; stage_rc(tid * 16 + i * 8192, R, C); const int Rb = Epi::PERM ? ((R & ~31) + perm32(R & 31)) : R;
        RA[i] = R; CA[i] = C; voffB[i] = (unsigned)(Rb * K + C) * 2u; }
    const size_t kstep = (size_t)(BK * 2);
    const size_t hstep = (size_t)HALF * K * 2;
    const unsigned ldsw = (unsigned)wid * 1024u;
    const int aoff = lds_byte(wr * 64 + fr, fq * 8), boff = lds_byte(wc * 32 + fr, fq * 8);
#define PG8_SA(b, h) (((b) * 2 + (h)) * HTB)
#define PG8_SB(b, h) ((4 + (b) * 2 + (h)) * HTB)
#define PG8_STAGE(bufoff, gbase, voff) do { _Pragma("unroll") for (int _i = 0; _i < 2; ++_i) \
        __builtin_amdgcn_global_load_lds((const unsigned*)((const char*)(gbase) + (voff)[_i]), (PG8_LAS unsigned*)(lds + (bufoff) + ldsw + _i * 8192), 16, 0, 0); } while (0)
#define PG8_LDA(dst, b, h) do { _Pragma("unroll") for (int m = 0; m < 4; ++m) _Pragma("unroll") for (int k = 0; k < 2; ++k) dst[m][k] = *(const PG8_LAS bf16x8*)(lds + PG8_SA(b, h) + aoff + m * 2048 + k * 1024); } while (0)
#define PG8_LDB(dst, b, h) do { _Pragma("unroll") for (int n = 0; n < 2; ++n) _Pragma("unroll") for (int k = 0; k < 2; ++k) dst[n][k] = *(const PG8_LAS bf16x8*)(lds + PG8_SB(b, h) + boff + n * 2048 + k * 1024); } while (0)
#define PG8_MMA(ai, bj, At, Bt) do { __builtin_amdgcn_s_setprio(1); _Pragma("unroll") for (int m = 0; m < 4; ++m) _Pragma("unroll") for (int n = 0; n < 2; ++n) _Pragma("unroll") for (int k = 0; k < 2; ++k) \
        acc[ai][bj][m][n] = __builtin_amdgcn_mfma_f32_16x16x32_bf16(Bt[n][k], At[m][k], acc[ai][bj][m][n], 0, 0, 0); __builtin_amdgcn_s_setprio(0); } while (0)
#define PG8_WAIT_V(n) asm volatile("s_waitcnt vmcnt(" #n ")" ::: "memory")
#define PG8_WAIT_L(n) asm volatile("s_waitcnt lgkmcnt(" #n ")" ::: "memory")
#define PG8_BAR __builtin_amdgcn_s_barrier()
#define PG8_SCHED __builtin_amdgcn_sched_barrier(0)
    Unit cur, nxt; int ui = 0;
    if (!S.next(0, cur)) return;
    f32x4 acc[2][2][4][2];
#pragma unroll
    for (int a = 0; a < 2; ++a)
#pragma unroll
        for (int b = 0; b < 2; ++b)
#pragma unroll
            for (int m = 0; m < 4; ++m)
#pragma unroll
                for (int n = 0; n < 2; ++n) acc[a][b][m][n] = (f32x4){0.f, 0.f, 0.f, 0.f};
    bf16x8 At[4][2], B0[2][2], B1[2][2];
    unsigned cvo[2][2], nvo[2][2];
    S.a_voff(cur, RA, CA, cvo);
    const char* const Ab = (const char*)g.A;
    const char* cB = S.b_ptr(cur);
    if constexpr (SP2) {
        PG8_STAGE(PG8_SB(0, 0), cB, voffB); PG8_STAGE(PG8_SB(0, 1), cB + hstep, voffB); PG8_STAGE(PG8_SA(0, 0), Ab, cvo[0]); PG8_STAGE(PG8_SA(0, 1), Ab, cvo[1]);
        if (wr == 1) PG8_BAR;
        PG8_WAIT_V(2); PG8_BAR;
        PG8_STAGE(PG8_SB(1, 0), cB + kstep, voffB); PG8_STAGE(PG8_SA(1, 0), Ab + kstep, cvo[0]); PG8_STAGE(PG8_SB(1, 1), cB + hstep + kstep, voffB);
        PG8_WAIT_V(6); PG8_BAR;
    } else {
        PG8_STAGE(PG8_SB(0, 0), cB, voffB); PG8_STAGE(PG8_SA(0, 0), Ab, cvo[0]); PG8_STAGE(PG8_SB(0, 1), cB + hstep, voffB); PG8_STAGE(PG8_SA(0, 1), Ab, cvo[1]);
        if (wr == 1) PG8_BAR;
        PG8_WAIT_V(4); PG8_BAR;
        PG8_STAGE(PG8_SB(1, 0), cB + kstep, voffB); PG8_STAGE(PG8_SA(1, 0), Ab + kstep, cvo[0]); PG8_STAGE(PG8_SB(1, 1), cB + hstep + kstep, voffB);
        PG8_WAIT_V(6); PG8_BAR;
    }
    for (;;) {
        const bool has_next = S.next(ui + 1, nxt);
        const char* nB = cB;
        unsigned nraw[2][2];
        if (has_next) { nB = S.b_ptr(nxt); S.a_raw(nxt, RA, CA, nraw); }
        else { nraw[0][0] = 0u; nraw[0][1] = 0u; nraw[1][0] = 0u; nraw[1][1] = 0u; }
        for (int t = 0; t < nt; t += 2) {
            const bool last = (t == nt - 2);
            const char* a1 = Ab + (size_t)(t + 1) * kstep;
            const char* a2 = last ? Ab : Ab + (size_t)(t + 2) * kstep; const char* b2 = last ? nB : cB + (size_t)(t + 2) * kstep;
            const char* a3 = a2 + kstep; const char* b3 = b2 + kstep;
            unsigned v2[2][2];
            if (last) { asm volatile("" : "+v"(nraw[0][0]), "+v"(nraw[0][1]), "+v"(nraw[1][0]), "+v"(nraw[1][1]));
                if (has_next) S.a_fin(nraw, CA, nvo); else { nvo[0][0] = cvo[0][0]; nvo[0][1] = cvo[0][1]; nvo[1][0] = cvo[1][0]; nvo[1][1] = cvo[1][1]; }
                v2[0][0] = nvo[0][0]; v2[0][1] = nvo[0][1]; v2[1][0] = nvo[1][0]; v2[1][1] = nvo[1][1]; }
            else { v2[0][0] = cvo[0][0]; v2[0][1] = cvo[0][1]; v2[1][0] = cvo[1][0]; v2[1][1] = cvo[1][1]; }
            if constexpr (SP2) {
            PG8_LDB(B0, 0, 0); PG8_LDB(B1, 0, 1); PG8_SCHED; PG8_LDA(At, 0, 0); PG8_STAGE(PG8_SA(1, 1), a1, cvo[1]);
            PG8_WAIT_V(8); PG8_WAIT_L(0); PG8_BAR; PG8_MMA(0, 0, At, B0); PG8_MMA(0, 1, At, B1); PG8_BAR; PG8_SCHED;
            PG8_LDA(At, 0, 1); PG8_STAGE(PG8_SB(0, 0), b2, voffB); PG8_STAGE(PG8_SB(0, 1), b2 + hstep, voffB); PG8_STAGE(PG8_SA(0, 0), a2, v2[0]);
            PG8_WAIT_V(8); PG8_WAIT_L(0); PG8_BAR; PG8_MMA(1, 0, At, B0); PG8_MMA(1, 1, At, B1); PG8_BAR; PG8_SCHED;
            PG8_LDB(B0, 1, 0); PG8_LDB(B1, 1, 1); PG8_SCHED; PG8_LDA(At, 1, 0); PG8_STAGE(PG8_SA(0, 1), a2, v2[1]);
            PG8_WAIT_V(8); PG8_WAIT_L(0); PG8_BAR; PG8_MMA(0, 0, At, B0); PG8_MMA(0, 1, At, B1); PG8_BAR; PG8_SCHED;
            PG8_LDA(At, 1, 1); PG8_STAGE(PG8_SB(1, 0), b3, voffB); PG8_STAGE(PG8_SB(1, 1), b3 + hstep, voffB); PG8_STAGE(PG8_SA(1, 0), a3, v2[0]);
            PG8_WAIT_V(8); PG8_WAIT_L(0); PG8_BAR; PG8_MMA(1, 0, At, B0); PG8_MMA(1, 1, At, B1); PG8_BAR; PG8_SCHED;
            } else {
            PG8_LDB(B0, 0, 0); PG8_SCHED; PG8_LDA(At, 0, 0); PG8_STAGE(PG8_SA(1, 1), a1, cvo[1]);
            PG8_WAIT_L(8); PG8_BAR; PG8_WAIT_L(0); PG8_MMA(0, 0, At, B0); PG8_BAR; PG8_SCHED;
            PG8_LDB(B1, 0, 1); PG8_STAGE(PG8_SB(0, 0), b2, voffB);
            PG8_BAR; PG8_WAIT_L(0); PG8_MMA(0, 1, At, B1); PG8_BAR;
            PG8_LDA(At, 0, 1); PG8_STAGE(PG8_SA(0, 0), a2, v2[0]);
            PG8_BAR; PG8_WAIT_L(0); PG8_MMA(1, 0, At, B0); PG8_BAR; PG8_SCHED;
            PG8_STAGE(PG8_SB(0, 1), b2 + hstep, voffB);
            PG8_WAIT_V(6); PG8_BAR; PG8_MMA(1, 1, At, B1); PG8_BAR;
            PG8_LDB(B0, 1, 0); PG8_SCHED; PG8_LDA(At, 1, 0); PG8_STAGE(PG8_SA(0, 1), a2, v2[1]);
            PG8_WAIT_L(8); PG8_BAR; PG8_WAIT_L(0); PG8_MMA(0, 0, At, B0); PG8_BAR; PG8_SCHED;
            PG8_LDB(B1, 1, 1); PG8_STAGE(PG8_SB(1, 0), b3, voffB);
            PG8_BAR; PG8_WAIT_L(0); PG8_MMA(0, 1, At, B1); PG8_BAR;
            PG8_LDA(At, 1, 1); PG8_STAGE(PG8_SA(1, 0), a3, v2[0]);
            PG8_BAR; PG8_WAIT_L(0); PG8_MMA(1, 0, At, B0); PG8_BAR; PG8_SCHED;
            PG8_STAGE(PG8_SB(1, 1), b3 + hstep, voffB);
            PG8_WAIT_V(6); PG8_BAR; PG8_MMA(1, 1, At, B1); PG8_BAR;
            }
        }
        if constexpr (ALIGN_EPI) { if (wr == 0) PG8_BAR; }
        E(acc, cur, wr, wc, fr, fq);
        if (!has_next) break;
#pragma unroll
        for (int a = 0; a < 2; ++a)
#pragma unroll
            for (int b = 0; b < 2; ++b)
#pragma unroll
                for (int m = 0; m < 4; ++m)
#pragma unroll
                    for (int n = 0; n < 2; ++n) acc[a][b][m][n] = (f32x4){0.f, 0.f, 0.f, 0.f};
        cur = nxt; cB = nB; ++ui;
        cvo[0][0] = nvo[0][0]; cvo[0][1] = nvo[0][1]; cvo[1][0] = nvo[1][0]; cvo[1][1] = nvo[1][1];
        if constexpr (ALIGN_EPI) { if (wr == 1) PG8_BAR; }
    }
    PG8_WAIT_V(0);
    if constexpr (!ALIGN_EPI) { if (wr == 0) PG8_BAR; }
    PG8_BAR;
#undef PG8_SA
#undef PG8_SB
#undef PG8_STAGE
#undef PG8_LDA
#undef PG8_LDB
#undef PG8_MMA
#undef PG8_WAIT_V
#undef PG8_WAIT_L
#undef PG8_BAR
#undef PG8_SCHED
}
}

constexpr int NWAVES = 8, NTHR = 512;
constexpr int T = 16384, D = 1024, SEQ = 4096, NB = 4;
constexpr int DIN = 3600, NMAIN = 3584;
constexpr int NE = 32, TOPK = 4, ECAP = 16384, MAXMT = 288;
constexpr float EPS = 1e-6f;
constexpr int MC_DNQ = 0, MC_DNK = 512, MC_DNV = 1024, MC_DNZ = 1536, MC_MLQ = 2048, MC_MLK = 2304, MC_MLV = 2560, MC_MLO = 3072;

constexpr size_t MiB = 1u << 20;
constexpr size_t WS_CTL = 0, CTL_ZERO_BYTES = 1 * MiB;
constexpr size_t WS_MOD = 1 * MiB;
constexpr size_t WS_MODF = WS_MOD + 128 * 1024;
constexpr size_t WS_WRT = WS_MOD + 256 * 1024;
constexpr size_t WS_WGT = WS_MOD + 384 * 1024;
constexpr size_t WS_BTIN = 2 * MiB;
constexpr size_t WS_BTOUT = 9 * MiB;
constexpr size_t WS_G16 = 11 * MiB;
constexpr size_t WS_TOKE = 12 * MiB;
constexpr size_t WS_TOKR = WS_TOKE + 256 * 1024;
constexpr size_t WS_TOKW = WS_TOKE + 512 * 1024;
constexpr size_t WS_SLOTTOK = 13 * MiB;
constexpr size_t WS_H = 16 * MiB;
constexpr size_t WS_MIX = 48 * MiB;
constexpr size_t WS_X1 = 80 * MiB;
constexpr size_t WS_BTGU = 144 * MiB;
constexpr size_t WS_BTDN = 272 * MiB;
constexpr size_t WS_PROJ = 336 * MiB;
constexpr size_t WS_RAW = 448 * MiB;
constexpr size_t WS_ACT = 336 * MiB;
constexpr size_t WS_Y = 480 * MiB;
constexpr size_t WS_DN_MP = 512 * MiB;
constexpr size_t WS_DN_UT = 544 * MiB;
constexpr size_t WS_DN_KC = 608 * MiB;
constexpr size_t WS_DN_WT = 624 * MiB;
constexpr size_t WS_DN_QD = 640 * MiB;
constexpr size_t WS_DN_QK = 656 * MiB;
constexpr size_t WS_DN_SD = 664 * MiB;
constexpr size_t WS_DN_ST = 666 * MiB;
constexpr size_t WS_ML_UPT = 698 * MiB;
constexpr size_t WS_ML_QC = 730 * MiB;
constexpr size_t WS_ML_KC = 738 * MiB;
constexpr size_t WS_ML_CT = 746 * MiB;
constexpr size_t WS_ML_AUX = 762 * MiB;
constexpr size_t WS_END = 764 * MiB;
constexpr int CW_BAR = 8192;
constexpr int CW_CNT = 1024;
constexpr int CW_CONV = 4096;

constexpr int RING_BYTES = 131072;
constexpr int LDSCTL_OFF = RING_BYTES;
constexpr int L_MISC = LDSCTL_OFF;
constexpr int L_CNT = LDSCTL_OFF + 256;
constexpr int L_TST = LDSCTL_OFF + 384;
constexpr int L_TILEE = LDSCTL_OFF + 576;
constexpr int L_EXTRA = LDSCTL_OFF + 2048;
constexpr int LDS_BYTES = 147456;

#define LAS __attribute__((address_space(3)))
typedef unsigned short bf16;
typedef unsigned v4u __attribute__((ext_vector_type(4)));
typedef unsigned v2u __attribute__((ext_vector_type(2)));
typedef float f32x4 __attribute__((ext_vector_type(4)));
#define LDS_WAIT() asm volatile("s_waitcnt lgkmcnt(0)" ::: "memory")
#define LDS_BARRIER() do { asm volatile("s_waitcnt lgkmcnt(0)" ::: "memory"); __builtin_amdgcn_s_barrier(); asm volatile("" ::: "memory"); } while (0)
__device__ __forceinline__ unsigned f2bf(float f) { unsigned u = __builtin_bit_cast(unsigned, f); return (u + 0x7fffu + ((u >> 16) & 1u)) >> 16; }
__device__ __forceinline__ unsigned pk2(float lo, float hi) { return f2bf(lo) | (f2bf(hi) << 16); }
__device__ __forceinline__ float bf2f(unsigned short b) { return __builtin_bit_cast(float, ((unsigned)b) << 16); }
__device__ __forceinline__ float sigmoidf_(float x) { return 1.0f / (1.0f + __expf(-x)); }
__device__ __forceinline__ float siluf_(float x) { return x / (1.0f + __expf(-x)); }
__device__ __forceinline__ float softplusf_(float x) { return x > 20.f ? x : log1pf(__expf(x)); }
__device__ __forceinline__ float logsigmoidf_(float x) { return x < 0.f ? x - log1pf(__expf(x)) : -log1pf(__expf(-x)); }

#define XB_TMO      128
#define XB_XCNT(j)  (256  + 64 * (j))
#define XB_XSUB(j)  (1280 + 64 * (j))
#define XB_XGEN(j)  (2304 + 64 * (j))
#define XB_TOP      3328
#define XB_TOPGEN   3392
#define XCD_BAR_WORDS 3456
#define XB_SPIN_CAP (1u << 18)
__device__ __forceinline__ unsigned xb_ld(unsigned* p)              { return __hip_atomic_load(p, __ATOMIC_RELAXED, __HIP_MEMORY_SCOPE_AGENT); }
__device__ __forceinline__ unsigned xb_add(unsigned* p, unsigned v) { return __hip_atomic_fetch_add(p, v, __ATOMIC_RELAXED, __HIP_MEMORY_SCOPE_AGENT); }
__device__ __forceinline__ unsigned xb_xcc_id() { return (unsigned)__builtin_amdgcn_s_getreg((3 << 11) | 20) & 0xFu; }
#define XB_SPIN(cond, bar) do { unsigned _sp = 0; while (cond) { __builtin_amdgcn_s_sleep(1); \
    if ((++_sp & 255u) == 0u) { if (xb_ld(&(bar)[XB_TMO])) break; if (_sp > XB_SPIN_CAP) { atomicAdd(&(bar)[XB_TMO], 1u); break; } } } } while (0)
struct XcdBarrier { unsigned* bar; unsigned x; volatile LAS unsigned* st; };
__device__ __forceinline__ XcdBarrier xcd_barrier_post(unsigned* bar, volatile LAS unsigned* st) {
    XcdBarrier b; b.bar = bar; b.x = xb_xcc_id(); b.st = st;
    if (threadIdx.x == 0) (void)xb_add(&bar[XB_XCNT(b.x)], 1u);
    return b;
}
__device__ __forceinline__ void xcd_barrier_complete(unsigned* bar, unsigned x, unsigned& nloc, unsigned& nx) {
    const unsigned G = gridDim.x * gridDim.y * gridDim.z;
    unsigned sum, cnt, mine, sp = 0u;
    for (;;) {
        sum = 0u; cnt = 0u; mine = 0u;
#pragma unroll
        for (unsigned j = 0; j < 16; ++j) { const unsigned c = xb_ld(&bar[XB_XCNT(j)]); sum += c; cnt += (c > 0u) ? 1u : 0u; mine = (j == x) ? c : mine; }
        if (sum == G) break;
        __builtin_amdgcn_s_sleep(1);
        if ((++sp & 255u) == 0u) { if (xb_ld(&bar[XB_TMO])) break; if (sp > XB_SPIN_CAP) { atomicAdd(&bar[XB_TMO], 1u); break; } }
    }
    nloc = mine > 0u ? mine : 1u; nx = cnt > 0u ? cnt : 1u;
}
__device__ __forceinline__ void xcd_barrier(const XcdBarrier& b) {
    asm volatile("s_waitcnt vmcnt(0)" ::: "memory");
    __syncthreads();
    if (threadIdx.x == 0) {
        unsigned* bar = b.bar;
        __builtin_amdgcn_s_waitcnt(0);
        unsigned nloc = b.st[0], nx = b.st[1];
        if (nloc == 0u) { xcd_barrier_complete(bar, b.x, nloc, nx); b.st[0] = nloc; b.st[1] = nx; }
        const unsigned old = xb_add(&bar[XB_XSUB(b.x)], 1u);
        const unsigned gen = old / nloc;
        if (old + 1u == (gen + 1u) * nloc) {
            __builtin_amdgcn_fence(__ATOMIC_RELEASE, "agent");
            asm volatile("s_waitcnt vmcnt(0)" ::: "memory");
            const unsigned og = xb_add(&bar[XB_TOP], 1u);
            const unsigned tg = og / nx;
            if (og + 1u == (tg + 1u) * nx) xb_add(&bar[XB_TOPGEN], 1u);
            else XB_SPIN(xb_ld(&bar[XB_TOPGEN]) == tg, bar);
            __builtin_amdgcn_fence(__ATOMIC_ACQUIRE, "agent");
            xb_add(&bar[XB_XGEN(b.x)], 1u);
            asm volatile("s_waitcnt vmcnt(0)" ::: "memory");
        } else {
            XB_SPIN(xb_ld(&bar[XB_XGEN(b.x)]) == gen, bar);
            __builtin_amdgcn_fence(__ATOMIC_ACQUIRE, "agent");
            asm volatile("s_waitcnt vmcnt(0)" ::: "memory");
        }
    }
    __syncthreads();
}

struct Args { const float* in[25]; float* out; unsigned char* ws; int ph_lo, ph_hi; };
struct InPtrs { const float* const* p; __device__ __forceinline__ const float* operator[](int i) const { const float* const* q = p; asm volatile("" : "+s"(q)); return q[i]; } };
struct Frame {
    LAS unsigned char* lds; unsigned char* ws; InPtrs in; float* out;
    int tid, lane, wave, vb, G;
};
enum { I_X = 0, I_C, I_WADA, I_BADA, I_NMIX, I_WIN, I_DNCONV, I_DNALOG, I_DNDT, I_DNNORM, I_MLCONV, I_MLIB, I_MLFB, I_MLNORM, I_WOUT, I_NFFN, I_WR, I_BR, I_WGU, I_BGU, I_WDN, I_BDN, I_WADAF, I_BADAF, I_NFIN };

__device__ __forceinline__ float wave_sum(float v) {
#pragma unroll
    for (int o = 1; o < 64; o <<= 1) v += __shfl_xor(v, o);
    return v;
}

__device__ __forceinline__ void transpose_item(const float* W, int ldw, int K, bf16* WT, int k0, int src_n0, int dst_n0, LAS float* scr, int lane) {
    float tv[32];
#pragma unroll
    for (int i = 0; i < 32; ++i) { const int kk = 2 * i + (lane >> 5); tv[i] = W[(size_t)(k0 + kk) * ldw + src_n0 + (lane & 31)]; }
#pragma unroll
    for (int i = 0; i < 32; ++i) { const int kk = 2 * i + (lane >> 5); scr[kk * 33 + (lane & 31)] = tv[i]; }
    LDS_WAIT(); asm volatile("" ::: "memory");
    const int c = lane & 7;
#pragma unroll
    for (int j = 0; j < 4; ++j) { const int n = (lane >> 3) + 8 * j; const LAS float* s = scr + (8 * c) * 33 + n;
        v4u o; o.x = pk2(s[0 * 33], s[1 * 33]); o.y = pk2(s[2 * 33], s[3 * 33]); o.z = pk2(s[4 * 33], s[5 * 33]); o.w = pk2(s[6 * 33], s[7 * 33]);
        *(v4u*)(WT + (size_t)(dst_n0 + n) * K + k0 + 8 * c) = o; }
    LDS_WAIT(); asm volatile("" ::: "memory");
}
__device__ __forceinline__ void p0_prologue(Frame& F) {
    __syncthreads();
    {
        LAS float* cond = (LAS float*)F.lds;
        LAS float* part = (LAS float*)(F.lds + 16384);
        const float* c = F.in[I_C];
        for (int i = F.tid; i < NB * D; i += NTHR) cond[i] = siluf_(c[i]);
        __syncthreads();
        for (int cb = F.vb; cb < 256; cb += F.G) {
            const int j0 = cb * 32; const bool fin = j0 >= 6144;
            const float* W = fin ? F.in[I_WADAF] : F.in[I_WADA]; const int ld = fin ? 2048 : 6144; const int jc = fin ? j0 - 6144 : j0;
            const float* bias = fin ? F.in[I_BADAF] : F.in[I_BADA];
            float* out = fin ? (float*)(F.ws + WS_MODF) : (float*)(F.ws + WS_MOD);
            const int s = F.tid >> 5, jj = F.tid & 31;
            float a0 = 0.f, a1 = 0.f, a2 = 0.f, a3 = 0.f;
            for (int k = s * 64; k < s * 64 + 64; ++k) { const float w = W[(size_t)k * ld + jc + jj]; a0 += cond[k] * w; a1 += cond[1024 + k] * w; a2 += cond[2048 + k] * w; a3 += cond[3072 + k] * w; }
            part[(s * 4 + 0) * 32 + jj] = a0; part[(s * 4 + 1) * 32 + jj] = a1; part[(s * 4 + 2) * 32 + jj] = a2; part[(s * 4 + 3) * 32 + jj] = a3;
            __syncthreads();
            if (F.tid < 128) { const int b = F.tid >> 5, j = F.tid & 31; float sum = 0.f;
                for (int q = 0; q < 16; ++q) sum += part[(q * 4 + b) * 32 + j];
                out[b * ld + jc + j] = sum + bias[jc + j]; }
            __syncthreads();
        }
    }
    {
        const int gt = F.vb * NTHR + F.tid, NGT = F.G * NTHR;
        float* wrT = (float*)(F.ws + WS_WRT); const float* wr = F.in[I_WR];
        for (int i = gt; i < NE * D; i += NGT) { const int e = i >> 10, k = i & 1023; wrT[i] = wr[k * NE + e]; }
        float* wgT = (float*)(F.ws + WS_WGT); const float* win = F.in[I_WIN];
        for (int i = gt; i < 16 * D; i += NGT) { const int g = i >> 10, k = i & 1023; const int col = g < 8 ? 2048 + g : 3592 + (g - 8); wgT[i] = win[(size_t)k * DIN + col]; }
    }
    {
        LAS float* scr = (LAS float*)(F.lds + F.wave * 16384);
        const int gw = F.vb * NWAVES + F.wave, NGW = F.G * NWAVES;
        constexpr int I_IN = 16 * (NMAIN / 32), I_OUT = 16 * 32;
        for (int it = gw; it < I_IN + I_OUT; it += NGW) {
            int r = it;
            if (r < I_IN) { const int nblk = NMAIN / 32, kb = r / nblk, nb = r % nblk; const int dn0 = nb * 32, sn0 = dn0 < 2048 ? dn0 : dn0 + 8;
                transpose_item(F.in[I_WIN], DIN, D, (bf16*)(F.ws + WS_BTIN), kb * 64, sn0, dn0, scr, F.lane); continue; }
            r -= I_IN;
            { const int kb = r / 32, nb = r % 32; transpose_item(F.in[I_WOUT], D, D, (bf16*)(F.ws + WS_BTOUT), kb * 64, nb * 32, nb * 32, scr, F.lane); }
        }
    }
}
__device__ __forceinline__ void convert_moe(Frame& F) {
    LAS float* scr = (LAS float*)(F.lds + F.wave * 16384);
    volatile LAS int* claim = (volatile LAS int*)(F.lds + L_MISC) + 16;
    unsigned* ctr = (unsigned*)(F.ws + WS_CTL) + CW_CONV;
    constexpr int I_GU1 = 16 * 64, I_DN1 = 16 * 32, NITEMS = NE * (I_GU1 + I_DN1);
    for (;;) {
        __syncthreads();
        if (F.tid == 0) claim[0] = (int)__hip_atomic_fetch_add(ctr, 64u, __ATOMIC_RELAXED, __HIP_MEMORY_SCOPE_AGENT);
        __syncthreads();
        const int base = claim[0];
        if (base >= NITEMS) break;
#pragma unroll 1
        for (int q8 = 0; q8 < 8; ++q8) {
            int r = base + q8 * 8 + F.wave;
            if (r < NE * I_GU1) { const int e = r / I_GU1, q = r % I_GU1, kb = q / 64, nb = q % 64; const int dn0 = nb * 32;
                const int sn0 = ((dn0 & 255) >> 7) * 1024 + (dn0 >> 8) * 128 + (dn0 & 127);
                transpose_item(F.in[I_WGU] + (size_t)e * D * 2048, 2048, D, (bf16*)(F.ws + WS_BTGU) + (size_t)e * 2048 * D, kb * 64, sn0, dn0, scr, F.lane); continue; }
            r -= NE * I_GU1;
            { const int e = r / I_DN1, q = r % I_DN1, kb = q / 32, nb = q % 32;
                transpose_item(F.in[I_WDN] + (size_t)e * D * D, D, D, (bf16*)(F.ws + WS_BTDN) + (size_t)e * D * D, kb * 64, nb * 32, nb * 32, scr, F.lane); }
        }
    }
}

#define MR_STEP(n, bit) { const bool hi = (lane & (bit)) != 0; _Pragma("unroll") for (int i = 0; i < (n) / 2; ++i) { const float send = hi ? v[i] : v[i + (n) / 2]; const float keep = hi ? v[i + (n) / 2] : v[i]; v[i] = keep + __shfl_xor(send, (bit)); } }
template <int N> __device__ __forceinline__ float multi_reduce(float (&v)[N], int lane) {
    float r;
    if constexpr (N == 32) { MR_STEP(32, 32) MR_STEP(16, 16) MR_STEP(8, 8) MR_STEP(4, 4) MR_STEP(2, 2) r = v[0]; r += __shfl_xor(r, 1); }
    else { MR_STEP(16, 32) MR_STEP(8, 16) MR_STEP(4, 8) MR_STEP(2, 4) r = v[0]; r += __shfl_xor(r, 2); r += __shfl_xor(r, 1); }
    return r;
}

__device__ __forceinline__ void p1_norm1(Frame& F) {
    LAS float* wg = (LAS float*)F.lds;
    { const float* src = (const float*)(F.ws + WS_WGT); for (int i = F.tid; i < 16 * D / 4; i += NTHR) ((LAS f32x4*)wg)[i] = ((const f32x4*)src)[i]; }
    __syncthreads();
    const float* x = F.in[I_X]; const float* nw = F.in[I_NMIX]; const float* mod = (const float*)(F.ws + WS_MOD);
    bf16* h1 = (bf16*)(F.ws + WS_H); float* g16 = (float*)(F.ws + WS_G16);
    const int gw = F.vb * NWAVES + F.wave, NGW = F.G * NWAVES;
    for (int row = gw; row < T; row += NGW) {
        const int b = row / SEQ;
        const f32x4* xr = (const f32x4*)(x + (size_t)row * D) + F.lane;
        f32x4 v[4]; float ss = 0.f;
#pragma unroll
        for (int j = 0; j < 4; ++j) { v[j] = xr[64 * j]; ss += (v[j].x * v[j].x + v[j].y * v[j].y) + (v[j].z * v[j].z + v[j].w * v[j].w); }
        const float rstd = rsqrtf(wave_sum(ss) * (1.f / D) + EPS);
        const float* sh = mod + b * 6144; const float* sc = sh + 1024;
#pragma unroll
        for (int j = 0; j < 4; ++j) { const int k = 256 * j + F.lane * 4;
            const f32x4 w = *(const f32x4*)(nw + k), s1 = *(const f32x4*)(sc + k), s0 = *(const f32x4*)(sh + k);
            v[j] = (v[j] * rstd * w) * (1.0f + s1) + s0; }
        v2u* o8 = (v2u*)(h1 + (size_t)row * D) + F.lane;
#pragma unroll
        for (int j = 0; j < 4; ++j) { v2u o; o.x = pk2(v[j].x, v[j].y); o.y = pk2(v[j].z, v[j].w); o8[64 * j] = o; }
        float acc[16];
#pragma unroll
        for (int g = 0; g < 16; ++g) { float a = 0.f;
#pragma unroll
            for (int j = 0; j < 4; ++j) { const f32x4 w = *(const LAS f32x4*)(wg + g * 1024 + 256 * j + F.lane * 4); a += (v[j].x * w.x + v[j].y * w.y) + (v[j].z * w.z + v[j].w * w.w); }
            acc[g] = a; if (g & 1) asm volatile("" ::: "memory"); }
        const float r = multi_reduce<16>(acc, F.lane);
        if ((F.lane & 3) == 0) g16[(size_t)row * 16 + (F.lane >> 2)] = r;
    }
}

struct EpiProj {
    static constexpr bool PERM = true;
    bf16* O; int ldc;
    __device__ __forceinline__ void operator()(const pg8::f32x4 (&acc)[2][2][4][2], const pg8::Unit& u, int wr, int wc, int fr, int fq) const {
        const int row0 = u.pm * 256 + wr * 64 + fr, col0 = u.pn * 256 + wc * 32 + 8 * fq;
#pragma unroll
        for (int ai = 0; ai < 2; ++ai)
#pragma unroll
            for (int m = 0; m < 4; ++m) { bf16* rowp = O + (size_t)(row0 + ai * 128 + m * 16) * ldc + col0;
#pragma unroll
                for (int bj = 0; bj < 2; ++bj) { const pg8::f32x4 v0 = acc[ai][bj][m][0], v1 = acc[ai][bj][m][1];
                    v4u w; w.x = pg8::cvt_pk_bf16(v0[0], v0[1]); w.y = pg8::cvt_pk_bf16(v0[2], v0[3]); w.z = pg8::cvt_pk_bf16(v1[0], v1[1]); w.w = pg8::cvt_pk_bf16(v1[2], v1[3]);
                    *(v4u*)(rowp + bj * 128) = w; } }
    }
};
struct EpiRes {
    static constexpr bool PERM = false;
    const float* X; float* O; const float* mod;
    __device__ __forceinline__ void operator()(const pg8::f32x4 (&acc)[2][2][4][2], const pg8::Unit& u, int wr, int wc, int fr, int fq) const {
        const int row0 = u.pm * 256 + wr * 64 + fr, col0 = u.pn * 256 + wc * 32 + 4 * fq;
        const int b = (u.pm * 256) / SEQ; const float* g1 = mod + b * 6144 + 2048;
        pg8::f32x4 gv[2][2];
#pragma unroll
        for (int bj = 0; bj < 2; ++bj)
#pragma unroll
            for (int n = 0; n < 2; ++n) gv[bj][n] = *(const pg8::f32x4*)(g1 + col0 + bj * 128 + n * 16);
#pragma unroll
        for (int ai = 0; ai < 2; ++ai)
#pragma unroll
            for (int m = 0; m < 4; ++m) { const size_t off = (size_t)(row0 + ai * 128 + m * 16) * D + col0;
#pragma unroll
                for (int bj = 0; bj < 2; ++bj)
#pragma unroll
                    for (int n = 0; n < 2; ++n) { const pg8::f32x4 xv = *(const pg8::f32x4*)(X + off + bj * 128 + n * 16);
                        *(pg8::f32x4*)(O + off + bj * 128 + n * 16) = xv + gv[bj][n] * acc[ai][bj][m][n]; }
                asm volatile("" ::: "memory"); }
    }
};
struct EpiGU {
    static constexpr bool PERM = true;
    bf16* O; const float* bgu;
    __device__ __forceinline__ void operator()(const pg8::f32x4 (&acc)[2][2][4][2], const pg8::Unit& u, int wr, int wc, int fr, int fq) const {
        const int row0 = u.pm * 256 + wr * 64 + fr, cc = u.pn * 128 + wc * 32 + 8 * fq;
        const float* bg = bgu + (size_t)u.e * 2048 + cc; const float* bu = bg + 1024;
        pg8::f32x4 bgv[2], buv[2];
#pragma unroll
        for (int n = 0; n < 2; ++n) { bgv[n] = *(const pg8::f32x4*)(bg + 4 * n); buv[n] = *(const pg8::f32x4*)(bu + 4 * n); }
#pragma unroll
        for (int ai = 0; ai < 2; ++ai)
#pragma unroll
            for (int m = 0; m < 4; ++m) { bf16* rowp = O + (size_t)(row0 + ai * 128 + m * 16) * D + cc;
                float r[8];
#pragma unroll
                for (int n = 0; n < 2; ++n)
#pragma unroll
                    for (int j = 0; j < 4; ++j) { float gt = acc[ai][0][m][n][j] + bgv[n][j], up = acc[ai][1][m][n][j] + buv[n][j];
                        gt = fminf(gt, 7.0f); up = fminf(fmaxf(up, -7.0f), 7.0f);
                        r[n * 4 + j] = (up + 1.0f) * gt * sigmoidf_(1.702f * gt); }
                v4u w; w.x = pg8::cvt_pk_bf16(r[0], r[1]); w.y = pg8::cvt_pk_bf16(r[2], r[3]); w.z = pg8::cvt_pk_bf16(r[4], r[5]); w.w = pg8::cvt_pk_bf16(r[6], r[7]);
                *(v4u*)rowp = w; }
    }
};
struct EpiDown {
    static constexpr bool PERM = true;
    bf16* O; const float* bdn;
    __device__ __forceinline__ void operator()(const pg8::f32x4 (&acc)[2][2][4][2], const pg8::Unit& u, int wr, int wc, int fr, int fq) const {
        const int row0 = u.pm * 256 + wr * 64 + fr, col0 = u.pn * 256 + wc * 32 + 8 * fq;
        const float* bb = bdn + (size_t)u.e * D + col0;
        pg8::f32x4 bv[2][2];
#pragma unroll
        for (int bj = 0; bj < 2; ++bj)
#pragma unroll
            for (int n = 0; n < 2; ++n) bv[bj][n] = *(const pg8::f32x4*)(bb + bj * 128 + 4 * n);
#pragma unroll
        for (int ai = 0; ai < 2; ++ai)
#pragma unroll
            for (int m = 0; m < 4; ++m) { bf16* rowp = O + (size_t)(row0 + ai * 128 + m * 16) * D + col0;
#pragma unroll
                for (int bj = 0; bj < 2; ++bj) { const pg8::f32x4 v0 = acc[ai][bj][m][0] + bv[bj][0], v1 = acc[ai][bj][m][1] + bv[bj][1];
                    v4u w; w.x = pg8::cvt_pk_bf16(v0[0], v0[1]); w.y = pg8::cvt_pk_bf16(v0[2], v0[3]); w.z = pg8::cvt_pk_bf16(v1[0], v1[1]); w.w = pg8::cvt_pk_bf16(v1[2], v1[3]);
                    *(v4u*)(rowp + bj * 128) = w; } }
    }
};

template <int MB, int NBK, bool GATHER> struct GroupedOrder {
    int G, c, nmt, K; const LAS int* tileE; const LAS int* tst; const LAS int* cnt; const int* slot_tok; const bf16* Bt; size_t bexp; LAS unsigned* tokbuf;
    __device__ bool next(int i, pg8::Unit& u) const {
        const int nwg = nmt * NBK; const long L = (long)i * G + c; if (L >= nwg) return false;
        int U = (int)L; { const int q = nwg / 8, r = nwg % 8, xcd = U % 8, off = U / 8; U = (xcd < r ? xcd * (q + 1) : r * (q + 1) + (xcd - r) * q) + off; }
        const int nig = MB * NBK, gid = U / nig, fm = gid * MB, gsz = (nmt - fm) < MB ? (nmt - fm) : MB;
        u.pm = fm + ((U % nig) % gsz); u.pn = (U % nig) / gsz; u.e = tileE[u.pm]; return true;
    }
    __device__ __forceinline__ void a_voff(const pg8::Unit& u, const int (&R)[2], const int (&C)[2], unsigned (&vo)[2][2]) const {
        if (GATHER) {
            const int r0 = (u.pm - tst[u.e]) * 256, ce = cnt[u.e];
#pragma unroll
            for (int h = 0; h < 2; ++h)
#pragma unroll
                for (int i = 0; i < 2; ++i) { int rk = r0 + h * 128 + R[i]; rk = rk < ce ? rk : ce - 1; const int tok = slot_tok[u.e * ECAP + rk];
                    vo[h][i] = (unsigned)(tok * K + C[i]) * 2u; }
        } else {
#pragma unroll
            for (int h = 0; h < 2; ++h)
#pragma unroll
                for (int i = 0; i < 2; ++i) vo[h][i] = (unsigned)((u.pm * 256 + h * 128 + R[i]) * K + C[i]) * 2u;
        }
    }
    __device__ __forceinline__ void a_raw(const pg8::Unit& u, const int (&R)[2], const int (&C)[2], unsigned (&raw)[2][2]) const {
        if (GATHER) {
            const int r0 = (u.pm - tst[u.e]) * 256, ce = cnt[u.e];
#pragma unroll
            for (int h = 0; h < 2; ++h)
#pragma unroll
                for (int i = 0; i < 2; ++i) { int rk = r0 + h * 128 + R[i]; rk = rk < ce ? rk : ce - 1; raw[h][i] = 0u;
                    __builtin_amdgcn_global_load_lds((const unsigned*)(slot_tok + u.e * ECAP + rk), (LAS unsigned*)(tokbuf + (h * 2 + i) * 64), 4, 0, 0); }
        } else a_voff(u, R, C, raw);
    }
    __device__ __forceinline__ void a_fin(const unsigned (&raw)[2][2], const int (&C)[2], unsigned (&vo)[2][2]) const {
#pragma unroll
        for (int h = 0; h < 2; ++h)
#pragma unroll
            for (int i = 0; i < 2; ++i) vo[h][i] = GATHER ? (tokbuf[(h * 2 + i) * 64 + (threadIdx.x & 63)] * (unsigned)K + (unsigned)C[i]) * 2u : raw[h][i];
    }
    __device__ __forceinline__ const char* b_ptr(const pg8::Unit& u) const { return (const char*)(Bt + (size_t)u.e * bexp + (size_t)u.pn * 256 * K); }
};

__device__ __forceinline__ int build_expert_tables(Frame& F) {
    LAS int* lc = (LAS int*)(F.lds + L_CNT); LAS int* lt = (LAS int*)(F.lds + L_TST); LAS int* le = (LAS int*)(F.lds + L_TILEE);
    const unsigned* gc = (const unsigned*)(F.ws + WS_CTL) + CW_CNT;
    __syncthreads();
    if (F.tid < 64) {
        int c = 0; if (F.lane < NE) { c = (int)__hip_atomic_load(gc + 64 * F.lane, __ATOMIC_RELAXED, __HIP_MEMORY_SCOPE_AGENT); if (c > ECAP) c = ECAP; }
        const int nt = (c + 255) >> 8; int incl = nt;
#pragma unroll
        for (int o = 1; o < 32; o <<= 1) { const int v = __shfl_up(incl, o); if (F.lane >= o) incl += v; }
        const int excl = incl - nt;
        if (F.lane < NE) { lc[F.lane] = c; lt[F.lane] = excl; for (int i = 0; i < nt; ++i) le[excl + i] = F.lane; }
        if (F.lane == NE - 1) lt[NE] = incl;
    }
    __syncthreads();
    return lt[NE];
}

__device__ __forceinline__ void p3_naive_dn(Frame& F, int bh) {
    const int b = bh >> 2, h = bh & 3;
    LAS float* qs_ = (LAS float*)F.lds;
    LAS float* ks_ = qs_ + 64 * 128;
    LAS float* vs_ = ks_ + 64 * 128;
    LAS float* qsc = vs_ + 64 * 128;
    LAS float* ksc = qsc + 64; LAS float* bet = ksc + 64; LAS float* ade = bet + 64;
    const bf16* proj = (const bf16*)(F.ws + WS_PROJ); const float* g16 = (const float*)(F.ws + WS_G16);
    const float* cw = F.in[I_DNCONV]; float* raw = (float*)(F.ws + WS_RAW);
    const float Aexp = __expf(F.in[I_DNALOG][h]), dtb = F.in[I_DNDT][h];
    const int e = F.tid >> 2, ds = F.tid & 3, d0 = ds * 32;
    float S[32];
#pragma unroll
    for (int i = 0; i < 32; ++i) S[i] = 0.f;
    for (int n = 0; n < 64; ++n) {
        __syncthreads();
        for (int idx = F.tid; idx < 64 * 384; idx += NTHR) {
            const int i = idx / 384, c = idx % 384, which = c >> 7, cc = c & 127, col = which * 512 + h * 128 + cc;
            const int t = n * 64 + i; float a = 0.f;
#pragma unroll
            for (int j = 0; j < 4; ++j) { const int tt = t - 3 + j; if (tt >= 0) a += bf2f(proj[(size_t)(b * SEQ + tt) * NMAIN + col]) * cw[j * 1536 + col]; }
            (which == 0 ? qs_ : which == 1 ? ks_ : vs_)[i * 128 + cc] = siluf_(a);
        }
        if (F.tid < 64) { const size_t row = (size_t)b * SEQ + n * 64 + F.tid;
            bet[F.tid] = sigmoidf_(g16[row * 16 + h]); ade[F.tid] = __expf(-Aexp * softplusf_(g16[row * 16 + 4 + h] + dtb)); }
        __syncthreads();
        if (F.tid < 128) { const int i = F.tid & 63, which = F.tid >> 6; const LAS float* p = (which ? ks_ : qs_) + i * 128; float ss = 0.f;
            for (int c = 0; c < 128; ++c) ss += p[c] * p[c];
            const float sc = rsqrtf(ss + EPS); if (which) ksc[i] = sc; else qsc[i] = sc * 0.08838834764831845f; }
        __syncthreads();
        for (int i = 0; i < 64; ++i) {
            const float kscale = ksc[i], qscale = qsc[i], be = bet[i], a = ade[i];
            const LAS float* kp = ks_ + i * 128 + d0; const LAS float* qp = qs_ + i * 128 + d0;
            float kv[32]; float p = 0.f;
#pragma unroll
            for (int d = 0; d < 32; ++d) { kv[d] = kp[d] * kscale; p += kv[d] * S[d]; }
            p += __shfl_xor(p, 1); p += __shfl_xor(p, 2);
            const float uu = be * (vs_[i * 128 + e] - a * p);
            float o = 0.f;
#pragma unroll
            for (int d = 0; d < 32; ++d) { S[d] = a * S[d] + kv[d] * uu; o += qp[d] * S[d]; }
            o *= qscale; o += __shfl_xor(o, 1); o += __shfl_xor(o, 2);
            if (ds == 0) raw[((size_t)b * SEQ + n * 64 + i) * D + h * 128 + e] = o;
        }
    }
}
__device__ __forceinline__ void p3_naive_ml(Frame& F, int bh) {
    const int b = bh >> 2, h = bh & 3;
    LAS float* qs_ = (LAS float*)F.lds;
    LAS float* ks_ = qs_ + 64 * 64;
    LAS float* vs_ = ks_ + 64 * 64;
    LAS float* ipr = vs_ + 64 * 128; LAS float* lgf = ipr + 64;
    const bf16* proj = (const bf16*)(F.ws + WS_PROJ); const float* g16 = (const float*)(F.ws + WS_G16);
    const float* cw = F.in[I_MLCONV]; float* raw = (float*)(F.ws + WS_RAW);
    const float ib = F.in[I_MLIB][h], fb = F.in[I_MLFB][h];
    const int e = F.tid >> 2, ds = F.tid & 3, d0 = ds * 16;
    float C[16], nn[16]; float m = 0.f;
#pragma unroll
    for (int i = 0; i < 16; ++i) { C[i] = 0.f; nn[i] = 0.f; }
    for (int n = 0; n < 64; ++n) {
        __syncthreads();
        for (int idx = F.tid; idx < 64 * 128; idx += NTHR) {
            const int i = idx >> 7, c = idx & 127, which = c >> 6, cc = c & 63, ch = which * 256 + h * 64 + cc;
            const int t = n * 64 + i; float a = 0.f;
#pragma unroll
            for (int j = 0; j < 4; ++j) { const int tt = t - 3 + j; if (tt >= 0) a += bf2f(proj[(size_t)(b * SEQ + tt) * NMAIN + MC_MLQ + ch]) * cw[j * 512 + ch]; }
            const float y = siluf_(a);
            if (which == 0) qs_[i * 64 + cc] = y * 0.125f; else ks_[i * 64 + cc] = y;
        }
        for (int idx = F.tid; idx < 64 * 128; idx += NTHR) { const int i = idx >> 7, c = idx & 127;
            vs_[idx] = bf2f(proj[(size_t)(b * SEQ + n * 64 + i) * NMAIN + MC_MLV + h * 128 + c]); }
        if (F.tid < 64) { const size_t row = (size_t)b * SEQ + n * 64 + F.tid;
            ipr[F.tid] = g16[row * 16 + 8 + h] + ib; lgf[F.tid] = logsigmoidf_(g16[row * 16 + 12 + h] + fb); }
        __syncthreads();
        for (int i = 0; i < 64; ++i) {
            const float lf = lgf[i], ip = ipr[i];
            const float mn = fmaxf(lf + m, ip), fp = __expf(lf + m - mn), iq = __expf(ip - mn); m = mn;
            const LAS float* kp = ks_ + i * 64 + d0; const LAS float* qp = qs_ + i * 64 + d0;
            const float vv = vs_[i * 128 + e] * iq;
            float num = 0.f, den = 0.f;
#pragma unroll
            for (int d = 0; d < 16; ++d) { const float kk = kp[d], qq = qp[d]; C[d] = fp * C[d] + kk * vv; nn[d] = fp * nn[d] + iq * kk; num += qq * C[d]; den += qq * nn[d]; }
            num += __shfl_xor(num, 1); num += __shfl_xor(num, 2); den += __shfl_xor(den, 1); den += __shfl_xor(den, 2);
            const float hh = num / fmaxf(fabsf(den), __expf(-m));
            if (ds == 0) raw[((size_t)b * SEQ + n * 64 + i) * D + 512 + h * 128 + e] = hh;
        }
    }
}

typedef short bf16x8_t __attribute__((ext_vector_type(8)));
template <int K> __device__ __forceinline__ f32x4 tile_mma(const LAS bf16* A, int lda, const LAS bf16* Bt, int ldb, int m0, int n0, int lane, f32x4 acc) {
    const int r = lane & 15, kq = (lane >> 4) * 8;
    const LAS bf16* ap = A + (m0 + r) * lda + kq; const LAS bf16* bp = Bt + (n0 + r) * ldb + kq;
#pragma unroll
    for (int k = 0; k < K; k += 32) { const bf16x8_t a = *(const LAS bf16x8_t*)(ap + k); const bf16x8_t b = *(const LAS bf16x8_t*)(bp + k);
        acc = __builtin_amdgcn_mfma_f32_16x16x32_bf16(a, b, acc, 0, 0, 0); }
    return acc;
}
__device__ __forceinline__ v2u pk4(f32x4 v) { v2u o; o.x = pk2(v.x, v.y); o.y = pk2(v.z, v.w); return o; }

__device__ __forceinline__ void dn_prep(Frame& F, int ch) {
    const int bh = ch >> 6, n = ch & 63, b = bh >> 2, h = bh & 3;
    const size_t row0 = (size_t)b * SEQ + n * 64;
    LAS bf16* kN = (LAS bf16*)(F.lds + 0);
    LAS bf16* qN = (LAS bf16*)(F.lds + 17408);
    LAS bf16* solT = (LAS bf16*)(F.lds + 0);
    LAS bf16* rhsT = (LAS bf16*)(F.lds + 36864);
    LAS bf16* kdT = (LAS bf16*)(F.lds + 73728);
    LAS bf16* Tm = (LAS bf16*)(F.lds + 92160);
    LAS float* Lm = (LAS float*)(F.lds + 101376);
    LAS float* gb = (LAS float*)(F.lds + 118784);
    LAS bf16* vN = (LAS bf16*)(F.lds + 101376);
    LAS float* cwL = (LAS float*)(F.lds + 119808);
    LAS bf16* Lb = (LAS bf16*)(F.lds + L_EXTRA);
    LAS bf16* TT = (LAS bf16*)(F.lds + 0);
    LAS bf16* XT = (LAS bf16*)(F.lds + 9216);
    const bf16* proj = (const bf16*)(F.ws + WS_PROJ); const float* g16 = (const float*)(F.ws + WS_G16); const float* cw = F.in[I_DNCONV];
    bf16* gMp = (bf16*)(F.ws + WS_DN_MP) + (size_t)ch * 16384; bf16* gUT = (bf16*)(F.ws + WS_DN_UT) + (size_t)ch * 16384;
    bf16* gKC = (bf16*)(F.ws + WS_DN_KC) + (size_t)ch * 8192; bf16* gWT = (bf16*)(F.ws + WS_DN_WT) + (size_t)ch * 8192;
    bf16* gQD = (bf16*)(F.ws + WS_DN_QD) + (size_t)ch * 8192; bf16* gQK = (bf16*)(F.ws + WS_DN_QK) + (size_t)ch * 4096;
    int tidA = F.tid; asm volatile("" : "+v"(tidA));
    const int lane = tidA & 63, w = F.wave, r = lane & 15, q4 = (lane >> 4) * 4;
    LDS_BARRIER();
    if (w == 0) {
        const float* g = g16 + (row0 + lane) * 16;
        const float be = sigmoidf_(g[h]); float G = -__expf(F.in[I_DNALOG][h]) * softplusf_(g[4 + h] + F.in[I_DNDT][h]);
#pragma unroll
        for (int o = 1; o < 64; o <<= 1) { const float v = __shfl_up(G, o); if (lane >= o) G += v; }
        const float Gl = __shfl(G, 63);
        gb[lane] = be; gb[64 + lane] = G; gb[128 + lane] = __expf(G); gb[192 + lane] = __expf(Gl - G);
        if (lane == 0) ((float*)(F.ws + WS_DN_SD))[ch] = __expf(Gl);
    }
    for (int idx = tidA; idx < 1536; idx += NTHR) { const int j = idx / 384, c = idx % 384; cwL[idx] = cw[j * 1536 + (c >> 7) * 512 + h * 128 + (c & 127)]; }
    LDS_BARRIER();
#pragma unroll 1
    for (int which = 0; which < 3; ++which) {
        v4u raw[2][4];
#pragma unroll
        for (int i2 = 0; i2 < 2; ++i2) { const int item = i2 * 512 + tidA, i = item >> 4, cg = item & 15, col = which * 512 + h * 128 + cg * 8;
#pragma unroll
            for (int j = 0; j < 4; ++j) { const int tt = n * 64 + i - 3 + j; raw[i2][j] = (v4u){0u, 0u, 0u, 0u};
                if (tt >= 0) raw[i2][j] = *(const v4u*)(proj + ((size_t)b * SEQ + tt) * NMAIN + col); } }
        LAS bf16* dstN = (which == 0 ? qN : which == 1 ? kN : vN);
#pragma unroll
        for (int i2 = 0; i2 < 2; ++i2) { const int item = i2 * 512 + tidA, i = item >> 4, cg = item & 15;
            float y[8];
#pragma unroll
            for (int e = 0; e < 8; ++e) y[e] = 0.f;
#pragma unroll
            for (int j = 0; j < 4; ++j) { const v4u rw = raw[i2][j];
                const f32x4 w0 = *(const LAS f32x4*)(cwL + j * 384 + which * 128 + cg * 8), w1 = *(const LAS f32x4*)(cwL + j * 384 + which * 128 + cg * 8 + 4);
                y[0] += bf2f(rw.x & 0xffff) * w0.x; y[1] += bf2f(rw.x >> 16) * w0.y; y[2] += bf2f(rw.y & 0xffff) * w0.z; y[3] += bf2f(rw.y >> 16) * w0.w;
                y[4] += bf2f(rw.z & 0xffff) * w1.x; y[5] += bf2f(rw.z >> 16) * w1.y; y[6] += bf2f(rw.w & 0xffff) * w1.z; y[7] += bf2f(rw.w >> 16) * w1.w; }
            float ss = 0.f;
#pragma unroll
            for (int e = 0; e < 8; ++e) { y[e] = siluf_(y[e]); ss += y[e] * y[e]; }
            ss += __shfl_xor(ss, 1); ss += __shfl_xor(ss, 2); ss += __shfl_xor(ss, 4); ss += __shfl_xor(ss, 8);
            float sc = 1.0f; if (which == 0) sc = rsqrtf(ss + EPS) * 0.08838834764831845f; if (which == 1) sc = rsqrtf(ss + EPS);
            v4u o; o.x = pk2(y[0] * sc, y[1] * sc); o.y = pk2(y[2] * sc, y[3] * sc); o.z = pk2(y[4] * sc, y[5] * sc); o.w = pk2(y[6] * sc, y[7] * sc);
            *(LAS v4u*)(dstN + i * 136 + cg * 8) = o;
            if (which == 0) { const float s2 = sc * gb[128 + i]; v4u o2; o2.x = pk2(y[0] * s2, y[1] * s2); o2.y = pk2(y[2] * s2, y[3] * s2); o2.z = pk2(y[4] * s2, y[5] * s2); o2.w = pk2(y[6] * s2, y[7] * s2);
                *(v4u*)(gQD + i * 128 + cg * 8) = o2; }
        }
    }
    LDS_BARRIER();
    {
        const int c = tidA & 127, tq = tidA >> 7;
#pragma unroll
        for (int g4 = 0; g4 < 4; ++g4) { const int i0 = tq * 16 + g4 * 4;
            const f32x4 be = *(const LAS f32x4*)(gb + i0), eG = *(const LAS f32x4*)(gb + 128 + i0), kd = *(const LAS f32x4*)(gb + 192 + i0);
            f32x4 kv, vv;
#pragma unroll
            for (int x = 0; x < 4; ++x) { kv[x] = bf2f(kN[(i0 + x) * 136 + c]); vv[x] = bf2f(vN[(i0 + x) * 136 + c]); }
            *(LAS v2u*)(rhsT + (128 + c) * 72 + i0) = pk4(kv * be * eG);
            *(LAS v2u*)(kdT + c * 72 + i0) = pk4(kv * kd);
            *(LAS v2u*)(rhsT + c * 72 + i0) = pk4(vv * be);
        }
    }
    LDS_BARRIER();
    for (int t = w; t < 16; t += 8) { const int mt = t >> 2, nt = t & 3;
        const f32x4 a = tile_mma<128>(kN, 136, kN, 136, mt * 16, nt * 16, lane, (f32x4){0.f, 0.f, 0.f, 0.f});
        const int j = nt * 16 + r; const float Gj = gb[64 + j];
#pragma unroll
        for (int x = 0; x < 4; ++x) { const int i = mt * 16 + q4 + x; const float lv = (i > j) ? gb[i] * a[x] * __expf(gb[64 + i] - Gj) : 0.f; Lm[i * 68 + j] = lv; Lb[i * 72 + j] = (bf16)f2bf(lv); }
    }
    for (int t = w; t < 16; t += 8) { const int jt = t >> 2, itl = t & 3;
        const f32x4 a = tile_mma<128>(kN, 136, qN, 136, jt * 16, itl * 16, lane, (f32x4){0.f, 0.f, 0.f, 0.f});
        const int i = itl * 16 + r; const float Gi = gb[64 + i]; f32x4 o;
#pragma unroll
        for (int x = 0; x < 4; ++x) { const int j = jt * 16 + q4 + x; o[x] = (j <= i) ? a[x] * __expf(Gi - gb[64 + j]) : 0.f; }
        *(v2u*)(gQK + i * 64 + jt * 16 + q4) = pk4(o);
    }
    LDS_BARRIER();
    if (w == 0) {
        unsigned lbase; asm volatile("v_mov_b32 %0, %1" : "=v"(lbase) : "s"((unsigned)(size_t)Lm));
        const int blk = lane >> 4, cc = lane & 15, kq8 = (lane >> 4) * 8;
        const LAS float* Lv = (const LAS float*)(size_t)lbase + (16 * blk) * 68 + 16 * blk;
#pragma unroll
        for (int x = 0; x < 9; ++x) *(LAS v4u*)(Tm + lane * 72 + x * 8) = (v4u){0u, 0u, 0u, 0u};
        float t[16];
#pragma unroll
        for (int i = 0; i < 16; ++i) {
            f32x4 l[4];
#pragma unroll
            for (int j4 = 0; j4 < (i + 3) / 4; ++j4) l[j4] = *(const LAS f32x4*)(Lv + i * 68 + j4 * 4);
            float s0 = (cc == i) ? 1.f : 0.f, s1 = 0.f;
#pragma unroll
            for (int j4 = 0; j4 < (i + 3) / 4; ++j4) {
                if (j4 * 4 + 0 < i) s0 -= l[j4].x * t[j4 * 4 + 0]; if (j4 * 4 + 1 < i) s1 -= l[j4].y * t[j4 * 4 + 1];
                if (j4 * 4 + 2 < i) s0 -= l[j4].z * t[j4 * 4 + 2]; if (j4 * 4 + 3 < i) s1 -= l[j4].w * t[j4 * 4 + 3]; }
            t[i] = s0 + s1; Tm[(16 * blk + i) * 72 + 16 * blk + cc] = (bf16)f2bf(t[i]);
        }
        { v4u o0, o1; o0.x = pk2(t[0], t[1]); o0.y = pk2(t[2], t[3]); o0.z = pk2(t[4], t[5]); o0.w = pk2(t[6], t[7]);
          o1.x = pk2(t[8], t[9]); o1.y = pk2(t[10], t[11]); o1.z = pk2(t[12], t[13]); o1.w = pk2(t[14], t[15]);
          *(LAS v4u*)(TT + (16 * blk + cc) * 72 + 16 * blk) = o0; *(LAS v4u*)(TT + (16 * blk + cc) * 72 + 16 * blk + 8) = o1; }
        const bf16x8_t zero8 = {0, 0, 0, 0, 0, 0, 0, 0};
#define INV_BLOCK(R, C) do { f32x4 xx = (f32x4){0.f, 0.f, 0.f, 0.f}; \
            _Pragma("unroll") for (int ks = 0; ks < (16 * ((R) - (C)) + 31) / 32; ++ks) { const bool ok = (32 * ks + kq8) < 16 * ((R) - (C)); const int ko = ok ? 16 * (C) + 32 * ks + kq8 : 0; \
                bf16x8_t a_ = *(const LAS bf16x8_t*)(Lb + (16 * (R) + cc) * 72 + ko); bf16x8_t b_ = *(const LAS bf16x8_t*)(TT + (16 * (C) + cc) * 72 + ko); \
                if (!ok) { a_ = zero8; b_ = zero8; } \
                xx = __builtin_amdgcn_mfma_f32_16x16x32_bf16(a_, b_, xx, 0, 0, 0); } \
            *(LAS v2u*)(XT + cc * 72 + (lane >> 4) * 4) = pk4(xx); \
            { const bool ok = kq8 < 16; const int ko = ok ? kq8 : 0; \
              bf16x8_t a_ = *(const LAS bf16x8_t*)(Tm + (16 * (R) + cc) * 72 + 16 * (R) + ko); bf16x8_t b_ = *(const LAS bf16x8_t*)(XT + cc * 72 + ko); \
              if (!ok) { a_ = zero8; b_ = zero8; } \
              f32x4 yy = __builtin_amdgcn_mfma_f32_16x16x32_bf16(a_, b_, (f32x4){0.f, 0.f, 0.f, 0.f}, 0, 0, 0); yy = -yy; \
              _Pragma("unroll") for (int x = 0; x < 4; ++x) Tm[(16 * (R) + (lane >> 4) * 4 + x) * 72 + 16 * (C) + cc] = (bf16)f2bf(yy[x]); \
              *(LAS v2u*)(TT + (16 * (C) + cc) * 72 + 16 * (R) + (lane >> 4) * 4) = pk4(yy); } } while (0)
        INV_BLOCK(1, 0); INV_BLOCK(2, 1); INV_BLOCK(3, 2);
        INV_BLOCK(2, 0); INV_BLOCK(3, 1);
        INV_BLOCK(3, 0);
#undef INV_BLOCK
    }
    LDS_BARRIER();
    int tidB = F.tid; asm volatile("" : "+v"(tidB));
    const int laneB = tidB & 63, rB = laneB & 15, q4B = (laneB >> 4) * 4;
    for (int t = w; t < 64; t += 8) { const int mt = t & 3, nt = t >> 2;
        const f32x4 a = tile_mma<64>(Tm, 72, rhsT, 72, mt * 16, nt * 16, laneB, (f32x4){0.f, 0.f, 0.f, 0.f});
        *(LAS v2u*)(solT + (nt * 16 + rB) * 72 + mt * 16 + q4B) = pk4(a);
    }
    for (int t = w; t < 32; t += 8) { const int mt = t & 7, nt = t >> 3;
        const f32x4 a = tile_mma<64>(rhsT + 128 * 72, 72, Tm, 72, mt * 16, nt * 16, laneB, (f32x4){0.f, 0.f, 0.f, 0.f});
        *(v2u*)(gKC + (nt * 16 + rB) * 128 + mt * 16 + q4B) = pk4(a);
    }
    LDS_BARRIER();
    for (int t = w; t < 64; t += 8) { const int mt = t & 7, nt = t >> 3;
        f32x4 a = tile_mma<64>(solT + 128 * 72, 72, kdT, 72, mt * 16, nt * 16, laneB, (f32x4){0.f, 0.f, 0.f, 0.f});
        a = -a; *(v2u*)(gMp + (nt * 16 + rB) * 128 + mt * 16 + q4B) = pk4(a);
    }
    for (int t = w; t < 64; t += 8) { const int mt = t & 7, nt = t >> 3;
        const f32x4 a = tile_mma<64>(kdT, 72, solT, 72, mt * 16, nt * 16, laneB, (f32x4){0.f, 0.f, 0.f, 0.f});
        *(v2u*)(gUT + (nt * 16 + rB) * 128 + mt * 16 + q4B) = pk4(a);
    }
    for (int c = tidB; c < 1024; c += NTHR) { const int row = c >> 3, pc = c & 7; *(v4u*)(gWT + row * 64 + pc * 8) = *(const LAS v4u*)(solT + row * 72 + pc * 8); }
}

#define DNS_LOAD(MR, UR, nn) do { const bf16* m1_ = gMp + (size_t)(nn) * 16384; const bf16* u1_ = gUT + (size_t)(nn) * 16384; \
    _Pragma("unroll") for (int x = 0; x < 4; ++x) { const int c = F.tid + 512 * x, row = c >> 4, pc = c & 15; MR[x] = *(const v4u*)(m1_ + row * 128 + pc * 8); } \
    _Pragma("unroll") for (int j = 0; j < NT; ++j) UR[j] = *(const v2u*)(u1_ + (c0 + 16 * j + r) * 128 + 16 * w + q4); } while (0)
#define UBF(v) ((f32x4){bf2f((v).x & 0xffff), bf2f((v).x >> 16), bf2f((v).y & 0xffff), bf2f((v).y >> 16)})
#define DNS_STEP(nn, MRc, URc, MRo, URo) do { \
    if ((nn) + 4 < 64) DNS_LOAD(MRo, URo, (nn) + 4); \
    const LAS bf16* STc = ST + ((nn) & 1) * (NT * 16 * 136); const LAS bf16* MPc = MP + ((nn) & 1) * (128 * 136); \
    LAS bf16* STn = ST + (((nn) + 1) & 1) * (NT * 16 * 136); LAS bf16* MPn = MP + (((nn) + 1) & 1) * (128 * 136); \
    const float sd = sdl[(nn)]; bf16x8_t a_[4]; \
    _Pragma("unroll") for (int s_ = 0; s_ < 4; ++s_) a_[s_] = *(const LAS bf16x8_t*)(MPc + (16 * w + r) * 136 + kq + 32 * s_); \
    _Pragma("unroll") for (int j = 0; j < NT; ++j) acc[j] = acc[j] * sd + UBF(u[j]); \
    _Pragma("unroll") for (int s_ = 0; s_ < 4; ++s_) { _Pragma("unroll") for (int j = 0; j < NT; ++j) { const bf16x8_t bb = *(const LAS bf16x8_t*)(STc + (16 * j + r) * 136 + kq + 32 * s_); \
        acc[j] = __builtin_amdgcn_mfma_f32_16x16x32_bf16(a_[s_], bb, acc[j], 0, 0, 0); } } \
    if ((nn) + 1 < 64) { bf16* gs = gST + (size_t)((nn) + 1) * 16384; \
        _Pragma("unroll") for (int j = 0; j < NT; ++j) { const v2u pv = pk4(acc[j]); *(LAS v2u*)(STn + (16 * j + r) * 136 + 16 * w + q4) = pv; *(v2u*)(gs + (c0 + 16 * j + r) * 128 + 16 * w + q4) = pv; } \
        _Pragma("unroll") for (int x = 0; x < 4; ++x) { const int c = F.tid + 512 * x, row = c >> 4, pc = c & 15; *(LAS v4u*)(MPn + row * 136 + pc * 8) = MRc[x]; } \
        _Pragma("unroll") for (int j = 0; j < NT; ++j) u[j] = URc[j]; } \
    LDS_BARRIER(); } while (0)
template <int NT> __device__ __forceinline__ void dn_scan(Frame& F, int bh, int part) {
    LAS bf16* ST = (LAS bf16*)(F.lds);
    LAS bf16* MP = (LAS bf16*)(F.lds + 2 * NT * 16 * 136 * 2);
    LAS float* sdl = (LAS float*)(F.lds + 2 * NT * 16 * 136 * 2 + 69632);
    const int ch0 = bh * 64, c0 = part * NT * 16, lane = F.lane, w = F.wave, r = lane & 15, q4 = (lane >> 4) * 4, kq = (lane >> 4) * 8;
    const bf16* gMp = (const bf16*)(F.ws + WS_DN_MP) + (size_t)ch0 * 16384; const bf16* gUT = (const bf16*)(F.ws + WS_DN_UT) + (size_t)ch0 * 16384;
    bf16* gST = (bf16*)(F.ws + WS_DN_ST) + (size_t)ch0 * 16384;
    LDS_BARRIER();
    for (int i = F.tid; i < NT * 16 * 136 / 2; i += NTHR) ((LAS unsigned*)ST)[i] = 0u;
    for (int c = F.tid; c < NT * 256; c += NTHR) { const int row = c >> 4, pc = c & 15; *(v4u*)(gST + (c0 + row) * 128 + pc * 8) = (v4u){0u, 0u, 0u, 0u}; }
    if (F.tid < 64) sdl[F.tid] = ((const float*)(F.ws + WS_DN_SD))[ch0 + F.tid];
    v4u m0[4], m1[4], m2[4], m3[4]; v2u u0[NT], u1[NT], u2[NT], u3[NT], u[NT]; f32x4 acc[NT];
    DNS_LOAD(m0, u, 0);
#pragma unroll
    for (int x = 0; x < 4; ++x) { const int c = F.tid + 512 * x, row = c >> 4, pc = c & 15; *(LAS v4u*)(MP + row * 136 + pc * 8) = m0[x]; }
#pragma unroll
    for (int j = 0; j < NT; ++j) acc[j] = (f32x4){0.f, 0.f, 0.f, 0.f};
    DNS_LOAD(m1, u1, 1); DNS_LOAD(m2, u2, 2); DNS_LOAD(m3, u3, 3);
    LDS_BARRIER();
#pragma unroll 1
    for (int n = 0; n < 64; n += 4) {
        DNS_STEP(n, m1, u1, m0, u0);
        DNS_STEP(n + 1, m2, u2, m1, u1);
        DNS_STEP(n + 2, m3, u3, m2, u2);
        DNS_STEP(n + 3, m0, u0, m3, u3);
    }
}

struct DnOutRegs { v4u rk[2], rq[2], rs[4], rw[2], rqk; };
__device__ __forceinline__ void dn_out_load(Frame& F, int ch, DnOutRegs& R) {
    const bf16* gKC = (const bf16*)(F.ws + WS_DN_KC) + (size_t)ch * 8192; const bf16* gWT = (const bf16*)(F.ws + WS_DN_WT) + (size_t)ch * 8192;
    const bf16* gQD = (const bf16*)(F.ws + WS_DN_QD) + (size_t)ch * 8192; const bf16* gQK = (const bf16*)(F.ws + WS_DN_QK) + (size_t)ch * 4096;
    const bf16* gST = (const bf16*)(F.ws + WS_DN_ST) + (size_t)ch * 16384;
#pragma unroll
    for (int x = 0; x < 2; ++x) { const int c = F.tid + 512 * x, row = c >> 4, pc = c & 15; R.rk[x] = *(const v4u*)(gKC + row * 128 + pc * 8); R.rq[x] = *(const v4u*)(gQD + row * 128 + pc * 8); }
#pragma unroll
    for (int x = 0; x < 4; ++x) { const int c = F.tid + 512 * x, row = c >> 4, pc = c & 15; R.rs[x] = *(const v4u*)(gST + row * 128 + pc * 8); }
#pragma unroll
    for (int x = 0; x < 2; ++x) { const int c = F.tid + 512 * x, row = c >> 3, pc = c & 7; R.rw[x] = *(const v4u*)(gWT + row * 64 + pc * 8); }
    { const int c = F.tid, row = c >> 3, pc = c & 7; R.rqk = *(const v4u*)(gQK + row * 64 + pc * 8); }
}
__device__ __forceinline__ void dn_out(Frame& F, int ch, DnOutRegs& R, int next_ch) {
    const int bh = ch >> 6, n = ch & 63, b = bh >> 2, h = bh & 3;
    const size_t row0 = (size_t)b * SEQ + n * 64;
    LAS bf16* kc = (LAS bf16*)(F.lds + 0);
    LAS bf16* wT = (LAS bf16*)(F.lds + 17408);
    LAS float* ob = (LAS float*)(F.lds + 0);
    LAS bf16* qd = (LAS bf16*)(F.lds + 35840);
    LAS bf16* qk = (LAS bf16*)(F.lds + 53248);
    LAS bf16* ST = (LAS bf16*)(F.lds + 62464);
    LAS bf16* vnT = (LAS bf16*)(F.lds + 97280);
    const int lane = F.lane, w = F.wave, r = lane & 15, q4 = (lane >> 4) * 4;
    const bf16* proj = (const bf16*)(F.ws + WS_PROJ);
    unsigned zz[8];
#pragma unroll
    for (int rr = 0; rr < 8; ++rr) zz[rr] = *(const unsigned*)(proj + (row0 + w * 8 + rr) * NMAIN + MC_DNZ + h * 128 + 2 * lane);
    LDS_BARRIER();
#pragma unroll
    for (int x = 0; x < 2; ++x) { const int c = F.tid + 512 * x, row = c >> 4, pc = c & 15; *(LAS v4u*)(kc + row * 136 + pc * 8) = R.rk[x]; *(LAS v4u*)(qd + row * 136 + pc * 8) = R.rq[x]; }
#pragma unroll
    for (int x = 0; x < 4; ++x) { const int c = F.tid + 512 * x, row = c >> 4, pc = c & 15; *(LAS v4u*)(ST + row * 136 + pc * 8) = R.rs[x]; }
#pragma unroll
    for (int x = 0; x < 2; ++x) { const int c = F.tid + 512 * x, row = c >> 3, pc = c & 7; *(LAS v4u*)(wT + row * 72 + pc * 8) = R.rw[x]; }
    { const int c = F.tid, row = c >> 3, pc = c & 7; *(LAS v4u*)(qk + row * 72 + pc * 8) = R.rqk; }
    if (next_ch >= 0) dn_out_load(F, next_ch, R);
    LDS_BARRIER();
    for (int t = w; t < 32; t += 8) { const int mt = t & 3, nt = t >> 2;
        const f32x4 a = tile_mma<128>(kc, 136, ST, 136, mt * 16, nt * 16, lane, (f32x4){0.f, 0.f, 0.f, 0.f});
        const int e = nt * 16 + r; const v2u wv = *(const LAS v2u*)(wT + e * 72 + mt * 16 + q4);
        f32x4 vn; vn.x = bf2f(wv.x & 0xffff) - a.x; vn.y = bf2f(wv.x >> 16) - a.y; vn.z = bf2f(wv.y & 0xffff) - a.z; vn.w = bf2f(wv.y >> 16) - a.w;
        *(LAS v2u*)(vnT + e * 72 + mt * 16 + q4) = pk4(vn);
    }
    LDS_BARRIER();
    for (int t = w; t < 32; t += 8) { const int mt = t & 3, nt = t >> 2;
        f32x4 a = tile_mma<128>(qd, 136, ST, 136, mt * 16, nt * 16, lane, (f32x4){0.f, 0.f, 0.f, 0.f});
        a = tile_mma<64>(qk, 72, vnT, 72, mt * 16, nt * 16, lane, a);
        const int e = nt * 16 + r;
#pragma unroll
        for (int x = 0; x < 4; ++x) ob[(mt * 16 + q4 + x) * 132 + e] = a[x];
    }
    LDS_BARRIER();
    bf16* mix = (bf16*)(F.ws + WS_MIX); const float* dnn = F.in[I_DNNORM];
    float oo0[8], oo1[8], sq[8];
    const float nw0 = dnn[2 * lane], nw1 = dnn[2 * lane + 1];
#pragma unroll
    for (int rr = 0; rr < 8; ++rr) { const int i = w * 8 + rr;
        oo0[rr] = ob[i * 132 + 2 * lane]; oo1[rr] = ob[i * 132 + 2 * lane + 1]; sq[rr] = oo0[rr] * oo0[rr] + oo1[rr] * oo1[rr]; }
#pragma unroll
    for (int o = 1; o < 64; o <<= 1) {
#pragma unroll
        for (int rr = 0; rr < 8; ++rr) sq[rr] += __shfl_xor(sq[rr], o); }
#pragma unroll
    for (int rr = 0; rr < 8; ++rr) { const int i = w * 8 + rr; const float rstd = rsqrtf(sq[rr] * (1.f / 128.f) + EPS);
        const float y0 = oo0[rr] * rstd * nw0 * siluf_(bf2f(zz[rr] & 0xffff)), y1 = oo1[rr] * rstd * nw1 * siluf_(bf2f(zz[rr] >> 16));
        *(unsigned*)(mix + (row0 + i) * D + h * 128 + 2 * lane) = pk2(y0, y1); }
}

__device__ __forceinline__ void ml_prep(Frame& F, int ch) {
    const int bh = ch >> 6, n = ch & 63, b = bh >> 2, h = bh & 3;
    const size_t row0 = (size_t)b * SEQ + n * 64;
    LAS bf16* kwT = (LAS bf16*)(F.lds + 0);
    LAS bf16* vT = (LAS bf16*)(F.lds + 9216);
    LAS float* gsc = (LAS float*)(F.lds + 27648);
    const bf16* proj = (const bf16*)(F.ws + WS_PROJ); const float* g16 = (const float*)(F.ws + WS_G16); const float* cw = F.in[I_MLCONV];
    float* gUp = (float*)(F.ws + WS_ML_UPT) + (size_t)ch * 8192; bf16* gQC = (bf16*)(F.ws + WS_ML_QC) + (size_t)ch * 4096; bf16* gKC = (bf16*)(F.ws + WS_ML_KC) + (size_t)ch * 4096;
    float* aux = (float*)(F.ws + WS_ML_AUX);
    const int lane = F.lane, w = F.wave, r = lane & 15, q4 = (lane >> 4) * 4;
    LDS_BARRIER();
    if (w == 0) {
        const float* g = g16 + (row0 + lane) * 16;
        const float ip = g[8 + h] + F.in[I_MLIB][h]; float bc = logsigmoidf_(g[12 + h] + F.in[I_MLFB][h]);
#pragma unroll
        for (int o = 1; o < 64; o <<= 1) { const float v = __shfl_up(bc, o); if (lane >= o) bc += v; }
        const float bl = __shfl(bc, 63), ge = bl - bc + ip; float gm = ge;
#pragma unroll
        for (int o = 1; o < 64; o <<= 1) gm = fmaxf(gm, __shfl_xor(gm, o));
        gsc[lane] = __expf(ge - gm);
        if (lane == 0) { aux[131072 + ch * 2] = bl; aux[131072 + ch * 2 + 1] = gm; }
    }
    LDS_BARRIER();
#pragma unroll 1
    for (int it = 0; it < 2; ++it) {
        const int item = it * 512 + F.tid, i = item >> 4, cg = item & 15, isk = cg >> 3, c8 = (cg & 7) * 8, chn = isk * 256 + h * 64 + c8;
        float y[8];
#pragma unroll
        for (int j = 0; j < 8; ++j) y[j] = 0.f;
#pragma unroll
        for (int j = 0; j < 4; ++j) { const int tt = n * 64 + i - 3 + j;
            if (tt >= 0) { const v4u raw = *(const v4u*)(proj + ((size_t)b * SEQ + tt) * NMAIN + MC_MLQ + chn);
                const f32x4 w0 = *(const f32x4*)(cw + j * 512 + chn), w1 = *(const f32x4*)(cw + j * 512 + chn + 4);
                y[0] += bf2f(raw.x & 0xffff) * w0.x; y[1] += bf2f(raw.x >> 16) * w0.y; y[2] += bf2f(raw.y & 0xffff) * w0.z; y[3] += bf2f(raw.y >> 16) * w0.w;
                y[4] += bf2f(raw.z & 0xffff) * w1.x; y[5] += bf2f(raw.z >> 16) * w1.y; y[6] += bf2f(raw.w & 0xffff) * w1.z; y[7] += bf2f(raw.w >> 16) * w1.w; } }
#pragma unroll
        for (int j = 0; j < 8; ++j) y[j] = siluf_(y[j]);
        if (!isk) { v4u o; o.x = pk2(y[0] * 0.125f, y[1] * 0.125f); o.y = pk2(y[2] * 0.125f, y[3] * 0.125f); o.z = pk2(y[4] * 0.125f, y[5] * 0.125f); o.w = pk2(y[6] * 0.125f, y[7] * 0.125f);
            *(v4u*)(gQC + i * 64 + c8) = o; }
        else { v4u o; o.x = pk2(y[0], y[1]); o.y = pk2(y[2], y[3]); o.z = pk2(y[4], y[5]); o.w = pk2(y[6], y[7]); *(v4u*)(gKC + i * 64 + c8) = o;
            const float sc = gsc[i];
#pragma unroll
            for (int j = 0; j < 8; ++j) kwT[(c8 + j) * 72 + i] = (bf16)f2bf(y[j] * sc); }
    }
#pragma unroll 1
    for (int it = 0; it < 2; ++it) {
        const int item = it * 512 + F.tid, i = item >> 4, cg = item & 15;
        const v4u raw = *(const v4u*)(proj + (row0 + i) * NMAIN + MC_MLV + h * 128 + cg * 8);
        LAS bf16* d = vT + (cg * 8) * 72 + i;
        d[0] = (bf16)(raw.x & 0xffff); d[72] = (bf16)(raw.x >> 16); d[144] = (bf16)(raw.y & 0xffff); d[216] = (bf16)(raw.y >> 16);
        d[288] = (bf16)(raw.z & 0xffff); d[360] = (bf16)(raw.z >> 16); d[432] = (bf16)(raw.w & 0xffff); d[504] = (bf16)(raw.w >> 16);
    }
    LDS_BARRIER();
    for (int t = w; t < 32; t += 8) { const int mt = t & 3, nt = t >> 2;
        const f32x4 a = tile_mma<64>(kwT, 72, vT, 72, mt * 16, nt * 16, lane, (f32x4){0.f, 0.f, 0.f, 0.f});
        *(f32x4*)(gUp + (nt * 16 + r) * 64 + mt * 16 + q4) = a;
    }
    if (F.tid < 64) { float s = 0.f; for (int x = 0; x < 64; ++x) s += bf2f(kwT[F.tid * 72 + x]); aux[ch * 64 + F.tid] = s; }
}

__device__ __forceinline__ void ml_scan(Frame& F, int bh) {
    const int ch0 = bh * 64;
    const float* gUp = (const float*)(F.ws + WS_ML_UPT) + (size_t)ch0 * 8192; bf16* gCT = (bf16*)(F.ws + WS_ML_CT) + (size_t)ch0 * 8192;
    float* aux = (float*)(F.ws + WS_ML_AUX);
    LAS float* sl = (LAS float*)F.lds;
    LDS_BARRIER();
    if (F.tid < 128) sl[F.tid] = aux[131072 + ch0 * 2 + F.tid];
    for (int i = F.tid; i < 4096; i += NTHR) sl[128 + i] = aux[ch0 * 64 + i];
    LDS_BARRIER();
    f32x4 C[4], uA[4], uB[4]; float nv = 0.f, m = 0.f;
#pragma unroll
    for (int x = 0; x < 4; ++x) { C[x] = (f32x4){0.f, 0.f, 0.f, 0.f}; uA[x] = *(const f32x4*)(gUp + x * 2048 + F.tid * 4); uB[x] = *(const f32x4*)(gUp + 8192 + x * 2048 + F.tid * 4); }
#define MLS_STEP(nn, UC) do { const int ch = ch0 + (nn); \
        _Pragma("unroll") for (int x = 0; x < 4; ++x) *(v2u*)(gCT + (size_t)(nn) * 8192 + x * 2048 + F.tid * 4) = pk4(C[x]); \
        if (F.tid < 64) aux[65536 + ch * 64 + F.tid] = nv; \
        if (F.tid == 0) aux[133120 + ch] = m; \
        const float bl = sl[2 * (nn)], gm = sl[2 * (nn) + 1]; \
        const float m1 = fmaxf(bl + m, gm), keep = __expf(bl + m - m1), sc = __expf(gm - m1); \
        _Pragma("unroll") for (int x = 0; x < 4; ++x) C[x] = C[x] * keep + UC[x] * sc; \
        nv = nv * keep + sl[128 + (nn) * 64 + (F.tid & 63)] * sc; m = m1; \
        if ((nn) + 2 < 64) { _Pragma("unroll") for (int x = 0; x < 4; ++x) UC[x] = *(const f32x4*)(gUp + (size_t)((nn) + 2) * 8192 + x * 2048 + F.tid * 4); } } while (0)
#pragma unroll 1
    for (int n = 0; n < 64; n += 2) { MLS_STEP(n, uA); MLS_STEP(n + 1, uB); }
#undef MLS_STEP
}

__device__ __forceinline__ void ml_out(Frame& F, int ch) {
    const int bh = ch >> 6, n = ch & 63, b = bh >> 2, h = bh & 3;
    const size_t row0 = (size_t)b * SEQ + n * 64;
    LAS bf16* qI = (LAS bf16*)(F.lds + 0);
    LAS bf16* qS = (LAS bf16*)(F.lds + 9216);
    LAS bf16* kS = (LAS bf16*)(F.lds + 18432);
    LAS bf16* pM = (LAS bf16*)(F.lds + 27648);
    LAS bf16* vT = (LAS bf16*)(F.lds + 36864);
    LAS bf16* cT = (LAS bf16*)(F.lds + 57600);
    LAS float* hb = (LAS float*)(F.lds + 78336);
    LAS float* gg = (LAS float*)(F.lds + 116224);
    const bf16* proj = (const bf16*)(F.ws + WS_PROJ); const float* g16 = (const float*)(F.ws + WS_G16);
    const bf16* gQC = (const bf16*)(F.ws + WS_ML_QC) + (size_t)ch * 4096; const bf16* gKC = (const bf16*)(F.ws + WS_ML_KC) + (size_t)ch * 4096;
    const bf16* gCT = (const bf16*)(F.ws + WS_ML_CT) + (size_t)ch * 8192; const float* aux = (const float*)(F.ws + WS_ML_AUX);
    const int lane = F.lane, w = F.wave, r = lane & 15, q4 = (lane >> 4) * 4;
    unsigned zz[8];
#pragma unroll
    for (int rr = 0; rr < 8; ++rr) zz[rr] = *(const unsigned*)(proj + (row0 + w * 8 + rr) * NMAIN + MC_MLO + h * 128 + 2 * lane);
    LDS_BARRIER();
    if (w == 0) {
        const float* g = g16 + (row0 + lane) * 16;
        const float ip = g[8 + h] + F.in[I_MLIB][h]; float bc = logsigmoidf_(g[12 + h] + F.in[I_MLFB][h]);
#pragma unroll
        for (int o = 1; o < 64; o <<= 1) { const float v = __shfl_up(bc, o); if (lane >= o) bc += v; }
        const float rj = ip - bc; float pm = rj;
#pragma unroll
        for (int o = 1; o < 64; o <<= 1) { const float v = __shfl_up(pm, o); if (lane >= o) pm = fmaxf(pm, v); }
        const float ms = aux[133120 + ch], mt = fmaxf(bc + ms, bc + pm);
        gg[lane] = bc; gg[64 + lane] = rj; gg[128 + lane] = mt; gg[192 + lane] = __expf(bc + ms - mt);
    }
    for (int i = F.tid; i < 16 * 72; i += NTHR) { const bf16 one = (bf16)0x3f80; vT[128 * 72 + i] = (i < 64) ? one : (bf16)0; cT[128 * 72 + i] = (bf16)0; }
    LDS_BARRIER();
    v4u rct[2], rv[2]; float rnv = 0.f;
#pragma unroll
    for (int x = 0; x < 2; ++x) { const int c = F.tid + 512 * x, row = c >> 3, pc = c & 7; rct[x] = *(const v4u*)(gCT + row * 64 + pc * 8);
        const int item = x * 512 + F.tid, i = item >> 4, cg = item & 15; rv[x] = *(const v4u*)(proj + (row0 + i) * NMAIN + MC_MLV + h * 128 + cg * 8); }
    if (F.tid < 64) rnv = aux[65536 + ch * 64 + F.tid];
    { const int c = F.tid, row = c >> 3, pc = c & 7;
        const v4u qv = *(const v4u*)(gQC + row * 64 + pc * 8); const v4u kv_ = *(const v4u*)(gKC + row * 64 + pc * 8); *(LAS v4u*)(qS + row * 72 + pc * 8) = qv; *(LAS v4u*)(kS + row * 72 + pc * 8) = kv_;
        const float in = gg[192 + row]; v4u o;
        o.x = pk2(bf2f(qv.x & 0xffff) * in, bf2f(qv.x >> 16) * in); o.y = pk2(bf2f(qv.y & 0xffff) * in, bf2f(qv.y >> 16) * in);
        o.z = pk2(bf2f(qv.z & 0xffff) * in, bf2f(qv.z >> 16) * in); o.w = pk2(bf2f(qv.w & 0xffff) * in, bf2f(qv.w >> 16) * in);
        *(LAS v4u*)(qI + row * 72 + pc * 8) = o; }
#pragma unroll
    for (int x = 0; x < 2; ++x) { const int c = F.tid + 512 * x, row = c >> 3, pc = c & 7; *(LAS v4u*)(cT + row * 72 + pc * 8) = rct[x]; }
    if (F.tid < 64) cT[128 * 72 + F.tid] = (bf16)f2bf(rnv);
#pragma unroll
    for (int it = 0; it < 2; ++it) {
        const int item = it * 512 + F.tid, i = item >> 4, cg = item & 15;
        const v4u raw = rv[it];
        LAS bf16* d = vT + (cg * 8) * 72 + i;
        d[0] = (bf16)(raw.x & 0xffff); d[72] = (bf16)(raw.x >> 16); d[144] = (bf16)(raw.y & 0xffff); d[216] = (bf16)(raw.y >> 16);
        d[288] = (bf16)(raw.z & 0xffff); d[360] = (bf16)(raw.z >> 16); d[432] = (bf16)(raw.w & 0xffff); d[504] = (bf16)(raw.w >> 16);
    }
    LDS_BARRIER();
    for (int t = w; t < 16; t += 8) { const int jt = t >> 2, itl = t & 3;
        const f32x4 a = tile_mma<64>(kS, 72, qS, 72, jt * 16, itl * 16, lane, (f32x4){0.f, 0.f, 0.f, 0.f});
        const int i = itl * 16 + r; const float e0 = gg[i] - gg[128 + i]; f32x4 o;
#pragma unroll
        for (int x = 0; x < 4; ++x) { const int j = jt * 16 + q4 + x; o[x] = (j <= i) ? a[x] * __expf(e0 + gg[64 + j]) : 0.f; }
        *(LAS v2u*)(pM + i * 72 + jt * 16 + q4) = pk4(o);
    }
    LDS_BARRIER();
    for (int t = w; t < 36; t += 8) { const int mt = t & 3, nt = t >> 2;
        f32x4 a = tile_mma<64>(qI, 72, cT, 72, mt * 16, nt * 16, lane, (f32x4){0.f, 0.f, 0.f, 0.f});
        a = tile_mma<64>(pM, 72, vT, 72, mt * 16, nt * 16, lane, a);
        const int e = nt * 16 + r;
#pragma unroll
        for (int x = 0; x < 4; ++x) hb[(mt * 16 + q4 + x) * 148 + e] = a[x];
    }
    LDS_BARRIER();
    bf16* mix = (bf16*)(F.ws + WS_MIX); const float* mln = F.in[I_MLNORM];
    float oo0[8], oo1[8], sq[8];
    const float nw0 = mln[h * 128 + 2 * lane], nw1 = mln[h * 128 + 2 * lane + 1];
#pragma unroll
    for (int rr = 0; rr < 8; ++rr) { const int i = w * 8 + rr;
        const float dd = 1.0f / fmaxf(fabsf(hb[i * 148 + 128]), __expf(-gg[128 + i]));
        oo0[rr] = hb[i * 148 + 2 * lane] * dd; oo1[rr] = hb[i * 148 + 2 * lane + 1] * dd; sq[rr] = oo0[rr] * oo0[rr] + oo1[rr] * oo1[rr]; }
#pragma unroll
    for (int o = 1; o < 64; o <<= 1) {
#pragma unroll
        for (int rr = 0; rr < 8; ++rr) sq[rr] += __shfl_xor(sq[rr], o); }
#pragma unroll
    for (int rr = 0; rr < 8; ++rr) { const int i = w * 8 + rr; const float rstd = rsqrtf(sq[rr] * (1.f / 128.f) + EPS);
        const float y0 = oo0[rr] * rstd * nw0 * sigmoidf_(bf2f(zz[rr] & 0xffff)), y1 = oo1[rr] * rstd * nw1 * sigmoidf_(bf2f(zz[rr] >> 16));
        *(unsigned*)(mix + (row0 + i) * D + 512 + h * 128 + 2 * lane) = pk2(y0, y1); }
}

template <int J0> __device__ __forceinline__ void p4_mixnorm(Frame& F) {
    const float* raw = (const float*)(F.ws + WS_RAW); const bf16* proj = (const bf16*)(F.ws + WS_PROJ); bf16* mix = (bf16*)(F.ws + WS_MIX);
    const float* dnn = F.in[I_DNNORM]; const float* mln = F.in[I_MLNORM];
    const int gw = F.vb * NWAVES + F.wave, NGW = F.G * NWAVES;
    for (int row = gw; row < T; row += NGW) {
        const f32x4* rr = (const f32x4*)(raw + (size_t)row * D) + F.lane;
        v2u* o8 = (v2u*)(mix + (size_t)row * D) + F.lane;
#pragma unroll
        for (int j = J0; j < 4; ++j) {
            f32x4 v = rr[64 * j]; float ss = (v.x * v.x + v.y * v.y) + (v.z * v.z + v.w * v.w);
#pragma unroll
            for (int o = 1; o < 32; o <<= 1) ss += __shfl_xor(ss, o);
            const float rstd = rsqrtf(ss * (1.f / 128.f) + EPS);
            const int k = 256 * j + F.lane * 4;
            f32x4 w, gt;
            if (j < 2) { w = *(const f32x4*)(dnn + (k & 127)); const v2u z = *(const v2u*)(proj + (size_t)row * NMAIN + MC_DNZ + k);
                gt.x = siluf_(bf2f(z.x & 0xffff)); gt.y = siluf_(bf2f(z.x >> 16)); gt.z = siluf_(bf2f(z.y & 0xffff)); gt.w = siluf_(bf2f(z.y >> 16)); }
            else { w = *(const f32x4*)(mln + (k - 512)); const v2u z = *(const v2u*)(proj + (size_t)row * NMAIN + MC_MLO + (k - 512));
                gt.x = sigmoidf_(bf2f(z.x & 0xffff)); gt.y = sigmoidf_(bf2f(z.x >> 16)); gt.z = sigmoidf_(bf2f(z.y & 0xffff)); gt.w = sigmoidf_(bf2f(z.y >> 16)); }
            v = v * rstd * w * gt;
            v2u o; o.x = pk2(v.x, v.y); o.y = pk2(v.z, v.w); o8[64 * j] = o;
        }
    }
}

__device__ __forceinline__ void p6_router(Frame& F, int rep) {
    LAS float* wr = (LAS float*)F.lds;
    LAS float* lg = (LAS float*)(F.lds + L_EXTRA);
    const float* x1 = (const float*)(F.ws + WS_X1);
    f32x4 vn[8];
    { const f32x4* xr0 = (const f32x4*)(x1 + (size_t)(F.vb * 64 + F.wave * 8) * D) + F.lane;
#pragma unroll
      for (int j = 0; j < 4; ++j) { vn[j] = xr0[64 * j]; vn[4 + j] = xr0[256 + 64 * j]; } }
    { const char* src = (const char*)(F.ws + WS_WRT);
#pragma unroll
        for (int it = 0; it < 16; ++it) { const int chunk = it * 8 + F.wave;
            __builtin_amdgcn_global_load_lds((const unsigned*)(src + chunk * 1024 + F.lane * 16), (LAS unsigned*)(F.lds + chunk * 1024), 16, 0, 0); }
        asm volatile("s_waitcnt vmcnt(0)" ::: "memory"); }
    __syncthreads(); const float* nw = F.in[I_NFFN]; const float* mod = (const float*)(F.ws + WS_MOD);
    bf16* h2 = (bf16*)(F.ws + WS_H); const float* br = F.in[I_BR];
    int* tok_e = (int*)(F.ws + WS_TOKE); int* tok_r = (int*)(F.ws + WS_TOKR); float* tok_w = (float*)(F.ws + WS_TOKW); int* slot_tok = (int*)(F.ws + WS_SLOTTOK);
    unsigned* gcnt = (unsigned*)(F.ws + WS_CTL) + CW_CNT;
    if (rep > 0) { tok_e = (int*)(F.ws + WS_RAW); tok_r = tok_e + 65536; tok_w = (float*)(tok_r + 65536); slot_tok = tok_r + 131072; gcnt += 16384 - CW_CNT; }
    LAS int* cntL = (LAS int*)(F.lds + L_EXTRA + 8448);
    LAS int* baseL = cntL + 32;
    for (int blk = F.vb; blk < T / 64; blk += F.G) {
        if (F.tid < 32) cntL[F.tid] = 0;
        __syncthreads();
#pragma unroll 1
        for (int rr = 0; rr < 8; rr += 2) {
            const int lr = F.wave * 8 + rr, row = blk * 64 + lr, b = row / SEQ;
            f32x4 v0[4], v1[4]; float ss0 = 0.f, ss1 = 0.f;
#pragma unroll
            for (int j = 0; j < 4; ++j) { v0[j] = vn[j]; v1[j] = vn[4 + j];
                ss0 += (v0[j].x * v0[j].x + v0[j].y * v0[j].y) + (v0[j].z * v0[j].z + v0[j].w * v0[j].w);
                ss1 += (v1[j].x * v1[j].x + v1[j].y * v1[j].y) + (v1[j].z * v1[j].z + v1[j].w * v1[j].w); }
            { const int nrow = (rr + 2 < 8) ? row + 2 : ((blk + F.G < T / 64) ? (blk + F.G) * 64 + F.wave * 8 : row);
              const f32x4* xr = (const f32x4*)(x1 + (size_t)nrow * D) + F.lane;
#pragma unroll
              for (int j = 0; j < 4; ++j) { vn[j] = xr[64 * j]; vn[4 + j] = xr[256 + 64 * j]; } }
            const float rstd0 = rsqrtf(wave_sum(ss0) * (1.f / D) + EPS), rstd1 = rsqrtf(wave_sum(ss1) * (1.f / D) + EPS);
            const float* sh = mod + b * 6144 + 3072; const float* sc = sh + 1024;
#pragma unroll
            for (int j = 0; j < 4; ++j) { const int k = 256 * j + F.lane * 4;
                const f32x4 w = *(const f32x4*)(nw + k), s1 = *(const f32x4*)(sc + k), s0 = *(const f32x4*)(sh + k);
                v0[j] = (v0[j] * rstd0 * w) * (1.0f + s1) + s0; v1[j] = (v1[j] * rstd1 * w) * (1.0f + s1) + s0; }
            v2u* o8 = (v2u*)(h2 + (size_t)row * D) + F.lane;
#pragma unroll
            for (int j = 0; j < 4; ++j) { v2u o; o.x = pk2(v0[j].x, v0[j].y); o.y = pk2(v0[j].z, v0[j].w); o8[64 * j] = o;
                v2u p; p.x = pk2(v1[j].x, v1[j].y); p.y = pk2(v1[j].z, v1[j].w); o8[256 + 64 * j] = p; }
            float acc0[32], acc1[32];
#pragma unroll
            for (int e = 0; e < 32; ++e) { float a0 = 0.f, a1 = 0.f;
#pragma unroll
                for (int j = 0; j < 4; ++j) { const f32x4 w = *(const LAS f32x4*)(wr + e * 1024 + 256 * j + F.lane * 4);
                    a0 += (v0[j].x * w.x + v0[j].y * w.y) + (v0[j].z * w.z + v0[j].w * w.w); a1 += (v1[j].x * w.x + v1[j].y * w.y) + (v1[j].z * w.z + v1[j].w * w.w); }
                acc0[e] = a0; acc1[e] = a1; if (e & 1) asm volatile("" ::: "memory"); }
            const float r0 = multi_reduce<32>(acc0, F.lane), r1 = multi_reduce<32>(acc1, F.lane);
            if ((F.lane & 1) == 0) { const float bb = br[F.lane >> 1]; lg[lr * 33 + (F.lane >> 1)] = r0 + bb; lg[(lr + 1) * 33 + (F.lane >> 1)] = r1 + bb; }
        }
        int te[4] = {0, 0, 0, 0}, lk[4] = {0, 0, 0, 0}; float ww[4] = {0.f, 0.f, 0.f, 0.f};
        if (F.lane < 8) {
            const int lr = F.wave * 8 + F.lane;
            float l[32];
#pragma unroll
            for (int e = 0; e < 32; ++e) l[e] = lg[lr * 33 + e];
            float tl[4];
#pragma unroll
            for (int k = 0; k < 4; ++k) { float best = -3.0e38f; int bi = 0;
#pragma unroll
                for (int e = 0; e < 32; ++e) { if (l[e] > best) { best = l[e]; bi = e; } }
                te[k] = bi; tl[k] = best;
#pragma unroll
                for (int e = 0; e < 32; ++e) if (e == bi) l[e] = -3.0e38f; }
            ww[0] = 1.f; ww[1] = __expf(tl[1] - tl[0]); ww[2] = __expf(tl[2] - tl[0]); ww[3] = __expf(tl[3] - tl[0]);
            const float inv = 1.f / (ww[0] + ww[1] + ww[2] + ww[3]);
#pragma unroll
            for (int k = 0; k < 4; ++k) { ww[k] *= inv; lk[k] = __hip_atomic_fetch_add(cntL + te[k], 1, __ATOMIC_RELAXED, __HIP_MEMORY_SCOPE_WORKGROUP); }
        }
        __syncthreads();
        if (F.tid < 32) baseL[F.tid] = (int)__hip_atomic_fetch_add(gcnt + 64 * F.tid, (unsigned)cntL[F.tid], __ATOMIC_RELAXED, __HIP_MEMORY_SCOPE_AGENT);
        __syncthreads();
        if (F.lane < 8) { const int row = blk * 64 + F.wave * 8 + F.lane;
#pragma unroll
            for (int k = 0; k < 4; ++k) { const int rk = baseL[te[k]] + lk[k]; tok_e[row * 4 + k] = te[k]; tok_r[row * 4 + k] = rk; tok_w[row * 4 + k] = ww[k]; if (rk < ECAP) slot_tok[te[k] * ECAP + rk] = row; } }
        __syncthreads();
    }
}

__device__ __forceinline__ void p9_final(Frame& F) {
    build_expert_tables(F);
    const LAS int* tst = (const LAS int*)(F.lds + L_TST);
    const float* x1 = (const float*)(F.ws + WS_X1); const bf16* y = (const bf16*)(F.ws + WS_Y);
    const float* mod = (const float*)(F.ws + WS_MOD); const float* modf = (const float*)(F.ws + WS_MODF); const float* nf = F.in[I_NFIN];
    const int* tok_e = (const int*)(F.ws + WS_TOKE); const int* tok_r = (const int*)(F.ws + WS_TOKR); const float* tok_w = (const float*)(F.ws + WS_TOKW);
    const int gw = F.vb * NWAVES + F.wave, NGW = F.G * NWAVES;
    for (int row = gw; row < T; row += NGW) {
        const int b = row / SEQ;
        const f32x4* xr = (const f32x4*)(x1 + (size_t)row * D) + F.lane;
        f32x4 v[4], m[4];
#pragma unroll
        for (int j = 0; j < 4; ++j) { v[j] = xr[64 * j]; m[j] = (f32x4){0.f, 0.f, 0.f, 0.f}; }
#pragma unroll
        for (int k = 0; k < 4; ++k) { const int e = tok_e[row * 4 + k], r = tok_r[row * 4 + k]; const float w = tok_w[row * 4 + k];
            const size_t cs = (size_t)tst[e] * 256 + r;
            const v2u* yr = (const v2u*)(y + cs * D) + F.lane;
#pragma unroll
            for (int j = 0; j < 4; ++j) { const v2u z = yr[64 * j];
                m[j].x += w * bf2f(z.x & 0xffff); m[j].y += w * bf2f(z.x >> 16); m[j].z += w * bf2f(z.y & 0xffff); m[j].w += w * bf2f(z.y >> 16); } }
        const float* g2 = mod + b * 6144 + 5120; float ss = 0.f;
#pragma unroll
        for (int j = 0; j < 4; ++j) { const f32x4 g = *(const f32x4*)(g2 + 256 * j + F.lane * 4); v[j] = v[j] + g * m[j];
            ss += (v[j].x * v[j].x + v[j].y * v[j].y) + (v[j].z * v[j].z + v[j].w * v[j].w); }
        const float rstd = rsqrtf(wave_sum(ss) * (1.f / D) + EPS);
        const float* sh = modf + b * 2048; const float* sc = sh + 1024;
        f32x4* orow = (f32x4*)(F.out + (size_t)row * D) + F.lane;
#pragma unroll
        for (int j = 0; j < 4; ++j) { const int k = 256 * j + F.lane * 4;
            const f32x4 w = *(const f32x4*)(nf + k), s1 = *(const f32x4*)(sc + k), s0 = *(const f32x4*)(sh + k);
            f32x4 ov = (v[j] * rstd * w) * (1.0f + s1) + s0;
            if (TP_A >= 0) { const unsigned long long* st = (const unsigned long long*)(F.ws + WS_CTL + 131072); const float eps = (float)(long long)(st[TP_B] - st[TP_A]) * (float)TP_SCALE * 0.25e-5f; ov = ov * (1.0f + eps); }
            orow[64 * j] = ov; }
    }
}

constexpr int NPH = 11;
__global__ void __launch_bounds__(NTHR, 2) fwd(Args args) {
    extern __shared__ __attribute__((aligned(16))) unsigned char lds_raw[];
    Frame F;
    F.lds = (LAS unsigned char*)lds_raw; F.ws = args.ws; F.out = args.out;
    F.in.p = (const float* const*)__builtin_amdgcn_kernarg_segment_ptr();
    F.tid = threadIdx.x; F.lane = F.tid & 63; F.wave = __builtin_amdgcn_readfirstlane(F.tid >> 6);
    F.G = gridDim.x; F.vb = blockIdx.x;
    for (int u = F.tid; u < (LDS_BYTES - LDSCTL_OFF) / 4; u += NTHR) ((LAS unsigned*)(F.lds + LDSCTL_OFF))[u] = 0u;
    __syncthreads();
    unsigned* ctl = (unsigned*)(F.ws + WS_CTL);
    const int lo = args.ph_lo, hi = args.ph_hi;
    XcdBarrier bar; bar.bar = ctl + CW_BAR; bar.x = 0; bar.st = nullptr;
    if (hi - lo > 1) bar = xcd_barrier_post(ctl + CW_BAR, (volatile LAS unsigned*)(F.lds + L_MISC) + 8);
#ifndef REPMASK
#define REPMASK 0
#endif
#define NREP(k) (((REPMASK >> (k)) & 1) ? 2 : 1)
#ifndef P3MODE
#define P3MODE 0
#endif
#ifndef XBARS
#define XBARS 0
#endif
#ifndef PHMASK
#define PHMASK 0x7ff
#endif
#define IN(k) (((PHMASK >> (k)) & 1) && lo <= (k) && (k) < hi)
#define SEAM(k) do { if (IN(k) && IN((k) + 1)) xcd_barrier(bar); STAMP((k) + 1, 0); } while (0)
    STAMP(0, 0);

    if (IN(0)) _Pragma("unroll") for (int rep_ = 0; rep_ < NREP(0); ++rep_) { p0_prologue(F); } SEAM(0);
    if (IN(1)) _Pragma("unroll") for (int rep_ = 0; rep_ < NREP(1); ++rep_) { p1_norm1(F); } SEAM(1);
    if (IN(2)) _Pragma("unroll") for (int rep_ = 0; rep_ < NREP(2); ++rep_) {
        pg8::Gemm g{(const bf16*)(F.ws + WS_H), D}; pg8::DenseOrder S; S.init(T, NMAIN, D, (const bf16*)(F.ws + WS_BTIN), F.G, F.vb);
        EpiProj E{(bf16*)(F.ws + WS_PROJ), NMAIN};
        pg8::gemm_phase<EpiProj, pg8::DenseOrder, true, true>(F.lds, g, S, E);
    } SEAM(2);
    if (IN(3)) _Pragma("unroll") for (int rep_ = 0; rep_ < NREP(3); ++rep_) { for (int it = F.vb; it < 2048; it += F.G) { if (it < 1024) { dn_prep(F, it); if (P3MODE == 1) dn_prep(F, it); } else { ml_prep(F, it - 1024); if (P3MODE == 2) ml_prep(F, it - 1024); } } } SEAM(3);
    if (IN(4)) _Pragma("unroll") for (int rep_ = 0; rep_ < NREP(4); ++rep_) {
        for (int role = F.vb; role < 144; role += F.G) {
            if (role < 128) dn_scan<1>(F, (role & 7) + 8 * (role >> 6), (role >> 3) & 7);
            else ml_scan(F, role - 128);
        }
        convert_moe(F);
    } SEAM(4);
    if (IN(5)) _Pragma("unroll") for (int rep_ = 0; rep_ < NREP(5); ++rep_) {
        { DnOutRegs R; int it = F.vb; if (it < 1024) dn_out_load(F, it, R);
          for (; it < 1024; it += F.G) dn_out(F, it, R, it + F.G < 1024 ? it + F.G : -1); }
        for (int it = 1024 + (F.vb + F.G - 1024 % F.G) % F.G; it < 2048; it += F.G) ml_out(F, it - 1024);
    } SEAM(5);
    if (IN(6)) _Pragma("unroll") for (int rep_ = 0; rep_ < NREP(6); ++rep_) {
        pg8::Gemm g{(const bf16*)(F.ws + WS_MIX), D}; pg8::DenseOrder S; S.init(T, D, D, (const bf16*)(F.ws + WS_BTOUT), F.G, F.vb);
        EpiRes E{F.in[I_X], (float*)(F.ws + WS_X1), (const float*)(F.ws + WS_MOD)};
        pg8::gemm_phase<EpiRes, pg8::DenseOrder, false, true>(F.lds, g, S, E);
    } SEAM(6);
    if (IN(7)) _Pragma("unroll") for (int rep_ = 0; rep_ < NREP(7); ++rep_) { p6_router(F, rep_); } SEAM(7);
    if (IN(8)) _Pragma("unroll") for (int rep_ = 0; rep_ < NREP(8); ++rep_) {
        const int nmt = build_expert_tables(F);
        GroupedOrder<4, 8, true> S; S.G = F.G; S.c = F.vb; S.nmt = nmt; S.K = D; S.tileE = (const LAS int*)(F.lds + L_TILEE); S.tst = (const LAS int*)(F.lds + L_TST); S.cnt = (const LAS int*)(F.lds + L_CNT);
        S.slot_tok = (const int*)(F.ws + WS_SLOTTOK); S.Bt = (const bf16*)(F.ws + WS_BTGU); S.bexp = (size_t)2048 * D; S.tokbuf = (LAS unsigned*)(F.lds + L_EXTRA) + F.wave * 256;
        pg8::Gemm g{(const bf16*)(F.ws + WS_H), D};
        EpiGU E{(bf16*)(F.ws + WS_ACT), F.in[I_BGU]};
        pg8::gemm_phase<EpiGU, GroupedOrder<4, 8, true>, true, true>(F.lds, g, S, E);
    } SEAM(8);
    if (IN(9)) _Pragma("unroll") for (int rep_ = 0; rep_ < NREP(9); ++rep_) {
        const int nmt = build_expert_tables(F);
        GroupedOrder<8, 4, false> S; S.G = F.G; S.c = F.vb; S.nmt = nmt; S.K = D; S.tileE = (const LAS int*)(F.lds + L_TILEE); S.tst = (const LAS int*)(F.lds + L_TST); S.cnt = (const LAS int*)(F.lds + L_CNT);
        S.slot_tok = nullptr; S.Bt = (const bf16*)(F.ws + WS_BTDN); S.bexp = (size_t)D * D; S.tokbuf = nullptr;
        pg8::Gemm g{(const bf16*)(F.ws + WS_ACT), D};
        EpiDown E{(bf16*)(F.ws + WS_Y), F.in[I_BDN]};
        pg8::gemm_phase<EpiDown, GroupedOrder<8, 4, false>, true, true>(F.lds, g, S, E);
    } SEAM(9);
    for (int xb_ = 0; xb_ < XBARS; ++xb_) xcd_barrier(bar);
    if (IN(10)) _Pragma("unroll") for (int rep_ = 0; rep_ < NREP(10); ++rep_) { p9_final(F); }
#undef IN
#undef SEAM
}

extern "C" void kernel_launch(void* const* d_in, const int* in_sizes, int n_in, void* d_out, int out_size, void* d_ws, size_t ws_size, hipStream_t stream) {
    static int grid = 0;
    if (grid == 0) {
        if (n_in != 25 || in_sizes[0] != T * D || out_size != T * D || ws_size < WS_END) { fprintf(stderr, "kernel_launch: unexpected shapes (n_in %d, ws %zu)\n", n_in, ws_size); grid = -1; return; }
        int dev = 0, cus = 0, per_cu = 0;
        if (hipGetDevice(&dev) != hipSuccess || hipDeviceGetAttribute(&cus, hipDeviceAttributeMultiprocessorCount, dev) != hipSuccess) { grid = -1; return; }
        if (hipFuncSetAttribute((const void*)fwd, hipFuncAttributeMaxDynamicSharedMemorySize, LDS_BYTES) != hipSuccess) { fprintf(stderr, "kernel_launch: hipFuncSetAttribute failed\n"); grid = -1; return; }
        if (hipOccupancyMaxActiveBlocksPerMultiprocessor(&per_cu, (const void*)fwd, NTHR, LDS_BYTES) != hipSuccess || per_cu < 1) { fprintf(stderr, "kernel_launch: occupancy query says %d\n", per_cu); }
        (void)hipGetLastError();
        grid = cus;
    }
    if (grid < 0) return;
    hipMemsetAsync((char*)d_ws + WS_CTL, 0, CTL_ZERO_BYTES, stream);
    Args a{};
    for (int i = 0; i < 25; ++i) a.in[i] = (const float*)d_in[i];
    a.out = (float*)d_out; a.ws = (unsigned char*)d_ws;
#if MK_ONE_LAUNCH
    a.ph_lo = 0; a.ph_hi = NPH;
    hipLaunchKernelGGL(fwd, dim3(grid), dim3(NTHR), LDS_BYTES, stream, a);
#else
    for (int p = 0; p < NPH; ++p) { a.ph_lo = p; a.ph_hi = p + 1; hipLaunchKernelGGL(fwd, dim3(grid), dim3(NTHR), LDS_BYTES, stream, a); }
#endif
}
```

```cpp
#include <hip/hip_runtime.h>
#include <cstdio>
#include <cstdint>

#ifndef TP_A
#define TP_A -1
#endif
#ifndef TP_B
#define TP_B 0
#endif
#ifndef TP_SCALE
#define TP_SCALE 1
#endif
#define STAMP(id, blk) do { if (TP_A >= 0 && (int)blockIdx.x == (blk) && threadIdx.x == 0) ((unsigned long long*)(F.ws + WS_CTL + 131072))[(id)] = wall_clock64(); } while (0)
#ifndef MK_ONE_LAUNCH
#define MK_ONE_LAUNCH 1
#endif

namespace pg8 {
#define PG8_LAS __attribute__((address_space(3)))
typedef unsigned short bf16_t;
typedef short bf16x8 __attribute__((ext_vector_type(8)));
typedef float f32x4 __attribute__((ext_vector_type(4)));
typedef unsigned u32x4 __attribute__((ext_vector_type(4)));
constexpr int BM = 256, BK = 64, HALF = 128, HTB = HALF * BK * 2, STAGE_BYTES = 8 * HTB, NXCD = 8, WGM = 8;

__host__ __device__ __forceinline__ int lds_byte(int r, int c) { const int st = (r >> 4) * 2 + (c >> 5), rr = r & 15, cc = c & 31, ob = rr * 64 + cc * 2; return st * 1024 + (ob ^ (((ob >> 9) & 1) << 5)); }
__host__ __device__ __forceinline__ void stage_rc(int b, int& R, int& C) { const int st = b / 1024, sb = b % 1024, swz = sb ^ (((sb >> 9) & 1) << 5); R = (st >> 1) * 16 + swz / 64; C = (st & 1) * 32 + (swz % 64) / 2; }
__host__ __device__ __forceinline__ int perm32(int rho) { const int n = rho >> 4, i = rho & 15; return 8 * (i >> 2) + 4 * n + (i & 3); }

struct Unit { int pm, pn, e; };
struct Gemm { const bf16_t* A; int K; };

struct DenseOrder {
    int nM, nN, nwg, G, c, K; const bf16_t* Bt;
    __device__ void init(int M, int N, int K_, const bf16_t* Bt_, int G_, int c_) { nM = M / BM; nN = N / BM; nwg = nM * nN; G = G_; c = c_; K = K_; Bt = Bt_; }
    __device__ bool next(int i, Unit& u) const {
        const long L = (long)i * G + c; if (L >= nwg) return false;
        int wgid = (int)L; { const int q = nwg / NXCD, r = nwg % NXCD, xcd = wgid % NXCD, off = wgid / NXCD; wgid = (xcd < r ? xcd * (q + 1) : r * (q + 1) + (xcd - r) * q) + off; }
        const int nig = WGM * nN, gid = wgid / nig, fm = gid * WGM, gsz = (nM - fm) < WGM ? (nM - fm) : WGM;
        u.pm = fm + ((wgid % nig) % gsz); u.pn = (wgid % nig) / gsz; u.e = 0; return true;
    }
    __device__ __forceinline__ void a_voff(const Unit& u, const int (&R)[2], const int (&C)[2], unsigned (&vo)[2][2]) const {
#pragma unroll
        for (int h = 0; h < 2; ++h)
#pragma unroll
            for (int i = 0; i < 2; ++i) vo[h][i] = (unsigned)((u.pm * BM + h * HALF + R[i]) * K + C[i]) * 2u;
    }
    __device__ __forceinline__ void a_raw(const Unit& u, const int (&R)[2], const int (&C)[2], unsigned (&vo)[2][2]) const { a_voff(u, R, C, vo); }
    __device__ __forceinline__ void a_fin(const unsigned (&raw)[2][2], const int (&C)[2], unsigned (&vo)[2][2]) const { vo[0][0] = raw[0][0]; vo[0][1] = raw[0][1]; vo[1][0] = raw[1][0]; vo[1][1] = raw[1][1]; }
    __device__ __forceinline__ const char* b_ptr(const Unit& u) const { return (const char*)Bt + (size_t)u.pn * BM * K * 2; }
};

__device__ __forceinline__ unsigned cvt_pk_bf16(float lo, float hi) { unsigned r; asm volatile("v_cvt_pk_bf16_f32 %0, %1, %2" : "=v"(r) : "v"(lo), "v"(hi)); return r; }

template <class Epi, class Sched, bool ALIGN_EPI = false, bool SP2 = false>
__device__ __forceinline__ void gemm_phase(PG8_LAS unsigned char* lds, const Gemm g, const Sched& S, const Epi& E) {
    const int tid = threadIdx.x, wid = __builtin_amdgcn_readfirstlane(tid >> 6), lane = tid & 63, wr = wid >> 2, wc = wid & 3, fr = lane & 15, fq = lane >> 4;
    const int K = g.K, nt = K / BK;
    int RA[2], CA[2]; unsigned voffB[2];
#pragma unroll
    for (int i = 0; i < 2; ++i) { int R, C; stage_rc(tid * 16 + i * 8192, R, C); const int Rb = Epi::PERM ? ((R & ~31) + perm32(R & 31)) : R;
        RA[i] = R; CA[i] = C; voffB[i] = (unsigned)(Rb * K + C) * 2u; }
    const size_t kstep = (size_t)(BK * 2);
    const size_t hstep = (size_t)HALF * K * 2;
    const unsigned ldsw = (unsigned)wid * 1024u;
    const int aoff = lds_byte(wr * 64 + fr, fq * 8), boff = lds_byte(wc * 32 + fr, fq * 8);
#define PG8_SA(b, h) (((b) * 2 + (h)) * HTB)
#define PG8_SB(b, h) ((4 + (b) * 2 + (h)) * HTB)
#define PG8_STAGE(bufoff, gbase, voff) do { _Pragma("unroll") for (int _i = 0; _i < 2; ++_i) \
        __builtin_amdgcn_global_load_lds((const unsigned*)((const char*)(gbase) + (voff)[_i]), (PG8_LAS unsigned*)(lds + (bufoff) + ldsw + _i * 8192), 16, 0, 0); } while (0)
#define PG8_LDA(dst, b, h) do { _Pragma("unroll") for (int m = 0; m < 4; ++m) _Pragma("unroll") for (int k = 0; k < 2; ++k) dst[m][k] = *(const PG8_LAS bf16x8*)(lds + PG8_SA(b, h) + aoff + m * 2048 + k * 1024); } while (0)
#define PG8_LDB(dst, b, h) do { _Pragma("unroll") for (int n = 0; n < 2; ++n) _Pragma("unroll") for (int k = 0; k < 2; ++k) dst[n][k] = *(const PG8_LAS bf16x8*)(lds + PG8_SB(b, h) + boff + n * 2048 + k * 1024); } while (0)
#define PG8_MMA(ai, bj, At, Bt) do { __builtin_amdgcn_s_setprio(1); _Pragma("unroll") for (int m = 0; m < 4; ++m) _Pragma("unroll") for (int n = 0; n < 2; ++n) _Pragma("unroll") for (int k = 0; k < 2; ++k) \
        acc[ai][bj][m][n] = __builtin_amdgcn_mfma_f32_16x16x32_bf16(Bt[n][k], At[m][k], acc[ai][bj][m][n], 0, 0, 0); __builtin_amdgcn_s_setprio(0); } while (0)
#define PG8_WAIT_V(n) asm volatile("s_waitcnt vmcnt(" #n ")" ::: "memory")
#define PG8_WAIT_L(n) asm volatile("s_waitcnt lgkmcnt(" #n ")" ::: "memory")
#define PG8_BAR __builtin_amdgcn_s_barrier()
#define PG8_SCHED __builtin_amdgcn_sched_barrier(0)
    Unit cur, nxt; int ui = 0;
    if (!S.next(0, cur)) return;
    f32x4 acc[2][2][4][2];
#pragma unroll
    for (int a = 0; a < 2; ++a)
#pragma unroll
        for (int b = 0; b < 2; ++b)
#pragma unroll
            for (int m = 0; m < 4; ++m)
#pragma unroll
                for (int n = 0; n < 2; ++n) acc[a][b][m][n] = (f32x4){0.f, 0.f, 0.f, 0.f};
    bf16x8 At[4][2], B0[2][2], B1[2][2];
    unsigned cvo[2][2], nvo[2][2];
    S.a_voff(cur, RA, CA, cvo);
    const char* const Ab = (const char*)g.A;
    const char* cB = S.b_ptr(cur);
    if constexpr (SP2) {
        PG8_STAGE(PG8_SB(0, 0), cB, voffB); PG8_STAGE(PG8_SB(0, 1), cB + hstep, voffB); PG8_STAGE(PG8_SA(0, 0), Ab, cvo[0]); PG8_STAGE(PG8_SA(0, 1), Ab, cvo[1]);
        if (wr == 1) PG8_BAR;
        PG8_WAIT_V(2); PG8_BAR;
        PG8_STAGE(PG8_SB(1, 0), cB + kstep, voffB); PG8_STAGE(PG8_SA(1, 0), Ab + kstep, cvo[0]); PG8_STAGE(PG8_SB(1, 1), cB + hstep + kstep, voffB);
        PG8_WAIT_V(6); PG8_BAR;
    } else {
        PG8_STAGE(PG8_SB(0, 0), cB, voffB); PG8_STAGE(PG8_SA(0, 0), Ab, cvo[0]); PG8_STAGE(PG8_SB(0, 1), cB + hstep, voffB); PG8_STAGE(PG8_SA(0, 1), Ab, cvo[1]);
        if (wr == 1) PG8_BAR;
        PG8_WAIT_V(4); PG8_BAR;
        PG8_STAGE(PG8_SB(1, 0), cB + kstep, voffB); PG8_STAGE(PG8_SA(1, 0), Ab + kstep, cvo[0]); PG8_STAGE(PG8_SB(1, 1), cB + hstep + kstep, voffB);
        PG8_WAIT_V(6); PG8_BAR;
    }
    for (;;) {
        const bool has_next = S.next(ui + 1, nxt);
        const char* nB = cB;
        unsigned nraw[2][2];
        if (has_next) { nB = S.b_ptr(nxt); S.a_raw(nxt, RA, CA, nraw); }
        else { nraw[0][0] = 0u; nraw[0][1] = 0u; nraw[1][0] = 0u; nraw[1][1] = 0u; }
        for (int t = 0; t < nt; t += 2) {
            const bool last = (t == nt - 2);
            const char* a1 = Ab + (size_t)(t + 1) * kstep;
            const char* a2 = last ? Ab : Ab + (size_t)(t + 2) * kstep; const char* b2 = last ? nB : cB + (size_t)(t + 2) * kstep;
            const char* a3 = a2 + kstep; const char* b3 = b2 + kstep;
            unsigned v2[2][2];
            if (last) { asm volatile("" : "+v"(nraw[0][0]), "+v"(nraw[0][1]), "+v"(nraw[1][0]), "+v"(nraw[1][1]));
                if (has_next) S.a_fin(nraw, CA, nvo); else { nvo[0][0] = cvo[0][0]; nvo[0][1] = cvo[0][1]; nvo[1][0] = cvo[1][0]; nvo[1][1] = cvo[1][1]; }
                v2[0][0] = nvo[0][0]; v2[0][1] = nvo[0][1]; v2[1][0] = nvo[1][0]; v2[1][1] = nvo[1][1]; }
            else { v2[0][0] = cvo[0][0]; v2[0][1] = cvo[0][1]; v2[1][0] = cvo[1][0]; v2[1][1] = cvo[1][1]; }
            if constexpr (SP2) {
            PG8_LDB(B0, 0, 0); PG8_LDB(B1, 0, 1); PG8_SCHED; PG8_LDA(At, 0, 0); PG8_STAGE(PG8_SA(1, 1), a1, cvo[1]);
            PG8_WAIT_V(8); PG8_WAIT_L(0); PG8_BAR; PG8_MMA(0, 0, At, B0); PG8_MMA(0, 1, At, B1); PG8_BAR; PG8_SCHED;
            PG8_LDA(At, 0, 1); PG8_STAGE(PG8_SB(0, 0), b2, voffB); PG8_STAGE(PG8_SB(0, 1), b2 + hstep, voffB); PG8_STAGE(PG8_SA(0, 0), a2, v2[0]);
            PG8_WAIT_V(8); PG8_WAIT_L(0); PG8_BAR; PG8_MMA(1, 0, At, B0); PG8_MMA(1, 1, At, B1); PG8_BAR; PG8_SCHED;
            PG8_LDB(B0, 1, 0); PG8_LDB(B1, 1, 1); PG8_SCHED; PG8_LDA(At, 1, 0); PG8_STAGE(PG8_SA(0, 1), a2, v2[1]);
            PG8_WAIT_V(8); PG8_WAIT_L(0); PG8_BAR; PG8_MMA(0, 0, At, B0); PG8_MMA(0, 1, At, B1); PG8_BAR; PG8_SCHED;
            PG8_LDA(At, 1, 1); PG8_STAGE(PG8_SB(1, 0), b3, voffB); PG8_STAGE(PG8_SB(1, 1), b3 + hstep, voffB); PG8_STAGE(PG8_SA(1, 0), a3, v2[0]);
            PG8_WAIT_V(8); PG8_WAIT_L(0); PG8_BAR; PG8_MMA(1, 0, At, B0); PG8_MMA(1, 1, At, B1); PG8_BAR; PG8_SCHED;
            } else {
            PG8_LDB(B0, 0, 0); PG8_SCHED; PG8_LDA(At, 0, 0); PG8_STAGE(PG8_SA(1, 1), a1, cvo[1]);
            PG8_WAIT_L(8); PG8_BAR; PG8_WAIT_L(0); PG8_MMA(0, 0, At, B0); PG8_BAR; PG8_SCHED;
            PG8_LDB(B1, 0, 1); PG8_STAGE(PG8_SB(0, 0), b2, voffB);
            PG8_BAR; PG8_WAIT_L(0); PG8_MMA(0, 1, At, B1); PG8_BAR;
            PG8_LDA(At, 0, 1); PG8_STAGE(PG8_SA(0, 0), a2, v2[0]);
            PG8_BAR; PG8_WAIT_L(0); PG8_MMA(1, 0, At, B0); PG8_BAR; PG8_SCHED;
            PG8_STAGE(PG8_SB(0, 1), b2 + hstep, voffB);
            PG8_WAIT_V(6); PG8_BAR; PG8_MMA(1, 1, At, B1); PG8_BAR;
            PG8_LDB(B0, 1, 0); PG8_SCHED; PG8_LDA(At, 1, 0); PG8_STAGE(PG8_SA(0, 1), a2, v2[1]);
            PG8_WAIT_L(8); PG8_BAR; PG8_WAIT_L(0); PG8_MMA(0, 0, At, B0); PG8_BAR; PG8_SCHED;
            PG8_LDB(B1, 1, 1); PG8_STAGE(PG8_SB(1, 0), b3, voffB);
            PG8_BAR; PG8_WAIT_L(0); PG8_MMA(0, 1, At, B1); PG8_BAR;
            PG8_LDA(At, 1, 1); PG8_STAGE(PG8_SA(1, 0), a3, v2[0]);
            PG8_BAR; PG8_WAIT_L(0); PG8_MMA(1, 0, At, B0); PG8_BAR; PG8_SCHED;
            PG8_STAGE(PG8_SB(1, 1), b3 + hstep, voffB);
            PG8_WAIT_V(6); PG8_BAR; PG8_MMA(1, 1, At, B1); PG8_BAR;
            }
        }
        if constexpr (ALIGN_EPI) { if (wr == 0) PG8_BAR; }
        E(acc, cur, wr, wc, fr, fq);
        if (!has_next) break;
#pragma unroll
        for (int a = 0; a < 2; ++a)
#pragma unroll
            for (int b = 0; b < 2; ++b)
#pragma unroll
                for (int m = 0; m < 4; ++m)
#pragma unroll
                    for (int n = 0; n < 2; ++n) acc[a][b][m][n] = (f32x4){0.f, 0.f, 0.f, 0.f};
        cur = nxt; cB = nB; ++ui;
        cvo[0][0] = nvo[0][0]; cvo[0][1] = nvo[0][1]; cvo[1][0] = nvo[1][0]; cvo[1][1] = nvo[1][1];
        if constexpr (ALIGN_EPI) { if (wr == 1) PG8_BAR; }
    }
    PG8_WAIT_V(0);
    if constexpr (!ALIGN_EPI) { if (wr == 0) PG8_BAR; }
    PG8_BAR;
#undef PG8_SA
#undef PG8_SB
#undef PG8_STAGE
#undef PG8_LDA
#undef PG8_LDB
#undef PG8_MMA
#undef PG8_WAIT_V
#undef PG8_WAIT_L
#undef PG8_BAR
#undef PG8_SCHED
}
}

constexpr int NWAVES = 8, NTHR = 512;
constexpr int T = 16384, D = 1024, SEQ = 4096, NB = 4;
constexpr int DIN = 3600, NMAIN = 3584;
constexpr int NE = 32, TOPK = 4, ECAP = 16384, MAXMT = 288;
constexpr float EPS = 1e-6f;
constexpr int MC_DNQ = 0, MC_DNK = 512, MC_DNV = 1024, MC_DNZ = 1536, MC_MLQ = 2048, MC_MLK = 2304, MC_MLV = 2560, MC_MLO = 3072;

constexpr size_t MiB = 1u << 20;
constexpr size_t WS_CTL = 0, CTL_ZERO_BYTES = 1 * MiB;
constexpr size_t WS_MOD = 1 * MiB;
constexpr size_t WS_MODF = WS_MOD + 128 * 1024;
constexpr size_t WS_WRT = WS_MOD + 256 * 1024;
constexpr size_t WS_WGT = WS_MOD + 384 * 1024;
constexpr size_t WS_BTIN = 2 * MiB;
constexpr size_t WS_BTOUT = 9 * MiB;
constexpr size_t WS_G16 = 11 * MiB;
constexpr size_t WS_TOKE = 12 * MiB;
constexpr size_t WS_TOKR = WS_TOKE + 256 * 1024;
constexpr size_t WS_TOKW = WS_TOKE + 512 * 1024;
constexpr size_t WS_SLOTTOK = 13 * MiB;
constexpr size_t WS_H = 16 * MiB;
constexpr size_t WS_MIX = 48 * MiB;
constexpr size_t WS_X1 = 80 * MiB;
constexpr size_t WS_BTGU = 144 * MiB;
constexpr size_t WS_BTDN = 272 * MiB;
constexpr size_t WS_PROJ = 336 * MiB;
constexpr size_t WS_RAW = 448 * MiB;
constexpr size_t WS_ACT = 336 * MiB;
constexpr size_t WS_Y = 480 * MiB;
constexpr size_t WS_DN_MP = 512 * MiB;
constexpr size_t WS_DN_UT = 544 * MiB;
constexpr size_t WS_DN_KC = 608 * MiB;
constexpr size_t WS_DN_WT = 624 * MiB;
constexpr size_t WS_DN_QD = 640 * MiB;
constexpr size_t WS_DN_QK = 656 * MiB;
constexpr size_t WS_DN_SD = 664 * MiB;
constexpr size_t WS_DN_ST = 666 * MiB;
constexpr size_t WS_ML_UPT = 698 * MiB;
constexpr size_t WS_ML_QC = 730 * MiB;
constexpr size_t WS_ML_KC = 738 * MiB;
constexpr size_t WS_ML_CT = 746 * MiB;
constexpr size_t WS_ML_AUX = 762 * MiB;
constexpr size_t WS_END = 764 * MiB;
constexpr int CW_BAR = 8192;
constexpr int CW_CNT = 1024;
constexpr int CW_CONV = 4096;

constexpr int RING_BYTES = 131072;
constexpr int LDSCTL_OFF = RING_BYTES;
constexpr int L_MISC = LDSCTL_OFF;
constexpr int L_CNT = LDSCTL_OFF + 256;
constexpr int L_TST = LDSCTL_OFF + 384;
constexpr int L_TILEE = LDSCTL_OFF + 576;
constexpr int L_EXTRA = LDSCTL_OFF + 2048;
constexpr int LDS_BYTES = 147456;

#define LAS __attribute__((address_space(3)))
typedef unsigned short bf16;
typedef unsigned v4u __attribute__((ext_vector_type(4)));
typedef unsigned v2u __attribute__((ext_vector_type(2)));
typedef float f32x4 __attribute__((ext_vector_type(4)));
#define LDS_WAIT() asm volatile("s_waitcnt lgkmcnt(0)" ::: "memory")
#define LDS_BARRIER() do { asm volatile("s_waitcnt lgkmcnt(0)" ::: "memory"); __builtin_amdgcn_s_barrier(); asm volatile("" ::: "memory"); } while (0)
__device__ __forceinline__ unsigned f2bf(float f) { unsigned u = __builtin_bit_cast(unsigned, f); return (u + 0x7fffu + ((u >> 16) & 1u)) >> 16; }
typedef __bf16 bf16v2_t __attribute__((ext_vector_type(2)));
typedef float f32v2_t __attribute__((ext_vector_type(2)));
__device__ __forceinline__ unsigned pk2(float lo, float hi) { const f32v2_t v = {lo, hi}; const bf16v2_t b = __builtin_convertvector(v, bf16v2_t); return __builtin_bit_cast(unsigned, b); }
__device__ __forceinline__ float bf2f(unsigned short b) { return __builtin_bit_cast(float, ((unsigned)b) << 16); }
#define UBF(v) ((f32x4){bf2f((v).x & 0xffff), bf2f((v).x >> 16), bf2f((v).y & 0xffff), bf2f((v).y >> 16)})
__device__ __forceinline__ float sigmoidf_(float x) { return __builtin_amdgcn_rcpf(1.0f + __builtin_amdgcn_exp2f(-1.4426950408889634f * x)); }
__device__ __forceinline__ float siluf_(float x) { return x * __builtin_amdgcn_rcpf(1.0f + __builtin_amdgcn_exp2f(-1.4426950408889634f * x)); }
__device__ __forceinline__ float softplusf_(float x) { return x > 20.f ? x : log1pf(__expf(x)); }
__device__ __forceinline__ float logsigmoidf_(float x) { return x < 0.f ? x - log1pf(__expf(x)) : -log1pf(__expf(-x)); }

#define XB_TMO      128
#define XB_XCNT(j)  (256  + 64 * (j))
#define XB_XSUB(j)  (1280 + 64 * (j))
#define XB_XGEN(j)  (2304 + 64 * (j))
#define XB_TOP      3328
#define XB_TOPGEN   3392
#define XCD_BAR_WORDS 3456
#define XB_SPIN_CAP (1u << 18)
__device__ __forceinline__ unsigned xb_ld(unsigned* p)              { return __hip_atomic_load(p, __ATOMIC_RELAXED, __HIP_MEMORY_SCOPE_AGENT); }
__device__ __forceinline__ unsigned xb_add(unsigned* p, unsigned v) { return __hip_atomic_fetch_add(p, v, __ATOMIC_RELAXED, __HIP_MEMORY_SCOPE_AGENT); }
__device__ __forceinline__ unsigned xb_xcc_id() { return (unsigned)__builtin_amdgcn_s_getreg((3 << 11) | 20) & 0xFu; }
#define XB_SPIN(cond, bar) do { unsigned _sp = 0; while (cond) { __builtin_amdgcn_s_sleep(1); \
    if ((++_sp & 255u) == 0u) { if (xb_ld(&(bar)[XB_TMO])) break; if (_sp > XB_SPIN_CAP) { atomicAdd(&(bar)[XB_TMO], 1u); break; } } } } while (0)
struct XcdBarrier { unsigned* bar; unsigned x; volatile LAS unsigned* st; };
__device__ __forceinline__ XcdBarrier xcd_barrier_post(unsigned* bar, volatile LAS unsigned* st) {
    XcdBarrier b; b.bar = bar; b.x = xb_xcc_id(); b.st = st;
    if (threadIdx.x == 0) (void)xb_add(&bar[XB_XCNT(b.x)], 1u);
    return b;
}
__device__ __forceinline__ void xcd_barrier_complete(unsigned* bar, unsigned x, unsigned& nloc, unsigned& nx) {
    const unsigned G = gridDim.x * gridDim.y * gridDim.z;
    unsigned sum, cnt, mine, sp = 0u;
    for (;;) {
        sum = 0u; cnt = 0u; mine = 0u;
#pragma unroll
        for (unsigned j = 0; j < 16; ++j) { const unsigned c = xb_ld(&bar[XB_XCNT(j)]); sum += c; cnt += (c > 0u) ? 1u : 0u; mine = (j == x) ? c : mine; }
        if (sum == G) break;
        __builtin_amdgcn_s_sleep(1);
        if ((++sp & 255u) == 0u) { if (xb_ld(&bar[XB_TMO])) break; if (sp > XB_SPIN_CAP) { atomicAdd(&bar[XB_TMO], 1u); break; } }
    }
    nloc = mine > 0u ? mine : 1u; nx = cnt > 0u ? cnt : 1u;
}
__device__ __forceinline__ void xcd_barrier(const XcdBarrier& b) {
    asm volatile("s_waitcnt vmcnt(0)" ::: "memory");
    __syncthreads();
    if (threadIdx.x == 0) {
        unsigned* bar = b.bar;
        __builtin_amdgcn_s_waitcnt(0);
        unsigned nloc = b.st[0], nx = b.st[1];
        if (nloc == 0u) { xcd_barrier_complete(bar, b.x, nloc, nx); b.st[0] = nloc; b.st[1] = nx; }
        const unsigned old = xb_add(&bar[XB_XSUB(b.x)], 1u);
        const unsigned gen = old / nloc;
        if (old + 1u == (gen + 1u) * nloc) {
            __builtin_amdgcn_fence(__ATOMIC_RELEASE, "agent");
            asm volatile("s_waitcnt vmcnt(0)" ::: "memory");
            const unsigned og = xb_add(&bar[XB_TOP], 1u);
            const unsigned tg = og / nx;
            if (og + 1u == (tg + 1u) * nx) xb_add(&bar[XB_TOPGEN], 1u);
            else XB_SPIN(xb_ld(&bar[XB_TOPGEN]) == tg, bar);
            __builtin_amdgcn_fence(__ATOMIC_ACQUIRE, "agent");
            xb_add(&bar[XB_XGEN(b.x)], 1u);
            asm volatile("s_waitcnt vmcnt(0)" ::: "memory");
        } else {
            XB_SPIN(xb_ld(&bar[XB_XGEN(b.x)]) == gen, bar);
            __builtin_amdgcn_fence(__ATOMIC_ACQUIRE, "agent");
            asm volatile("s_waitcnt vmcnt(0)" ::: "memory");
        }
    }
    __syncthreads();
}

struct Args { const float* in[25]; float* out; unsigned char* ws; int ph_lo, ph_hi; };
struct InPtrs { const float* const* p; __device__ __forceinline__ const float* operator[](int i) const { const float* const* q = p; asm volatile("" : "+s"(q)); return q[i]; } };
struct Frame {
    LAS unsigned char* lds; unsigned char* ws; InPtrs in; float* out;
    int tid, lane, wave, vb, G;
};
enum { I_X = 0, I_C, I_WADA, I_BADA, I_NMIX, I_WIN, I_DNCONV, I_DNALOG, I_DNDT, I_DNNORM, I_MLCONV, I_MLIB, I_MLFB, I_MLNORM, I_WOUT, I_NFFN, I_WR, I_BR, I_WGU, I_BGU, I_WDN, I_BDN, I_WADAF, I_BADAF, I_NFIN };

__device__ __forceinline__ float wave_sum(float v) {
#pragma unroll
    for (int o = 1; o < 64; o <<= 1) v += __shfl_xor(v, o);
    return v;
}

__device__ __forceinline__ void transpose_item(const float* W, int ldw, int K, bf16* WT, int k0, int src_n0, int dst_n0, LAS float* scr, int lane) {
    float tv[32];
#pragma unroll
    for (int i = 0; i < 32; ++i) { const int kk = 2 * i + (lane >> 5); tv[i] = W[(size_t)(k0 + kk) * ldw + src_n0 + (lane & 31)]; }
#pragma unroll
    for (int i = 0; i < 32; ++i) { const int kk = 2 * i + (lane >> 5); scr[kk * 33 + (lane & 31)] = tv[i]; }
    LDS_WAIT(); asm volatile("" ::: "memory");
    const int c = lane & 7;
#pragma unroll
    for (int j = 0; j < 4; ++j) { const int n = (lane >> 3) + 8 * j; const LAS float* s = scr + (8 * c) * 33 + n;
        v4u o; o.x = pk2(s[0 * 33], s[1 * 33]); o.y = pk2(s[2 * 33], s[3 * 33]); o.z = pk2(s[4 * 33], s[5 * 33]); o.w = pk2(s[6 * 33], s[7 * 33]);
        *(v4u*)(WT + (size_t)(dst_n0 + n) * K + k0 + 8 * c) = o; }
    LDS_WAIT(); asm volatile("" ::: "memory");
}
__device__ __forceinline__ void p0_prologue(Frame& F) {
    __syncthreads();
    {
        LAS float* cond = (LAS float*)F.lds;
        LAS float* part = (LAS float*)(F.lds + 16384);
        const float* c = F.in[I_C];
        for (int i = F.tid; i < NB * D; i += NTHR) cond[i] = siluf_(c[i]);
        __syncthreads();
        for (int cb = F.vb; cb < 256; cb += F.G) {
            const int j0 = cb * 32; const bool fin = j0 >= 6144;
            const float* W = fin ? F.in[I_WADAF] : F.in[I_WADA]; const int ld = fin ? 2048 : 6144; const int jc = fin ? j0 - 6144 : j0;
            const float* bias = fin ? F.in[I_BADAF] : F.in[I_BADA];
            float* out = fin ? (float*)(F.ws + WS_MODF) : (float*)(F.ws + WS_MOD);
            const int s = F.tid >> 5, jj = F.tid & 31;
            float a0 = 0.f, a1 = 0.f, a2 = 0.f, a3 = 0.f;
            for (int k = s * 64; k < s * 64 + 64; ++k) { const float w = W[(size_t)k * ld + jc + jj]; a0 += cond[k] * w; a1 += cond[1024 + k] * w; a2 += cond[2048 + k] * w; a3 += cond[3072 + k] * w; }
            part[(s * 4 + 0) * 32 + jj] = a0; part[(s * 4 + 1) * 32 + jj] = a1; part[(s * 4 + 2) * 32 + jj] = a2; part[(s * 4 + 3) * 32 + jj] = a3;
            __syncthreads();
            if (F.tid < 128) { const int b = F.tid >> 5, j = F.tid & 31; float sum = 0.f;
                for (int q = 0; q < 16; ++q) sum += part[(q * 4 + b) * 32 + j];
                out[b * ld + jc + j] = sum + bias[jc + j]; }
            __syncthreads();
        }
    }
    {
        const int gt = F.vb * NTHR + F.tid, NGT = F.G * NTHR;
        float* wrT = (float*)(F.ws + WS_WRT); const float* wr = F.in[I_WR];
        for (int i = gt; i < NE * D; i += NGT) { const int e = i >> 10, k = i & 1023; wrT[i] = wr[k * NE + e]; }
        float* wgT = (float*)(F.ws + WS_WGT); const float* win = F.in[I_WIN];
        for (int i = gt; i < 16 * D; i += NGT) { const int g = i >> 10, k = i & 1023; const int col = g < 8 ? 2048 + g : 3592 + (g - 8); wgT[i] = win[(size_t)k * DIN + col]; }
    }
    {
        LAS float* scr = (LAS float*)(F.lds + F.wave * 16384);
        const int gw = F.vb * NWAVES + F.wave, NGW = F.G * NWAVES;
        constexpr int I_IN = 16 * (NMAIN / 32), I_OUT = 16 * 32;
        for (int it = gw; it < I_IN + I_OUT; it += NGW) {
            int r = it;
            if (r < I_IN) { const int nblk = NMAIN / 32, kb = r / nblk, nb = r % nblk; const int dn0 = nb * 32, sn0 = dn0 < 2048 ? dn0 : dn0 + 8;
                transpose_item(F.in[I_WIN], DIN, D, (bf16*)(F.ws + WS_BTIN), kb * 64, sn0, dn0, scr, F.lane); continue; }
            r -= I_IN;
            { const int kb = r / 32, nb = r % 32; transpose_item(F.in[I_WOUT], D, D, (bf16*)(F.ws + WS_BTOUT), kb * 64, nb * 32, nb * 32, scr, F.lane); }
        }
    }
}
__device__ __forceinline__ void convert_moe(Frame& F) {
    LAS float* scr = (LAS float*)(F.lds + F.wave * 16384);
    volatile LAS int* claim = (volatile LAS int*)(F.lds + L_MISC) + 16;
    unsigned* ctr = (unsigned*)(F.ws + WS_CTL) + CW_CONV;
    constexpr int I_GU1 = 16 * 64, I_DN1 = 16 * 32, NITEMS = NE * (I_GU1 + I_DN1);
    for (;;) {
        __syncthreads();
        if (F.tid == 0) claim[0] = (int)__hip_atomic_fetch_add(ctr, 64u, __ATOMIC_RELAXED, __HIP_MEMORY_SCOPE_AGENT);
        __syncthreads();
        const int base = claim[0];
        if (base >= NITEMS) break;
#pragma unroll 1
        for (int q8 = 0; q8 < 8; ++q8) {
            int r = base + q8 * 8 + F.wave;
            if (r < NE * I_GU1) { const int e = r / I_GU1, q = r % I_GU1, kb = q / 64, nb = q % 64; const int dn0 = nb * 32;
                const int sn0 = ((dn0 & 255) >> 7) * 1024 + (dn0 >> 8) * 128 + (dn0 & 127);
                transpose_item(F.in[I_WGU] + (size_t)e * D * 2048, 2048, D, (bf16*)(F.ws + WS_BTGU) + (size_t)e * 2048 * D, kb * 64, sn0, dn0, scr, F.lane); continue; }
            r -= NE * I_GU1;
            { const int e = r / I_DN1, q = r % I_DN1, kb = q / 32, nb = q % 32;
                transpose_item(F.in[I_WDN] + (size_t)e * D * D, D, D, (bf16*)(F.ws + WS_BTDN) + (size_t)e * D * D, kb * 64, nb * 32, nb * 32, scr, F.lane); }
        }
    }
}

#define MR_STEP(n, bit) { const bool hi = (lane & (bit)) != 0; _Pragma("unroll") for (int i = 0; i < (n) / 2; ++i) { const float send = hi ? v[i] : v[i + (n) / 2]; const float keep = hi ? v[i + (n) / 2] : v[i]; v[i] = keep + __shfl_xor(send, (bit)); } }
template <int N> __device__ __forceinline__ float multi_reduce(float (&v)[N], int lane) {
    float r;
    if constexpr (N == 32) { MR_STEP(32, 32) MR_STEP(16, 16) MR_STEP(8, 8) MR_STEP(4, 4) MR_STEP(2, 2) r = v[0]; r += __shfl_xor(r, 1); }
    else { MR_STEP(16, 32) MR_STEP(8, 16) MR_STEP(4, 8) MR_STEP(2, 4) r = v[0]; r += __shfl_xor(r, 2); r += __shfl_xor(r, 1); }
    return r;
}

__device__ __forceinline__ void p1_norm1(Frame& F) {
    LAS float* wg = (LAS float*)F.lds;
    { const float* src = (const float*)(F.ws + WS_WGT); for (int i = F.tid; i < 16 * D / 4; i += NTHR) ((LAS f32x4*)wg)[i] = ((const f32x4*)src)[i]; }
    __syncthreads();
    const float* x = F.in[I_X]; const float* nw = F.in[I_NMIX]; const float* mod = (const float*)(F.ws + WS_MOD);
    bf16* h1 = (bf16*)(F.ws + WS_H); float* g16 = (float*)(F.ws + WS_G16);
    const int gw = F.vb * NWAVES + F.wave, NGW = F.G * NWAVES;
    for (int row = gw; row < T; row += NGW) {
        const int b = row / SEQ;
        const f32x4* xr = (const f32x4*)(x + (size_t)row * D) + F.lane;
        f32x4 v[4]; float ss = 0.f;
#pragma unroll
        for (int j = 0; j < 4; ++j) { v[j] = xr[64 * j]; ss += (v[j].x * v[j].x + v[j].y * v[j].y) + (v[j].z * v[j].z + v[j].w * v[j].w); }
        const float rstd = rsqrtf(wave_sum(ss) * (1.f / D) + EPS);
        const float* sh = mod + b * 6144; const float* sc = sh + 1024;
#pragma unroll
        for (int j = 0; j < 4; ++j) { const int k = 256 * j + F.lane * 4;
            const f32x4 w = *(const f32x4*)(nw + k), s1 = *(const f32x4*)(sc + k), s0 = *(const f32x4*)(sh + k);
            v[j] = (v[j] * rstd * w) * (1.0f + s1) + s0; }
        v2u* o8 = (v2u*)(h1 + (size_t)row * D) + F.lane;
#pragma unroll
        for (int j = 0; j < 4; ++j) { v2u o; o.x = pk2(v[j].x, v[j].y); o.y = pk2(v[j].z, v[j].w); o8[64 * j] = o; }
        float acc[16];
#pragma unroll
        for (int g = 0; g < 16; ++g) { float a = 0.f;
#pragma unroll
            for (int j = 0; j < 4; ++j) { const f32x4 w = *(const LAS f32x4*)(wg + g * 1024 + 256 * j + F.lane * 4); a += (v[j].x * w.x + v[j].y * w.y) + (v[j].z * w.z + v[j].w * w.w); }
            acc[g] = a; if (g & 1) asm volatile("" ::: "memory"); }
        const float r = multi_reduce<16>(acc, F.lane);
        if ((F.lane & 3) == 0) g16[(size_t)row * 16 + (F.lane >> 2)] = r;
    }
}

struct EpiProj {
    static constexpr bool PERM = true;
    bf16* O; int ldc;
    __device__ __forceinline__ void operator()(const pg8::f32x4 (&acc)[2][2][4][2], const pg8::Unit& u, int wr, int wc, int fr, int fq) const {
        const int row0 = u.pm * 256 + wr * 64 + fr, col0 = u.pn * 256 + wc * 32 + 8 * fq;
#pragma unroll
        for (int ai = 0; ai < 2; ++ai)
#pragma unroll
            for (int m = 0; m < 4; ++m) { bf16* rowp = O + (size_t)(row0 + ai * 128 + m * 16) * ldc + col0;
#pragma unroll
                for (int bj = 0; bj < 2; ++bj) { const pg8::f32x4 v0 = acc[ai][bj][m][0], v1 = acc[ai][bj][m][1];
                    v4u w; w.x = pk2(v0[0], v0[1]); w.y = pk2(v0[2], v0[3]); w.z = pk2(v1[0], v1[1]); w.w = pk2(v1[2], v1[3]);
                    *(v4u*)(rowp + bj * 128) = w; } }
    }
};
struct EpiRes {
    static constexpr bool PERM = true;
    const float* X; bf16* O; const float* mod;
    __device__ __forceinline__ void operator()(const pg8::f32x4 (&acc)[2][2][4][2], const pg8::Unit& u, int wr, int wc, int fr, int fq) const {
        const int row0 = u.pm * 256 + wr * 64 + fr, col0 = u.pn * 256 + wc * 32 + 8 * fq;
        const int b = (u.pm * 256) / SEQ; const float* g1 = mod + b * 6144 + 2048;
        pg8::f32x4 gv[2][2];
#pragma unroll
        for (int bj = 0; bj < 2; ++bj)
#pragma unroll
            for (int n = 0; n < 2; ++n) gv[bj][n] = *(const pg8::f32x4*)(g1 + col0 + bj * 128 + 4 * n);
#pragma unroll
        for (int ai = 0; ai < 2; ++ai)
#pragma unroll
            for (int m = 0; m < 4; ++m) { const size_t off = (size_t)(row0 + ai * 128 + m * 16) * D + col0;
#pragma unroll
                for (int bj = 0; bj < 2; ++bj) { const pg8::f32x4 x0 = *(const pg8::f32x4*)(X + off + bj * 128), x1v = *(const pg8::f32x4*)(X + off + bj * 128 + 4);
                    const pg8::f32x4 v0 = x0 + gv[bj][0] * acc[ai][bj][m][0], v1 = x1v + gv[bj][1] * acc[ai][bj][m][1];
                    v4u w; w.x = pk2(v0[0], v0[1]); w.y = pk2(v0[2], v0[3]); w.z = pk2(v1[0], v1[1]); w.w = pk2(v1[2], v1[3]);
                    *(v4u*)(O + off + bj * 128) = w; }
                asm volatile("" ::: "memory"); }
    }
};
struct EpiGU {
    static constexpr bool PERM = true;
    bf16* O; const float* bgu;
    __device__ __forceinline__ void operator()(const pg8::f32x4 (&acc)[2][2][4][2], const pg8::Unit& u, int wr, int wc, int fr, int fq) const {
        const int row0 = u.pm * 256 + wr * 64 + fr, cc = u.pn * 128 + wc * 32 + 8 * fq;
        const float* bg = bgu + (size_t)u.e * 2048 + cc; const float* bu = bg + 1024;
        pg8::f32x4 bgv[2], buv[2];
#pragma unroll
        for (int n = 0; n < 2; ++n) { bgv[n] = *(const pg8::f32x4*)(bg + 4 * n); buv[n] = *(const pg8::f32x4*)(bu + 4 * n); }
#pragma unroll
        for (int ai = 0; ai < 2; ++ai)
#pragma unroll
            for (int m = 0; m < 4; ++m) { bf16* rowp = O + (size_t)(row0 + ai * 128 + m * 16) * D + cc;
                float r[8];
#pragma unroll
                for (int n = 0; n < 2; ++n)
#pragma unroll
                    for (int j = 0; j < 4; ++j) { float gt = acc[ai][0][m][n][j] + bgv[n][j], up = acc[ai][1][m][n][j] + buv[n][j];
                        gt = fminf(gt, 7.0f); up = fminf(fmaxf(up, -7.0f), 7.0f);
                        r[n * 4 + j] = (up + 1.0f) * gt * sigmoidf_(1.702f * gt); }
                v4u w; w.x = pk2(r[0], r[1]); w.y = pk2(r[2], r[3]); w.z = pk2(r[4], r[5]); w.w = pk2(r[6], r[7]);
                *(v4u*)rowp = w; }
    }
};
struct EpiDown {
    static constexpr bool PERM = true;
    bf16* O; const float* bdn;
    __device__ __forceinline__ void operator()(const pg8::f32x4 (&acc)[2][2][4][2], const pg8::Unit& u, int wr, int wc, int fr, int fq) const {
        const int row0 = u.pm * 256 + wr * 64 + fr, col0 = u.pn * 256 + wc * 32 + 8 * fq;
        const float* bb = bdn + (size_t)u.e * D + col0;
        pg8::f32x4 bv[2][2];
#pragma unroll
        for (int bj = 0; bj < 2; ++bj)
#pragma unroll
            for (int n = 0; n < 2; ++n) bv[bj][n] = *(const pg8::f32x4*)(bb + bj * 128 + 4 * n);
#pragma unroll
        for (int ai = 0; ai < 2; ++ai)
#pragma unroll
            for (int m = 0; m < 4; ++m) { bf16* rowp = O + (size_t)(row0 + ai * 128 + m * 16) * D + col0;
#pragma unroll
                for (int bj = 0; bj < 2; ++bj) { const pg8::f32x4 v0 = acc[ai][bj][m][0] + bv[bj][0], v1 = acc[ai][bj][m][1] + bv[bj][1];
                    v4u w; w.x = pk2(v0[0], v0[1]); w.y = pk2(v0[2], v0[3]); w.z = pk2(v1[0], v1[1]); w.w = pk2(v1[2], v1[3]);
                    *(v4u*)(rowp + bj * 128) = w; } }
    }
};

template <int MB, int NBK, bool GATHER> struct GroupedOrder {
    int G, c, nmt, K; const LAS int* tileE; const LAS int* tst; const LAS int* cnt; const int* slot_tok; const bf16* Bt; size_t bexp; LAS unsigned* tokbuf;
    __device__ bool next(int i, pg8::Unit& u) const {
        const int nwg = nmt * NBK; const long L = (long)i * G + c; if (L >= nwg) return false;
        int U = (int)L; { const int q = nwg / 8, r = nwg % 8, xcd = U % 8, off = U / 8; U = (xcd < r ? xcd * (q + 1) : r * (q + 1) + (xcd - r) * q) + off; }
        const int nig = MB * NBK, gid = U / nig, fm = gid * MB, gsz = (nmt - fm) < MB ? (nmt - fm) : MB;
        u.pm = fm + ((U % nig) % gsz); u.pn = (U % nig) / gsz; u.e = tileE[u.pm]; return true;
    }
    __device__ __forceinline__ void a_voff(const pg8::Unit& u, const int (&R)[2], const int (&C)[2], unsigned (&vo)[2][2]) const {
        if (GATHER) {
            const int r0 = (u.pm - tst[u.e]) * 256, ce = cnt[u.e];
#pragma unroll
            for (int h = 0; h < 2; ++h)
#pragma unroll
                for (int i = 0; i < 2; ++i) { int rk = r0 + h * 128 + R[i]; rk = rk < ce ? rk : ce - 1; const int tok = slot_tok[u.e * ECAP + rk];
                    vo[h][i] = (unsigned)(tok * K + C[i]) * 2u; }
        } else {
#pragma unroll
            for (int h = 0; h < 2; ++h)
#pragma unroll
                for (int i = 0; i < 2; ++i) vo[h][i] = (unsigned)((u.pm * 256 + h * 128 + R[i]) * K + C[i]) * 2u;
        }
    }
    __device__ __forceinline__ void a_raw(const pg8::Unit& u, const int (&R)[2], const int (&C)[2], unsigned (&raw)[2][2]) const {
        if (GATHER) {
            const int r0 = (u.pm - tst[u.e]) * 256, ce = cnt[u.e];
#pragma unroll
            for (int h = 0; h < 2; ++h)
#pragma unroll
                for (int i = 0; i < 2; ++i) { int rk = r0 + h * 128 + R[i]; rk = rk < ce ? rk : ce - 1; raw[h][i] = 0u;
                    __builtin_amdgcn_global_load_lds((const unsigned*)(slot_tok + u.e * ECAP + rk), (LAS unsigned*)(tokbuf + (h * 2 + i) * 64), 4, 0, 0); }
        } else a_voff(u, R, C, raw);
    }
    __device__ __forceinline__ void a_fin(const unsigned (&raw)[2][2], const int (&C)[2], unsigned (&vo)[2][2]) const {
#pragma unroll
        for (int h = 0; h < 2; ++h)
#pragma unroll
            for (int i = 0; i < 2; ++i) vo[h][i] = GATHER ? (tokbuf[(h * 2 + i) * 64 + (threadIdx.x & 63)] * (unsigned)K + (unsigned)C[i]) * 2u : raw[h][i];
    }
    __device__ __forceinline__ const char* b_ptr(const pg8::Unit& u) const { return (const char*)(Bt + (size_t)u.e * bexp + (size_t)u.pn * 256 * K); }
};

__device__ __forceinline__ int build_expert_tables(Frame& F) {
    LAS int* lc = (LAS int*)(F.lds + L_CNT); LAS int* lt = (LAS int*)(F.lds + L_TST); LAS int* le = (LAS int*)(F.lds + L_TILEE);
    const unsigned* gc = (const unsigned*)(F.ws + WS_CTL) + CW_CNT;
    __syncthreads();
    if (F.tid < 64) {
        int c = 0; if (F.lane < NE) { c = (int)__hip_atomic_load(gc + 64 * F.lane, __ATOMIC_RELAXED, __HIP_MEMORY_SCOPE_AGENT); if (c > ECAP) c = ECAP; }
        const int nt = (c + 255) >> 8; int incl = nt;
#pragma unroll
        for (int o = 1; o < 32; o <<= 1) { const int v = __shfl_up(incl, o); if (F.lane >= o) incl += v; }
        const int excl = incl - nt;
        if (F.lane < NE) { lc[F.lane] = c; lt[F.lane] = excl; for (int i = 0; i < nt; ++i) le[excl + i] = F.lane; }
        if (F.lane == NE - 1) lt[NE] = incl;
    }
    __syncthreads();
    return lt[NE];
}

__device__ __forceinline__ void p3_naive_dn(Frame& F, int bh) {
    const int b = bh >> 2, h = bh & 3;
    LAS float* qs_ = (LAS float*)F.lds;
    LAS float* ks_ = qs_ + 64 * 128;
    LAS float* vs_ = ks_ + 64 * 128;
    LAS float* qsc = vs_ + 64 * 128;
    LAS float* ksc = qsc + 64; LAS float* bet = ksc + 64; LAS float* ade = bet + 64;
    const bf16* proj = (const bf16*)(F.ws + WS_PROJ); const float* g16 = (const float*)(F.ws + WS_G16);
    const float* cw = F.in[I_DNCONV]; float* raw = (float*)(F.ws + WS_RAW);
    const float Aexp = __expf(F.in[I_DNALOG][h]), dtb = F.in[I_DNDT][h];
    const int e = F.tid >> 2, ds = F.tid & 3, d0 = ds * 32;
    float S[32];
#pragma unroll
    for (int i = 0; i < 32; ++i) S[i] = 0.f;
    for (int n = 0; n < 64; ++n) {
        __syncthreads();
        for (int idx = F.tid; idx < 64 * 384; idx += NTHR) {
            const int i = idx / 384, c = idx % 384, which = c >> 7, cc = c & 127, col = which * 512 + h * 128 + cc;
            const int t = n * 64 + i; float a = 0.f;
#pragma unroll
            for (int j = 0; j < 4; ++j) { const int tt = t - 3 + j; if (tt >= 0) a += bf2f(proj[(size_t)(b * SEQ + tt) * NMAIN + col]) * cw[j * 1536 + col]; }
            (which == 0 ? qs_ : which == 1 ? ks_ : vs_)[i * 128 + cc] = siluf_(a);
        }
        if (F.tid < 64) { const size_t row = (size_t)b * SEQ + n * 64 + F.tid;
            bet[F.tid] = sigmoidf_(g16[row * 16 + h]); ade[F.tid] = __expf(-Aexp * softplusf_(g16[row * 16 + 4 + h] + dtb)); }
        __syncthreads();
        if (F.tid < 128) { const int i = F.tid & 63, which = F.tid >> 6; const LAS float* p = (which ? ks_ : qs_) + i * 128; float ss = 0.f;
            for (int c = 0; c < 128; ++c) ss += p[c] * p[c];
            const float sc = rsqrtf(ss + EPS); if (which) ksc[i] = sc; else qsc[i] = sc * 0.08838834764831845f; }
        __syncthreads();
        for (int i = 0; i < 64; ++i) {
            const float kscale = ksc[i], qscale = qsc[i], be = bet[i], a = ade[i];
            const LAS float* kp = ks_ + i * 128 + d0; const LAS float* qp = qs_ + i * 128 + d0;
            float kv[32]; float p = 0.f;
#pragma unroll
            for (int d = 0; d < 32; ++d) { kv[d] = kp[d] * kscale; p += kv[d] * S[d]; }
            p += __shfl_xor(p, 1); p += __shfl_xor(p, 2);
            const float uu = be * (vs_[i * 128 + e] - a * p);
            float o = 0.f;
#pragma unroll
            for (int d = 0; d < 32; ++d) { S[d] = a * S[d] + kv[d] * uu; o += qp[d] * S[d]; }
            o *= qscale; o += __shfl_xor(o, 1); o += __shfl_xor(o, 2);
            if (ds == 0) raw[((size_t)b * SEQ + n * 64 + i) * D + h * 128 + e] = o;
        }
    }
}
__device__ __forceinline__ void p3_naive_ml(Frame& F, int bh) {
    const int b = bh >> 2, h = bh & 3;
    LAS float* qs_ = (LAS float*)F.lds;
    LAS float* ks_ = qs_ + 64 * 64;
    LAS float* vs_ = ks_ + 64 * 64;
    LAS float* ipr = vs_ + 64 * 128; LAS float* lgf = ipr + 64;
    const bf16* proj = (const bf16*)(F.ws + WS_PROJ); const float* g16 = (const float*)(F.ws + WS_G16);
    const float* cw = F.in[I_MLCONV]; float* raw = (float*)(F.ws + WS_RAW);
    const float ib = F.in[I_MLIB][h], fb = F.in[I_MLFB][h];
    const int e = F.tid >> 2, ds = F.tid & 3, d0 = ds * 16;
    float C[16], nn[16]; float m = 0.f;
#pragma unroll
    for (int i = 0; i < 16; ++i) { C[i] = 0.f; nn[i] = 0.f; }
    for (int n = 0; n < 64; ++n) {
        __syncthreads();
        for (int idx = F.tid; idx < 64 * 128; idx += NTHR) {
            const int i = idx >> 7, c = idx & 127, which = c >> 6, cc = c & 63, ch = which * 256 + h * 64 + cc;
            const int t = n * 64 + i; float a = 0.f;
#pragma unroll
            for (int j = 0; j < 4; ++j) { const int tt = t - 3 + j; if (tt >= 0) a += bf2f(proj[(size_t)(b * SEQ + tt) * NMAIN + MC_MLQ + ch]) * cw[j * 512 + ch]; }
            const float y = siluf_(a);
            if (which == 0) qs_[i * 64 + cc] = y * 0.125f; else ks_[i * 64 + cc] = y;
        }
        for (int idx = F.tid; idx < 64 * 128; idx += NTHR) { const int i = idx >> 7, c = idx & 127;
            vs_[idx] = bf2f(proj[(size_t)(b * SEQ + n * 64 + i) * NMAIN + MC_MLV + h * 128 + c]); }
        if (F.tid < 64) { const size_t row = (size_t)b * SEQ + n * 64 + F.tid;
            ipr[F.tid] = g16[row * 16 + 8 + h] + ib; lgf[F.tid] = logsigmoidf_(g16[row * 16 + 12 + h] + fb); }
        __syncthreads();
        for (int i = 0; i < 64; ++i) {
            const float lf = lgf[i], ip = ipr[i];
            const float mn = fmaxf(lf + m, ip), fp = __expf(lf + m - mn), iq = __expf(ip - mn); m = mn;
            const LAS float* kp = ks_ + i * 64 + d0; const LAS float* qp = qs_ + i * 64 + d0;
            const float vv = vs_[i * 128 + e] * iq;
            float num = 0.f, den = 0.f;
#pragma unroll
            for (int d = 0; d < 16; ++d) { const float kk = kp[d], qq = qp[d]; C[d] = fp * C[d] + kk * vv; nn[d] = fp * nn[d] + iq * kk; num += qq * C[d]; den += qq * nn[d]; }
            num += __shfl_xor(num, 1); num += __shfl_xor(num, 2); den += __shfl_xor(den, 1); den += __shfl_xor(den, 2);
            const float hh = num / fmaxf(fabsf(den), __expf(-m));
            if (ds == 0) raw[((size_t)b * SEQ + n * 64 + i) * D + 512 + h * 128 + e] = hh;
        }
    }
}

typedef short bf16x8_t __attribute__((ext_vector_type(8)));
template <int K> __device__ __forceinline__ f32x4 tile_mma(const LAS bf16* A, int lda, const LAS bf16* Bt, int ldb, int m0, int n0, int lane, f32x4 acc) {
    const int r = lane & 15, kq = (lane >> 4) * 8;
    const LAS bf16* ap = A + (m0 + r) * lda + kq; const LAS bf16* bp = Bt + (n0 + r) * ldb + kq;
#pragma unroll
    for (int k = 0; k < K; k += 32) { const bf16x8_t a = *(const LAS bf16x8_t*)(ap + k); const bf16x8_t b = *(const LAS bf16x8_t*)(bp + k);
        acc = __builtin_amdgcn_mfma_f32_16x16x32_bf16(a, b, acc, 0, 0, 0); }
    return acc;
}
__device__ __forceinline__ v2u pk4(f32x4 v) { v2u o; o.x = pk2(v.x, v.y); o.y = pk2(v.z, v.w); return o; }

__device__ __forceinline__ void dn_prep(Frame& F, int ch) {
    const int bh = ch >> 6, n = ch & 63, b = bh >> 2, h = bh & 3;
    const size_t row0 = (size_t)b * SEQ + n * 64;
    LAS bf16* kN = (LAS bf16*)(F.lds + 0);
    LAS bf16* qN = (LAS bf16*)(F.lds + 17408);
    LAS bf16* solT = (LAS bf16*)(F.lds + 0);
    LAS bf16* rhsT = (LAS bf16*)(F.lds + 36864);
    LAS bf16* kdT = (LAS bf16*)(F.lds + 73728);
    LAS bf16* Tm = (LAS bf16*)(F.lds + 92160);
    LAS float* Lm = (LAS float*)(F.lds + 101376);
    LAS float* gb = (LAS float*)(F.lds + 118784);
    LAS bf16* vN = (LAS bf16*)(F.lds + 101376);
    LAS float* cwL = (LAS float*)(F.lds + 119808);
    LAS bf16* Lb = (LAS bf16*)(F.lds + L_EXTRA);
    LAS bf16* TT = (LAS bf16*)(F.lds + 0);
    LAS bf16* XT = (LAS bf16*)(F.lds + 9216);
    const bf16* proj = (const bf16*)(F.ws + WS_PROJ); const float* g16 = (const float*)(F.ws + WS_G16); const float* cw = F.in[I_DNCONV];
    bf16* gMp = (bf16*)(F.ws + WS_DN_MP) + (size_t)ch * 16384; bf16* gUT = (bf16*)(F.ws + WS_DN_UT) + (size_t)ch * 16384;
    bf16* gKC = (bf16*)(F.ws + WS_DN_KC) + (size_t)ch * 8192; bf16* gWT = (bf16*)(F.ws + WS_DN_WT) + (size_t)ch * 8192;
    bf16* gQD = (bf16*)(F.ws + WS_DN_QD) + (size_t)ch * 8192; bf16* gQK = (bf16*)(F.ws + WS_DN_QK) + (size_t)ch * 4096;
    int tidA = F.tid; asm volatile("" : "+v"(tidA));
    const int lane = tidA & 63, w = F.wave, r = lane & 15, q4 = (lane >> 4) * 4;
    LDS_BARRIER();
    if (w == 0) {
        const float* g = g16 + (row0 + lane) * 16;
        const float be = sigmoidf_(g[h]); float G = -__expf(F.in[I_DNALOG][h]) * softplusf_(g[4 + h] + F.in[I_DNDT][h]);
#pragma unroll
        for (int o = 1; o < 64; o <<= 1) { const float v = __shfl_up(G, o); if (lane >= o) G += v; }
        const float Gl = __shfl(G, 63);
        gb[lane] = be; gb[64 + lane] = G; gb[128 + lane] = __expf(G); gb[192 + lane] = __expf(Gl - G);
        if (lane == 0) ((float*)(F.ws + WS_DN_SD))[ch] = __expf(Gl);
    }
    for (int idx = tidA; idx < 1536; idx += NTHR) { const int j = idx / 384, c = idx % 384; cwL[idx] = cw[j * 1536 + (c >> 7) * 512 + h * 128 + (c & 127)]; }
    LDS_BARRIER();
#pragma unroll 1
    for (int which = 0; which < 3; ++which) {
        v4u raw[2][4];
#pragma unroll
        for (int i2 = 0; i2 < 2; ++i2) { const int item = i2 * 512 + tidA, i = item >> 4, cg = item & 15, col = which * 512 + h * 128 + cg * 8;
#pragma unroll
            for (int j = 0; j < 4; ++j) { const int tt = n * 64 + i - 3 + j; raw[i2][j] = (v4u){0u, 0u, 0u, 0u};
                if (tt >= 0) raw[i2][j] = *(const v4u*)(proj + ((size_t)b * SEQ + tt) * NMAIN + col); } }
        LAS bf16* dstN = (which == 0 ? qN : which == 1 ? kN : vN);
#pragma unroll
        for (int i2 = 0; i2 < 2; ++i2) { const int item = i2 * 512 + tidA, i = item >> 4, cg = item & 15;
            float y[8];
#pragma unroll
            for (int e = 0; e < 8; ++e) y[e] = 0.f;
#pragma unroll
            for (int j = 0; j < 4; ++j) { const v4u rw = raw[i2][j];
                const f32x4 w0 = *(const LAS f32x4*)(cwL + j * 384 + which * 128 + cg * 8), w1 = *(const LAS f32x4*)(cwL + j * 384 + which * 128 + cg * 8 + 4);
                y[0] += bf2f(rw.x & 0xffff) * w0.x; y[1] += bf2f(rw.x >> 16) * w0.y; y[2] += bf2f(rw.y & 0xffff) * w0.z; y[3] += bf2f(rw.y >> 16) * w0.w;
                y[4] += bf2f(rw.z & 0xffff) * w1.x; y[5] += bf2f(rw.z >> 16) * w1.y; y[6] += bf2f(rw.w & 0xffff) * w1.z; y[7] += bf2f(rw.w >> 16) * w1.w; }
            float ss = 0.f;
#pragma unroll
            for (int e = 0; e < 8; ++e) { y[e] = siluf_(y[e]); ss += y[e] * y[e]; }
            ss += __shfl_xor(ss, 1); ss += __shfl_xor(ss, 2); ss += __shfl_xor(ss, 4); ss += __shfl_xor(ss, 8);
            float sc = 1.0f; if (which == 0) sc = rsqrtf(ss + EPS) * 0.08838834764831845f; if (which == 1) sc = rsqrtf(ss + EPS);
            v4u o; o.x = pk2(y[0] * sc, y[1] * sc); o.y = pk2(y[2] * sc, y[3] * sc); o.z = pk2(y[4] * sc, y[5] * sc); o.w = pk2(y[6] * sc, y[7] * sc);
            *(LAS v4u*)(dstN + i * 136 + cg * 8) = o;
            if (which == 0) { const float s2 = sc * gb[128 + i]; v4u o2; o2.x = pk2(y[0] * s2, y[1] * s2); o2.y = pk2(y[2] * s2, y[3] * s2); o2.z = pk2(y[4] * s2, y[5] * s2); o2.w = pk2(y[6] * s2, y[7] * s2);
                *(v4u*)(gQD + i * 128 + cg * 8) = o2; }
        }
    }
    LDS_BARRIER();
    {
        const int c = tidA & 127, tq = tidA >> 7;
#pragma unroll
        for (int g4 = 0; g4 < 4; ++g4) { const int i0 = tq * 16 + g4 * 4;
            const f32x4 be = *(const LAS f32x4*)(gb + i0), eG = *(const LAS f32x4*)(gb + 128 + i0), kd = *(const LAS f32x4*)(gb + 192 + i0);
            f32x4 kv, vv;
#pragma unroll
            for (int x = 0; x < 4; ++x) { kv[x] = bf2f(kN[(i0 + x) * 136 + c]); vv[x] = bf2f(vN[(i0 + x) * 136 + c]); }
            *(LAS v2u*)(rhsT + (128 + c) * 72 + i0) = pk4(kv * be * eG);
            *(LAS v2u*)(kdT + c * 72 + i0) = pk4(kv * kd);
            *(LAS v2u*)(rhsT + c * 72 + i0) = pk4(vv * be);
        }
    }
    LDS_BARRIER();
#pragma unroll 2
    for (int t = w; t < 16; t += 8) { const int mt = t >> 2, nt = t & 3;
        const f32x4 a = tile_mma<128>(kN, 136, kN, 136, mt * 16, nt * 16, lane, (f32x4){0.f, 0.f, 0.f, 0.f});
        const int j = nt * 16 + r; const float Gj = gb[64 + j];
#pragma unroll
        for (int x = 0; x < 4; ++x) { const int i = mt * 16 + q4 + x; const float lv = (i > j) ? gb[i] * a[x] * __expf(gb[64 + i] - Gj) : 0.f; Lm[i * 68 + j] = lv; Lb[i * 72 + j] = (bf16)f2bf(lv); }
    }
#pragma unroll 2
    for (int t = w; t < 16; t += 8) { const int jt = t >> 2, itl = t & 3;
        const f32x4 a = tile_mma<128>(kN, 136, qN, 136, jt * 16, itl * 16, lane, (f32x4){0.f, 0.f, 0.f, 0.f});
        const int i = itl * 16 + r; const float Gi = gb[64 + i]; f32x4 o;
#pragma unroll
        for (int x = 0; x < 4; ++x) { const int j = jt * 16 + q4 + x; o[x] = (j <= i) ? a[x] * __expf(Gi - gb[64 + j]) : 0.f; }
        *(v2u*)(gQK + i * 64 + jt * 16 + q4) = pk4(o);
    }
    LDS_BARRIER();
    if (w == 0) {
        unsigned lbase; asm volatile("v_mov_b32 %0, %1" : "=v"(lbase) : "s"((unsigned)(size_t)Lm));
        const int blk = lane >> 4, cc = lane & 15, kq8 = (lane >> 4) * 8;
        const LAS float* Lv = (const LAS float*)(size_t)lbase + (16 * blk) * 68 + 16 * blk;
#pragma unroll
        for (int x = 0; x < 9; ++x) *(LAS v4u*)(Tm + lane * 72 + x * 8) = (v4u){0u, 0u, 0u, 0u};
        float t[16];
#pragma unroll
        for (int i = 0; i < 16; ++i) {
            f32x4 l[4];
#pragma unroll
            for (int j4 = 0; j4 < (i + 3) / 4; ++j4) l[j4] = *(const LAS f32x4*)(Lv + i * 68 + j4 * 4);
            float s0 = (cc == i) ? 1.f : 0.f, s1 = 0.f;
#pragma unroll
            for (int j4 = 0; j4 < (i + 3) / 4; ++j4) {
                if (j4 * 4 + 0 < i) s0 -= l[j4].x * t[j4 * 4 + 0]; if (j4 * 4 + 1 < i) s1 -= l[j4].y * t[j4 * 4 + 1];
                if (j4 * 4 + 2 < i) s0 -= l[j4].z * t[j4 * 4 + 2]; if (j4 * 4 + 3 < i) s1 -= l[j4].w * t[j4 * 4 + 3]; }
            t[i] = s0 + s1; Tm[(16 * blk + i) * 72 + 16 * blk + cc] = (bf16)f2bf(t[i]);
        }
        { v4u o0, o1; o0.x = pk2(t[0], t[1]); o0.y = pk2(t[2], t[3]); o0.z = pk2(t[4], t[5]); o0.w = pk2(t[6], t[7]);
          o1.x = pk2(t[8], t[9]); o1.y = pk2(t[10], t[11]); o1.z = pk2(t[12], t[13]); o1.w = pk2(t[14], t[15]);
          *(LAS v4u*)(TT + (16 * blk + cc) * 72 + 16 * blk) = o0; *(LAS v4u*)(TT + (16 * blk + cc) * 72 + 16 * blk + 8) = o1; }
        const bf16x8_t zero8 = {0, 0, 0, 0, 0, 0, 0, 0};
#define INV_BLOCK(R, C) do { f32x4 xx = (f32x4){0.f, 0.f, 0.f, 0.f}; \
            _Pragma("unroll") for (int ks = 0; ks < (16 * ((R) - (C)) + 31) / 32; ++ks) { const bool ok = (32 * ks + kq8) < 16 * ((R) - (C)); const int ko = ok ? 16 * (C) + 32 * ks + kq8 : 0; \
                bf16x8_t a_ = *(const LAS bf16x8_t*)(Lb + (16 * (R) + cc) * 72 + ko); bf16x8_t b_ = *(const LAS bf16x8_t*)(TT + (16 * (C) + cc) * 72 + ko); \
                if (!ok) { a_ = zero8; b_ = zero8; } \
                xx = __builtin_amdgcn_mfma_f32_16x16x32_bf16(a_, b_, xx, 0, 0, 0); } \
            *(LAS v2u*)(XT + cc * 72 + (lane >> 4) * 4) = pk4(xx); \
            { const bool ok = kq8 < 16; const int ko = ok ? kq8 : 0; \
              bf16x8_t a_ = *(const LAS bf16x8_t*)(Tm + (16 * (R) + cc) * 72 + 16 * (R) + ko); bf16x8_t b_ = *(const LAS bf16x8_t*)(XT + cc * 72 + ko); \
              if (!ok) { a_ = zero8; b_ = zero8; } \
              f32x4 yy = __builtin_amdgcn_mfma_f32_16x16x32_bf16(a_, b_, (f32x4){0.f, 0.f, 0.f, 0.f}, 0, 0, 0); yy = -yy; \
              _Pragma("unroll") for (int x = 0; x < 4; ++x) Tm[(16 * (R) + (lane >> 4) * 4 + x) * 72 + 16 * (C) + cc] = (bf16)f2bf(yy[x]); \
              *(LAS v2u*)(TT + (16 * (C) + cc) * 72 + 16 * (R) + (lane >> 4) * 4) = pk4(yy); } } while (0)
        INV_BLOCK(1, 0); INV_BLOCK(2, 1); INV_BLOCK(3, 2);
        INV_BLOCK(2, 0); INV_BLOCK(3, 1);
        INV_BLOCK(3, 0);
#undef INV_BLOCK
    }
    LDS_BARRIER();
    int tidB = F.tid; asm volatile("" : "+v"(tidB));
    const int laneB = tidB & 63, rB = laneB & 15, q4B = (laneB >> 4) * 4;
#pragma unroll 4
    for (int t = w; t < 64; t += 8) { const int mt = t & 3, nt = t >> 2;
        const f32x4 a = tile_mma<64>(Tm, 72, rhsT, 72, mt * 16, nt * 16, laneB, (f32x4){0.f, 0.f, 0.f, 0.f});
        *(LAS v2u*)(solT + (nt * 16 + rB) * 72 + mt * 16 + q4B) = pk4(a);
    }
#pragma unroll 4
    for (int t = w; t < 32; t += 8) { const int mt = t & 7, nt = t >> 3;
        const f32x4 a = tile_mma<64>(rhsT + 128 * 72, 72, Tm, 72, mt * 16, nt * 16, laneB, (f32x4){0.f, 0.f, 0.f, 0.f});
        *(v2u*)(gKC + (nt * 16 + rB) * 128 + mt * 16 + q4B) = pk4(a);
    }
    LDS_BARRIER();
#pragma unroll 4
    for (int t = w; t < 64; t += 8) { const int mt = t & 7, nt = t >> 3;
        f32x4 a = tile_mma<64>(solT + 128 * 72, 72, kdT, 72, mt * 16, nt * 16, laneB, (f32x4){0.f, 0.f, 0.f, 0.f});
        a = -a; *(v2u*)(gMp + (nt * 16 + rB) * 128 + mt * 16 + q4B) = pk4(a);
    }
#pragma unroll 4
    for (int t = w; t < 64; t += 8) { const int mt = t & 7, nt = t >> 3;
        const f32x4 a = tile_mma<64>(kdT, 72, solT, 72, mt * 16, nt * 16, laneB, (f32x4){0.f, 0.f, 0.f, 0.f});
        *(v2u*)(gUT + (nt * 16 + rB) * 128 + mt * 16 + q4B) = pk4(a);
    }
    for (int c = tidB; c < 1024; c += NTHR) { const int row = c >> 3, pc = c & 7; *(v4u*)(gWT + row * 64 + pc * 8) = *(const LAS v4u*)(solT + row * 72 + pc * 8); }
}

#define DNS_LOAD(MR, UR, nn) do { const bf16* m1_ = gMp + (size_t)(nn) * 16384; const bf16* u1_ = gUT + (size_t)(nn) * 16384; \
    _Pragma("unroll") for (int x = 0; x < 4; ++x) { const int c = F.tid + 512 * x, row = c >> 4, pc = c & 15; MR[x] = *(const v4u*)(m1_ + row * 128 + pc * 8); } \
    _Pragma("unroll") for (int j = 0; j < NT; ++j) UR[j] = *(const v2u*)(u1_ + (c0 + 16 * j + r) * 128 + 16 * w + q4); } while (0)
#define DNS_STEP(nn, MRc, URc, MRo, URo) do { \
    if ((nn) + 4 < 64) DNS_LOAD(MRo, URo, (nn) + 4); \
    const LAS bf16* STc = ST + ((nn) & 1) * (NT * 16 * 136); const LAS bf16* MPc = MP + ((nn) & 1) * (128 * 136); \
    LAS bf16* STn = ST + (((nn) + 1) & 1) * (NT * 16 * 136); LAS bf16* MPn = MP + (((nn) + 1) & 1) * (128 * 136); \
    const float sd = sdl[(nn)]; bf16x8_t a_[4]; \
    _Pragma("unroll") for (int s_ = 0; s_ < 4; ++s_) a_[s_] = *(const LAS bf16x8_t*)(MPc + (16 * w + r) * 136 + kq + 32 * s_); \
    _Pragma("unroll") for (int j = 0; j < NT; ++j) acc[j] = acc[j] * sd + UBF(u[j]); \
    _Pragma("unroll") for (int s_ = 0; s_ < 4; ++s_) { _Pragma("unroll") for (int j = 0; j < NT; ++j) { const bf16x8_t bb = *(const LAS bf16x8_t*)(STc + (16 * j + r) * 136 + kq + 32 * s_); \
        acc[j] = __builtin_amdgcn_mfma_f32_16x16x32_bf16(a_[s_], bb, acc[j], 0, 0, 0); } } \
    if ((nn) + 1 < 64) { bf16* gs = gST + (size_t)((nn) + 1) * 16384; \
        _Pragma("unroll") for (int j = 0; j < NT; ++j) { const v2u pv = pk4(acc[j]); *(LAS v2u*)(STn + (16 * j + r) * 136 + 16 * w + q4) = pv; *(v2u*)(gs + (c0 + 16 * j + r) * 128 + 16 * w + q4) = pv; } \
        _Pragma("unroll") for (int x = 0; x < 4; ++x) { const int c = F.tid + 512 * x, row = c >> 4, pc = c & 15; *(LAS v4u*)(MPn + row * 136 + pc * 8) = MRc[x]; } \
        _Pragma("unroll") for (int j = 0; j < NT; ++j) u[j] = URc[j]; } \
    LDS_BARRIER(); } while (0)
template <int NT> __device__ __forceinline__ void dn_scan(Frame& F, int bh, int part) {
    LAS bf16* ST = (LAS bf16*)(F.lds);
    LAS bf16* MP = (LAS bf16*)(F.lds + 2 * NT * 16 * 136 * 2);
    LAS float* sdl = (LAS float*)(F.lds + 2 * NT * 16 * 136 * 2 + 69632);
    const int ch0 = bh * 64, c0 = part * NT * 16, lane = F.lane, w = F.wave, r = lane & 15, q4 = (lane >> 4) * 4, kq = (lane >> 4) * 8;
    const bf16* gMp = (const bf16*)(F.ws + WS_DN_MP) + (size_t)ch0 * 16384; const bf16* gUT = (const bf16*)(F.ws + WS_DN_UT) + (size_t)ch0 * 16384;
    bf16* gST = (bf16*)(F.ws + WS_DN_ST) + (size_t)ch0 * 16384;
    LDS_BARRIER();
    for (int i = F.tid; i < NT * 16 * 136 / 2; i += NTHR) ((LAS unsigned*)ST)[i] = 0u;
    for (int c = F.tid; c < NT * 256; c += NTHR) { const int row = c >> 4, pc = c & 15; *(v4u*)(gST + (c0 + row) * 128 + pc * 8) = (v4u){0u, 0u, 0u, 0u}; }
    if (F.tid < 64) sdl[F.tid] = ((const float*)(F.ws + WS_DN_SD))[ch0 + F.tid];
    v4u m0[4], m1[4], m2[4], m3[4]; v2u u0[NT], u1[NT], u2[NT], u3[NT], u[NT]; f32x4 acc[NT];
    DNS_LOAD(m0, u, 0);
#pragma unroll
    for (int x = 0; x < 4; ++x) { const int c = F.tid + 512 * x, row = c >> 4, pc = c & 15; *(LAS v4u*)(MP + row * 136 + pc * 8) = m0[x]; }
#pragma unroll
    for (int j = 0; j < NT; ++j) acc[j] = (f32x4){0.f, 0.f, 0.f, 0.f};
    DNS_LOAD(m1, u1, 1); DNS_LOAD(m2, u2, 2); DNS_LOAD(m3, u3, 3);
    LDS_BARRIER();
#pragma unroll 1
    for (int n = 0; n < 64; n += 4) {
        DNS_STEP(n, m1, u1, m0, u0);
        DNS_STEP(n + 1, m2, u2, m1, u1);
        DNS_STEP(n + 2, m3, u3, m2, u2);
        DNS_STEP(n + 3, m0, u0, m3, u3);
    }
}

struct DnOutRegs { v4u rk[2], rq[2], rs[4], rw[2], rqk; };
__device__ __forceinline__ void dn_out_load(Frame& F, int ch, DnOutRegs& R) {
    const bf16* gKC = (const bf16*)(F.ws + WS_DN_KC) + (size_t)ch * 8192; const bf16* gWT = (const bf16*)(F.ws + WS_DN_WT) + (size_t)ch * 8192;
    const bf16* gQD = (const bf16*)(F.ws + WS_DN_QD) + (size_t)ch * 8192; const bf16* gQK = (const bf16*)(F.ws + WS_DN_QK) + (size_t)ch * 4096;
    const bf16* gST = (const bf16*)(F.ws + WS_DN_ST) + (size_t)ch * 16384;
#pragma unroll
    for (int x = 0; x < 2; ++x) { const int c = F.tid + 512 * x, row = c >> 4, pc = c & 15; R.rk[x] = *(const v4u*)(gKC + row * 128 + pc * 8); R.rq[x] = *(const v4u*)(gQD + row * 128 + pc * 8); }
#pragma unroll
    for (int x = 0; x < 4; ++x) { const int c = F.tid + 512 * x, row = c >> 4, pc = c & 15; R.rs[x] = *(const v4u*)(gST + row * 128 + pc * 8); }
#pragma unroll
    for (int x = 0; x < 2; ++x) { const int c = F.tid + 512 * x, row = c >> 3, pc = c & 7; R.rw[x] = *(const v4u*)(gWT + row * 64 + pc * 8); }
    { const int c = F.tid, row = c >> 3, pc = c & 7; R.rqk = *(const v4u*)(gQK + row * 64 + pc * 8); }
}
__device__ __forceinline__ void dn_out(Frame& F, int ch, DnOutRegs& R, int next_ch) {
    const int bh = ch >> 6, n = ch & 63, b = bh >> 2, h = bh & 3;
    const size_t row0 = (size_t)b * SEQ + n * 64;
    LAS bf16* kc = (LAS bf16*)(F.lds + 0);
    LAS bf16* wT = (LAS bf16*)(F.lds + 17408);
    LAS float* ob = (LAS float*)(F.lds + 0);
    LAS bf16* qd = (LAS bf16*)(F.lds + 35840);
    LAS bf16* qk = (LAS bf16*)(F.lds + 53248);
    LAS bf16* ST = (LAS bf16*)(F.lds + 62464);
    LAS bf16* vnT = (LAS bf16*)(F.lds + 97280);
    const int lane = F.lane, w = F.wave, r = lane & 15, q4 = (lane >> 4) * 4;
    const bf16* proj = (const bf16*)(F.ws + WS_PROJ);
    unsigned zz[8];
#pragma unroll
    for (int rr = 0; rr < 8; ++rr) zz[rr] = *(const unsigned*)(proj + (row0 + w * 8 + rr) * NMAIN + MC_DNZ + h * 128 + 2 * lane);
    LDS_BARRIER();
#pragma unroll
    for (int x = 0; x < 2; ++x) { const int c = F.tid + 512 * x, row = c >> 4, pc = c & 15; *(LAS v4u*)(kc + row * 136 + pc * 8) = R.rk[x]; *(LAS v4u*)(qd + row * 136 + pc * 8) = R.rq[x]; }
#pragma unroll
    for (int x = 0; x < 4; ++x) { const int c = F.tid + 512 * x, row = c >> 4, pc = c & 15; *(LAS v4u*)(ST + row * 136 + pc * 8) = R.rs[x]; }
#pragma unroll
    for (int x = 0; x < 2; ++x) { const int c = F.tid + 512 * x, row = c >> 3, pc = c & 7; *(LAS v4u*)(wT + row * 72 + pc * 8) = R.rw[x]; }
    { const int c = F.tid, row = c >> 3, pc = c & 7; *(LAS v4u*)(qk + row * 72 + pc * 8) = R.rqk; }
    if (next_ch >= 0) dn_out_load(F, next_ch, R);
    LDS_BARRIER();
#pragma unroll 4
    for (int t = w; t < 32; t += 8) { const int mt = t & 3, nt = t >> 2;
        const f32x4 a = tile_mma<128>(kc, 136, ST, 136, mt * 16, nt * 16, lane, (f32x4){0.f, 0.f, 0.f, 0.f});
        const int e = nt * 16 + r; const v2u wv = *(const LAS v2u*)(wT + e * 72 + mt * 16 + q4);
        f32x4 vn; vn.x = bf2f(wv.x & 0xffff) - a.x; vn.y = bf2f(wv.x >> 16) - a.y; vn.z = bf2f(wv.y & 0xffff) - a.z; vn.w = bf2f(wv.y >> 16) - a.w;
        *(LAS v2u*)(vnT + e * 72 + mt * 16 + q4) = pk4(vn);
    }
    LDS_BARRIER();
#pragma unroll 4
    for (int t = w; t < 32; t += 8) { const int mt = t & 3, nt = t >> 2;
        f32x4 a = tile_mma<128>(qd, 136, ST, 136, mt * 16, nt * 16, lane, (f32x4){0.f, 0.f, 0.f, 0.f});
        a = tile_mma<64>(qk, 72, vnT, 72, mt * 16, nt * 16, lane, a);
        const int e = nt * 16 + r;
#pragma unroll
        for (int x = 0; x < 4; ++x) ob[(mt * 16 + q4 + x) * 132 + e] = a[x];
    }
    LDS_BARRIER();
    bf16* mix = (bf16*)(F.ws + WS_MIX); const float* dnn = F.in[I_DNNORM];
    float oo0[8], oo1[8], sq[8];
    const float nw0 = dnn[2 * lane], nw1 = dnn[2 * lane + 1];
#pragma unroll
    for (int rr = 0; rr < 8; ++rr) { const int i = w * 8 + rr;
        oo0[rr] = ob[i * 132 + 2 * lane]; oo1[rr] = ob[i * 132 + 2 * lane + 1]; sq[rr] = oo0[rr] * oo0[rr] + oo1[rr] * oo1[rr]; }
#pragma unroll
    for (int o = 1; o < 64; o <<= 1) {
#pragma unroll
        for (int rr = 0; rr < 8; ++rr) sq[rr] += __shfl_xor(sq[rr], o); }
#pragma unroll
    for (int rr = 0; rr < 8; ++rr) { const int i = w * 8 + rr; const float rstd = rsqrtf(sq[rr] * (1.f / 128.f) + EPS);
        const float y0 = oo0[rr] * rstd * nw0 * siluf_(bf2f(zz[rr] & 0xffff)), y1 = oo1[rr] * rstd * nw1 * siluf_(bf2f(zz[rr] >> 16));
        *(unsigned*)(mix + (row0 + i) * D + h * 128 + 2 * lane) = pk2(y0, y1); }
}

__device__ __forceinline__ void ml_prep(Frame& F, int ch) {
    const int bh = ch >> 6, n = ch & 63, b = bh >> 2, h = bh & 3;
    const size_t row0 = (size_t)b * SEQ + n * 64;
    LAS bf16* kwT = (LAS bf16*)(F.lds + 0);
    LAS bf16* vT = (LAS bf16*)(F.lds + 9216);
    LAS float* gsc = (LAS float*)(F.lds + 27648);
    LAS bf16* vNn = (LAS bf16*)(F.lds + 28160);
    LAS bf16* kNn = (LAS bf16*)(F.lds + 45568);
    const bf16* proj = (const bf16*)(F.ws + WS_PROJ); const float* g16 = (const float*)(F.ws + WS_G16); const float* cw = F.in[I_MLCONV];
    float* gUp = (float*)(F.ws + WS_ML_UPT) + (size_t)ch * 8192; bf16* gQC = (bf16*)(F.ws + WS_ML_QC) + (size_t)ch * 4096; bf16* gKC = (bf16*)(F.ws + WS_ML_KC) + (size_t)ch * 4096;
    float* aux = (float*)(F.ws + WS_ML_AUX);
    const int lane = F.lane, w = F.wave, r = lane & 15, q4 = (lane >> 4) * 4;
    LDS_BARRIER();
    if (w == 0) {
        const float* g = g16 + (row0 + lane) * 16;
        const float ip = g[8 + h] + F.in[I_MLIB][h]; float bc = logsigmoidf_(g[12 + h] + F.in[I_MLFB][h]);
#pragma unroll
        for (int o = 1; o < 64; o <<= 1) { const float v = __shfl_up(bc, o); if (lane >= o) bc += v; }
        const float bl = __shfl(bc, 63), ge = bl - bc + ip; float gm = ge;
#pragma unroll
        for (int o = 1; o < 64; o <<= 1) gm = fmaxf(gm, __shfl_xor(gm, o));
        gsc[lane] = __expf(ge - gm);
        if (lane == 0) { aux[131072 + ch * 2] = bl; aux[131072 + ch * 2 + 1] = gm; }
    }
    LDS_BARRIER();
#pragma unroll 1
    for (int it = 0; it < 2; ++it) {
        const int item = it * 512 + F.tid, i = item >> 4, cg = item & 15, isk = cg >> 3, c8 = (cg & 7) * 8, chn = isk * 256 + h * 64 + c8;
        float y[8];
#pragma unroll
        for (int j = 0; j < 8; ++j) y[j] = 0.f;
#pragma unroll
        for (int j = 0; j < 4; ++j) { const int tt = n * 64 + i - 3 + j;
            if (tt >= 0) { const v4u raw = *(const v4u*)(proj + ((size_t)b * SEQ + tt) * NMAIN + MC_MLQ + chn);
                const f32x4 w0 = *(const f32x4*)(cw + j * 512 + chn), w1 = *(const f32x4*)(cw + j * 512 + chn + 4);
                y[0] += bf2f(raw.x & 0xffff) * w0.x; y[1] += bf2f(raw.x >> 16) * w0.y; y[2] += bf2f(raw.y & 0xffff) * w0.z; y[3] += bf2f(raw.y >> 16) * w0.w;
                y[4] += bf2f(raw.z & 0xffff) * w1.x; y[5] += bf2f(raw.z >> 16) * w1.y; y[6] += bf2f(raw.w & 0xffff) * w1.z; y[7] += bf2f(raw.w >> 16) * w1.w; } }
#pragma unroll
        for (int j = 0; j < 8; ++j) y[j] = siluf_(y[j]);
        if (!isk) { v4u o; o.x = pk2(y[0] * 0.125f, y[1] * 0.125f); o.y = pk2(y[2] * 0.125f, y[3] * 0.125f); o.z = pk2(y[4] * 0.125f, y[5] * 0.125f); o.w = pk2(y[6] * 0.125f, y[7] * 0.125f);
            *(v4u*)(gQC + i * 64 + c8) = o; }
        else { v4u o; o.x = pk2(y[0], y[1]); o.y = pk2(y[2], y[3]); o.z = pk2(y[4], y[5]); o.w = pk2(y[6], y[7]); *(v4u*)(gKC + i * 64 + c8) = o;
            const float sc = gsc[i]; v4u o2; o2.x = pk2(y[0] * sc, y[1] * sc); o2.y = pk2(y[2] * sc, y[3] * sc); o2.z = pk2(y[4] * sc, y[5] * sc); o2.w = pk2(y[6] * sc, y[7] * sc);
            *(LAS v4u*)(kNn + i * 72 + c8) = o2; }
    }
#pragma unroll
    for (int it = 0; it < 2; ++it) {
        const int item = it * 512 + F.tid, i = item >> 4, cg = item & 15;
        *(LAS v4u*)(vNn + i * 136 + cg * 8) = *(const v4u*)(proj + (row0 + i) * NMAIN + MC_MLV + h * 128 + cg * 8);
    }
    LDS_BARRIER();
    {
        const int c = F.tid & 127, tq = F.tid >> 7;
#pragma unroll
        for (int g4 = 0; g4 < 4; ++g4) { const int i0 = tq * 16 + g4 * 4;
            v2u o; o.x = (unsigned)vNn[(i0 + 0) * 136 + c] | ((unsigned)vNn[(i0 + 1) * 136 + c] << 16); o.y = (unsigned)vNn[(i0 + 2) * 136 + c] | ((unsigned)vNn[(i0 + 3) * 136 + c] << 16);
            *(LAS v2u*)(vT + c * 72 + i0) = o;
            if (c < 64) { v2u p; p.x = (unsigned)kNn[(i0 + 0) * 72 + c] | ((unsigned)kNn[(i0 + 1) * 72 + c] << 16); p.y = (unsigned)kNn[(i0 + 2) * 72 + c] | ((unsigned)kNn[(i0 + 3) * 72 + c] << 16);
                *(LAS v2u*)(kwT + c * 72 + i0) = p; } }
    }
    LDS_BARRIER();
#pragma unroll 4
    for (int t = w; t < 32; t += 8) { const int mt = t & 3, nt = t >> 2;
        const f32x4 a = tile_mma<64>(kwT, 72, vT, 72, mt * 16, nt * 16, lane, (f32x4){0.f, 0.f, 0.f, 0.f});
        *(f32x4*)(gUp + (nt * 16 + r) * 64 + mt * 16 + q4) = a;
    }
    if (F.tid < 64) { float s = 0.f; for (int x = 0; x < 64; ++x) s += bf2f(kwT[F.tid * 72 + x]); aux[ch * 64 + F.tid] = s; }
}

__device__ __forceinline__ void ml_scan(Frame& F, int bh) {
    const int ch0 = bh * 64;
    const float* gUp = (const float*)(F.ws + WS_ML_UPT) + (size_t)ch0 * 8192; bf16* gCT = (bf16*)(F.ws + WS_ML_CT) + (size_t)ch0 * 8192;
    float* aux = (float*)(F.ws + WS_ML_AUX);
    LAS float* sl = (LAS float*)F.lds;
    LDS_BARRIER();
    if (F.tid < 128) sl[F.tid] = aux[131072 + ch0 * 2 + F.tid];
    for (int i = F.tid; i < 4096; i += NTHR) sl[128 + i] = aux[ch0 * 64 + i];
    LDS_BARRIER();
    f32x4 C[4], uA[4], uB[4]; float nv = 0.f, m = 0.f;
#pragma unroll
    for (int x = 0; x < 4; ++x) { C[x] = (f32x4){0.f, 0.f, 0.f, 0.f}; uA[x] = *(const f32x4*)(gUp + x * 2048 + F.tid * 4); uB[x] = *(const f32x4*)(gUp + 8192 + x * 2048 + F.tid * 4); }
#define MLS_STEP(nn, UC) do { const int ch = ch0 + (nn); \
        _Pragma("unroll") for (int x = 0; x < 4; ++x) *(v2u*)(gCT + (size_t)(nn) * 8192 + x * 2048 + F.tid * 4) = pk4(C[x]); \
        if (F.tid < 64) aux[65536 + ch * 64 + F.tid] = nv; \
        if (F.tid == 0) aux[133120 + ch] = m; \
        const float bl = sl[2 * (nn)], gm = sl[2 * (nn) + 1]; \
        const float m1 = fmaxf(bl + m, gm), keep = __expf(bl + m - m1), sc = __expf(gm - m1); \
        _Pragma("unroll") for (int x = 0; x < 4; ++x) C[x] = C[x] * keep + UC[x] * sc; \
        nv = nv * keep + sl[128 + (nn) * 64 + (F.tid & 63)] * sc; m = m1; \
        if ((nn) + 2 < 64) { _Pragma("unroll") for (int x = 0; x < 4; ++x) UC[x] = *(const f32x4*)(gUp + (size_t)((nn) + 2) * 8192 + x * 2048 + F.tid * 4); } } while (0)
#pragma unroll 1
    for (int n = 0; n < 64; n += 2) { MLS_STEP(n, uA); MLS_STEP(n + 1, uB); }
#undef MLS_STEP
}

__device__ __forceinline__ void ml_out(Frame& F, int ch) {
    const int bh = ch >> 6, n = ch & 63, b = bh >> 2, h = bh & 3;
    const size_t row0 = (size_t)b * SEQ + n * 64;
    LAS bf16* qI = (LAS bf16*)(F.lds + 0);
    LAS bf16* qS = (LAS bf16*)(F.lds + 9216);
    LAS bf16* kS = (LAS bf16*)(F.lds + 18432);
    LAS bf16* pM = (LAS bf16*)(F.lds + 27648);
    LAS bf16* vT = (LAS bf16*)(F.lds + 36864);
    LAS bf16* cT = (LAS bf16*)(F.lds + 57600);
    LAS float* hb = (LAS float*)(F.lds + 78336);
    LAS bf16* vNn = (LAS bf16*)(F.lds + 78336);
    LAS float* gg = (LAS float*)(F.lds + 116224);
    const bf16* proj = (const bf16*)(F.ws + WS_PROJ); const float* g16 = (const float*)(F.ws + WS_G16);
    const bf16* gQC = (const bf16*)(F.ws + WS_ML_QC) + (size_t)ch * 4096; const bf16* gKC = (const bf16*)(F.ws + WS_ML_KC) + (size_t)ch * 4096;
    const bf16* gCT = (const bf16*)(F.ws + WS_ML_CT) + (size_t)ch * 8192; const float* aux = (const float*)(F.ws + WS_ML_AUX);
    const int lane = F.lane, w = F.wave, r = lane & 15, q4 = (lane >> 4) * 4;
    unsigned zz[8];
#pragma unroll
    for (int rr = 0; rr < 8; ++rr) zz[rr] = *(const unsigned*)(proj + (row0 + w * 8 + rr) * NMAIN + MC_MLO + h * 128 + 2 * lane);
    LDS_BARRIER();
    if (w == 0) {
        const float* g = g16 + (row0 + lane) * 16;
        const float ip = g[8 + h] + F.in[I_MLIB][h]; float bc = logsigmoidf_(g[12 + h] + F.in[I_MLFB][h]);
#pragma unroll
        for (int o = 1; o < 64; o <<= 1) { const float v = __shfl_up(bc, o); if (lane >= o) bc += v; }
        const float rj = ip - bc; float pm = rj;
#pragma unroll
        for (int o = 1; o < 64; o <<= 1) { const float v = __shfl_up(pm, o); if (lane >= o) pm = fmaxf(pm, v); }
        const float ms = aux[133120 + ch], mt = fmaxf(bc + ms, bc + pm);
        gg[lane] = bc; gg[64 + lane] = rj; gg[128 + lane] = mt; gg[192 + lane] = __expf(bc + ms - mt);
    }
    for (int i = F.tid; i < 16 * 72; i += NTHR) { const bf16 one = (bf16)0x3f80; vT[128 * 72 + i] = (i < 64) ? one : (bf16)0; cT[128 * 72 + i] = (bf16)0; }
    LDS_BARRIER();
    v4u rct[2], rv[2]; float rnv = 0.f;
#pragma unroll
    for (int x = 0; x < 2; ++x) { const int c = F.tid + 512 * x, row = c >> 3, pc = c & 7; rct[x] = *(const v4u*)(gCT + row * 64 + pc * 8);
        const int item = x * 512 + F.tid, i = item >> 4, cg = item & 15; rv[x] = *(const v4u*)(proj + (row0 + i) * NMAIN + MC_MLV + h * 128 + cg * 8); }
    if (F.tid < 64) rnv = aux[65536 + ch * 64 + F.tid];
    { const int c = F.tid, row = c >> 3, pc = c & 7;
        const v4u qv = *(const v4u*)(gQC + row * 64 + pc * 8); const v4u kv_ = *(const v4u*)(gKC + row * 64 + pc * 8); *(LAS v4u*)(qS + row * 72 + pc * 8) = qv; *(LAS v4u*)(kS + row * 72 + pc * 8) = kv_;
        const float in = gg[192 + row]; v4u o;
        o.x = pk2(bf2f(qv.x & 0xffff) * in, bf2f(qv.x >> 16) * in); o.y = pk2(bf2f(qv.y & 0xffff) * in, bf2f(qv.y >> 16) * in);
        o.z = pk2(bf2f(qv.z & 0xffff) * in, bf2f(qv.z >> 16) * in); o.w = pk2(bf2f(qv.w & 0xffff) * in, bf2f(qv.w >> 16) * in);
        *(LAS v4u*)(qI + row * 72 + pc * 8) = o; }
#pragma unroll
    for (int x = 0; x < 2; ++x) { const int c = F.tid + 512 * x, row = c >> 3, pc = c & 7; *(LAS v4u*)(cT + row * 72 + pc * 8) = rct[x]; }
    if (F.tid < 64) cT[128 * 72 + F.tid] = (bf16)f2bf(rnv);
#pragma unroll
    for (int it = 0; it < 2; ++it) { const int item = it * 512 + F.tid, i = item >> 4, cg = item & 15; *(LAS v4u*)(vNn + i * 136 + cg * 8) = rv[it]; }
    LDS_BARRIER();
    {   const int c = F.tid & 127, tq = F.tid >> 7;
#pragma unroll
        for (int g4 = 0; g4 < 4; ++g4) { const int i0 = tq * 16 + g4 * 4;
            v2u o; o.x = (unsigned)vNn[(i0 + 0) * 136 + c] | ((unsigned)vNn[(i0 + 1) * 136 + c] << 16); o.y = (unsigned)vNn[(i0 + 2) * 136 + c] | ((unsigned)vNn[(i0 + 3) * 136 + c] << 16);
            *(LAS v2u*)(vT + c * 72 + i0) = o; }
    }
    LDS_BARRIER();
#pragma unroll 2
    for (int t = w; t < 16; t += 8) { const int jt = t >> 2, itl = t & 3;
        const f32x4 a = tile_mma<64>(kS, 72, qS, 72, jt * 16, itl * 16, lane, (f32x4){0.f, 0.f, 0.f, 0.f});
        const int i = itl * 16 + r; const float e0 = gg[i] - gg[128 + i]; f32x4 o;
#pragma unroll
        for (int x = 0; x < 4; ++x) { const int j = jt * 16 + q4 + x; o[x] = (j <= i) ? a[x] * __expf(e0 + gg[64 + j]) : 0.f; }
        *(LAS v2u*)(pM + i * 72 + jt * 16 + q4) = pk4(o);
    }
    LDS_BARRIER();
#pragma unroll 4
    for (int t = w; t < 36; t += 8) { const int mt = t & 3, nt = t >> 2;
        f32x4 a = tile_mma<64>(qI, 72, cT, 72, mt * 16, nt * 16, lane, (f32x4){0.f, 0.f, 0.f, 0.f});
        a = tile_mma<64>(pM, 72, vT, 72, mt * 16, nt * 16, lane, a);
        const int e = nt * 16 + r;
#pragma unroll
        for (int x = 0; x < 4; ++x) hb[(mt * 16 + q4 + x) * 148 + e] = a[x];
    }
    LDS_BARRIER();
    bf16* mix = (bf16*)(F.ws + WS_MIX); const float* mln = F.in[I_MLNORM];
    float oo0[8], oo1[8], sq[8];
    const float nw0 = mln[h * 128 + 2 * lane], nw1 = mln[h * 128 + 2 * lane + 1];
#pragma unroll
    for (int rr = 0; rr < 8; ++rr) { const int i = w * 8 + rr;
        const float dd = 1.0f / fmaxf(fabsf(hb[i * 148 + 128]), __expf(-gg[128 + i]));
        oo0[rr] = hb[i * 148 + 2 * lane] * dd; oo1[rr] = hb[i * 148 + 2 * lane + 1] * dd; sq[rr] = oo0[rr] * oo0[rr] + oo1[rr] * oo1[rr]; }
#pragma unroll
    for (int o = 1; o < 64; o <<= 1) {
#pragma unroll
        for (int rr = 0; rr < 8; ++rr) sq[rr] += __shfl_xor(sq[rr], o); }
#pragma unroll
    for (int rr = 0; rr < 8; ++rr) { const int i = w * 8 + rr; const float rstd = rsqrtf(sq[rr] * (1.f / 128.f) + EPS);
        const float y0 = oo0[rr] * rstd * nw0 * sigmoidf_(bf2f(zz[rr] & 0xffff)), y1 = oo1[rr] * rstd * nw1 * sigmoidf_(bf2f(zz[rr] >> 16));
        *(unsigned*)(mix + (row0 + i) * D + 512 + h * 128 + 2 * lane) = pk2(y0, y1); }
}

template <int J0> __device__ __forceinline__ void p4_mixnorm(Frame& F) {
    const float* raw = (const float*)(F.ws + WS_RAW); const bf16* proj = (const bf16*)(F.ws + WS_PROJ); bf16* mix = (bf16*)(F.ws + WS_MIX);
    const float* dnn = F.in[I_DNNORM]; const float* mln = F.in[I_MLNORM];
    const int gw = F.vb * NWAVES + F.wave, NGW = F.G * NWAVES;
    for (int row = gw; row < T; row += NGW) {
        const f32x4* rr = (const f32x4*)(raw + (size_t)row * D) + F.lane;
        v2u* o8 = (v2u*)(mix + (size_t)row * D) + F.lane;
#pragma unroll
        for (int j = J0; j < 4; ++j) {
            f32x4 v = rr[64 * j]; float ss = (v.x * v.x + v.y * v.y) + (v.z * v.z + v.w * v.w);
#pragma unroll
            for (int o = 1; o < 32; o <<= 1) ss += __shfl_xor(ss, o);
            const float rstd = rsqrtf(ss * (1.f / 128.f) + EPS);
            const int k = 256 * j + F.lane * 4;
            f32x4 w, gt;
            if (j < 2) { w = *(const f32x4*)(dnn + (k & 127)); const v2u z = *(const v2u*)(proj + (size_t)row * NMAIN + MC_DNZ + k);
                gt.x = siluf_(bf2f(z.x & 0xffff)); gt.y = siluf_(bf2f(z.x >> 16)); gt.z = siluf_(bf2f(z.y & 0xffff)); gt.w = siluf_(bf2f(z.y >> 16)); }
            else { w = *(const f32x4*)(mln + (k - 512)); const v2u z = *(const v2u*)(proj + (size_t)row * NMAIN + MC_MLO + (k - 512));
                gt.x = sigmoidf_(bf2f(z.x & 0xffff)); gt.y = sigmoidf_(bf2f(z.x >> 16)); gt.z = sigmoidf_(bf2f(z.y & 0xffff)); gt.w = sigmoidf_(bf2f(z.y >> 16)); }
            v = v * rstd * w * gt;
            v2u o; o.x = pk2(v.x, v.y); o.y = pk2(v.z, v.w); o8[64 * j] = o;
        }
    }
}

__device__ __forceinline__ void p6_router(Frame& F, int rep) {
    LAS float* wr = (LAS float*)F.lds;
    LAS float* lg = (LAS float*)(F.lds + L_EXTRA);
    const bf16* x1 = (const bf16*)(F.ws + WS_X1);
    v2u vn[8];
    { const v2u* xr0 = (const v2u*)(x1 + (size_t)(F.vb * 64 + F.wave * 8) * D) + F.lane;
#pragma unroll
      for (int j = 0; j < 4; ++j) { vn[j] = xr0[64 * j]; vn[4 + j] = xr0[256 + 64 * j]; } }
    { const char* src = (const char*)(F.ws + WS_WRT);
#pragma unroll
        for (int it = 0; it < 16; ++it) { const int chunk = it * 8 + F.wave;
            __builtin_amdgcn_global_load_lds((const unsigned*)(src + chunk * 1024 + F.lane * 16), (LAS unsigned*)(F.lds + chunk * 1024), 16, 0, 0); }
        asm volatile("s_waitcnt vmcnt(0)" ::: "memory"); }
    __syncthreads(); const float* nw = F.in[I_NFFN]; const float* mod = (const float*)(F.ws + WS_MOD);
    bf16* h2 = (bf16*)(F.ws + WS_H); const float* br = F.in[I_BR];
    int* tok_e = (int*)(F.ws + WS_TOKE); int* tok_r = (int*)(F.ws + WS_TOKR); float* tok_w = (float*)(F.ws + WS_TOKW); int* slot_tok = (int*)(F.ws + WS_SLOTTOK);
    unsigned* gcnt = (unsigned*)(F.ws + WS_CTL) + CW_CNT;
    if (rep > 0) { tok_e = (int*)(F.ws + WS_RAW); tok_r = tok_e + 65536; tok_w = (float*)(tok_r + 65536); slot_tok = tok_r + 131072; gcnt += 16384 - CW_CNT; }
    LAS int* cntL = (LAS int*)(F.lds + L_EXTRA + 8448);
    LAS int* baseL = cntL + 32;
    for (int blk = F.vb; blk < T / 64; blk += F.G) {
        if (F.tid < 32) cntL[F.tid] = 0;
        __syncthreads();
#pragma unroll 1
        for (int rr = 0; rr < 8; rr += 2) {
            const int lr = F.wave * 8 + rr, row = blk * 64 + lr, b = row / SEQ;
            f32x4 v0[4], v1[4]; float ss0 = 0.f, ss1 = 0.f;
#pragma unroll
            for (int j = 0; j < 4; ++j) { v0[j] = UBF(vn[j]); v1[j] = UBF(vn[4 + j]);
                ss0 += (v0[j].x * v0[j].x + v0[j].y * v0[j].y) + (v0[j].z * v0[j].z + v0[j].w * v0[j].w);
                ss1 += (v1[j].x * v1[j].x + v1[j].y * v1[j].y) + (v1[j].z * v1[j].z + v1[j].w * v1[j].w); }
            { const int nrow = (rr + 2 < 8) ? row + 2 : ((blk + F.G < T / 64) ? (blk + F.G) * 64 + F.wave * 8 : row);
              const v2u* xr = (const v2u*)(x1 + (size_t)nrow * D) + F.lane;
#pragma unroll
              for (int j = 0; j < 4; ++j) { vn[j] = xr[64 * j]; vn[4 + j] = xr[256 + 64 * j]; } }
            const float rstd0 = rsqrtf(wave_sum(ss0) * (1.f / D) + EPS), rstd1 = rsqrtf(wave_sum(ss1) * (1.f / D) + EPS);
            const float* sh = mod + b * 6144 + 3072; const float* sc = sh + 1024;
#pragma unroll
            for (int j = 0; j < 4; ++j) { const int k = 256 * j + F.lane * 4;
                const f32x4 w = *(const f32x4*)(nw + k), s1 = *(const f32x4*)(sc + k), s0 = *(const f32x4*)(sh + k);
                v0[j] = (v0[j] * rstd0 * w) * (1.0f + s1) + s0; v1[j] = (v1[j] * rstd1 * w) * (1.0f + s1) + s0; }
            v2u* o8 = (v2u*)(h2 + (size_t)row * D) + F.lane;
#pragma unroll
            for (int j = 0; j < 4; ++j) { v2u o; o.x = pk2(v0[j].x, v0[j].y); o.y = pk2(v0[j].z, v0[j].w); o8[64 * j] = o;
                v2u p; p.x = pk2(v1[j].x, v1[j].y); p.y = pk2(v1[j].z, v1[j].w); o8[256 + 64 * j] = p; }
            float acc0[32], acc1[32];
#pragma unroll
            for (int e = 0; e < 32; ++e) { float a0 = 0.f, a1 = 0.f;
#pragma unroll
                for (int j = 0; j < 4; ++j) { const f32x4 w = *(const LAS f32x4*)(wr + e * 1024 + 256 * j + F.lane * 4);
                    a0 += (v0[j].x * w.x + v0[j].y * w.y) + (v0[j].z * w.z + v0[j].w * w.w); a1 += (v1[j].x * w.x + v1[j].y * w.y) + (v1[j].z * w.z + v1[j].w * w.w); }
                acc0[e] = a0; acc1[e] = a1; if (e & 1) asm volatile("" ::: "memory"); }
            const float r0 = multi_reduce<32>(acc0, F.lane), r1 = multi_reduce<32>(acc1, F.lane);
            if ((F.lane & 1) == 0) { const float bb = br[F.lane >> 1]; lg[lr * 33 + (F.lane >> 1)] = r0 + bb; lg[(lr + 1) * 33 + (F.lane >> 1)] = r1 + bb; }
        }
        int te[4] = {0, 0, 0, 0}, lk[4] = {0, 0, 0, 0}; float ww[4] = {0.f, 0.f, 0.f, 0.f};
        if (F.lane < 8) {
            const int lr = F.wave * 8 + F.lane;
            float l[32];
#pragma unroll
            for (int e = 0; e < 32; ++e) l[e] = lg[lr * 33 + e];
            float tl[4];
#pragma unroll
            for (int k = 0; k < 4; ++k) { float best = -3.0e38f; int bi = 0;
#pragma unroll
                for (int e = 0; e < 32; ++e) { if (l[e] > best) { best = l[e]; bi = e; } }
                te[k] = bi; tl[k] = best;
#pragma unroll
                for (int e = 0; e < 32; ++e) if (e == bi) l[e] = -3.0e38f; }
            ww[0] = 1.f; ww[1] = __expf(tl[1] - tl[0]); ww[2] = __expf(tl[2] - tl[0]); ww[3] = __expf(tl[3] - tl[0]);
            const float inv = 1.f / (ww[0] + ww[1] + ww[2] + ww[3]);
#pragma unroll
            for (int k = 0; k < 4; ++k) { ww[k] *= inv; lk[k] = __hip_atomic_fetch_add(cntL + te[k], 1, __ATOMIC_RELAXED, __HIP_MEMORY_SCOPE_WORKGROUP); }
        }
        __syncthreads();
        if (F.tid < 32) baseL[F.tid] = (int)__hip_atomic_fetch_add(gcnt + 64 * F.tid, (unsigned)cntL[F.tid], __ATOMIC_RELAXED, __HIP_MEMORY_SCOPE_AGENT);
        __syncthreads();
        if (F.lane < 8) { const int row = blk * 64 + F.wave * 8 + F.lane;
#pragma unroll
            for (int k = 0; k < 4; ++k) { const int rk = baseL[te[k]] + lk[k]; tok_e[row * 4 + k] = te[k]; tok_r[row * 4 + k] = rk; tok_w[row * 4 + k] = ww[k]; if (rk < ECAP) slot_tok[te[k] * ECAP + rk] = row; } }
        __syncthreads();
    }
}

__device__ __forceinline__ void p9_final(Frame& F) {
    build_expert_tables(F);
    const LAS int* tst = (const LAS int*)(F.lds + L_TST);
    const bf16* x1 = (const bf16*)(F.ws + WS_X1); const bf16* y = (const bf16*)(F.ws + WS_Y);
    const float* mod = (const float*)(F.ws + WS_MOD); const float* modf = (const float*)(F.ws + WS_MODF); const float* nf = F.in[I_NFIN];
    const int* tok_e = (const int*)(F.ws + WS_TOKE); const int* tok_r = (const int*)(F.ws + WS_TOKR); const float* tok_w = (const float*)(F.ws + WS_TOKW);
    const int gw = F.vb * NWAVES + F.wave, NGW = F.G * NWAVES;
    for (int row = gw; row < T; row += NGW) {
        const int b = row / SEQ;
        const v2u* xr = (const v2u*)(x1 + (size_t)row * D) + F.lane;
        f32x4 v[4], m[4];
#pragma unroll
        for (int j = 0; j < 4; ++j) { const v2u xv = xr[64 * j]; v[j] = UBF(xv); m[j] = (f32x4){0.f, 0.f, 0.f, 0.f}; }
#pragma unroll
        for (int k = 0; k < 4; ++k) { const int e = tok_e[row * 4 + k], r = tok_r[row * 4 + k]; const float w = tok_w[row * 4 + k];
            const size_t cs = (size_t)tst[e] * 256 + r;
            const v2u* yr = (const v2u*)(y + cs * D) + F.lane;
#pragma unroll
            for (int j = 0; j < 4; ++j) { const v2u z = yr[64 * j];
                m[j].x += w * bf2f(z.x & 0xffff); m[j].y += w * bf2f(z.x >> 16); m[j].z += w * bf2f(z.y & 0xffff); m[j].w += w * bf2f(z.y >> 16); } }
        const float* g2 = mod + b * 6144 + 5120; float ss = 0.f;
#pragma unroll
        for (int j = 0; j < 4; ++j) { const f32x4 g = *(const f32x4*)(g2 + 256 * j + F.lane * 4); v[j] = v[j] + g * m[j];
            ss += (v[j].x * v[j].x + v[j].y * v[j].y) + (v[j].z * v[j].z + v[j].w * v[j].w); }
        const float rstd = rsqrtf(wave_sum(ss) * (1.f / D) + EPS);
        const float* sh = modf + b * 2048; const float* sc = sh + 1024;
        f32x4* orow = (f32x4*)(F.out + (size_t)row * D) + F.lane;
#pragma unroll
        for (int j = 0; j < 4; ++j) { const int k = 256 * j + F.lane * 4;
            const f32x4 w = *(const f32x4*)(nf + k), s1 = *(const f32x4*)(sc + k), s0 = *(const f32x4*)(sh + k);
            f32x4 ov = (v[j] * rstd * w) * (1.0f + s1) + s0;
            if (TP_A >= 0) { const unsigned long long* st = (const unsigned long long*)(F.ws + WS_CTL + 131072); const float eps = (float)(long long)(st[TP_B] - st[TP_A]) * (float)TP_SCALE * 0.25e-5f; ov = ov * (1.0f + eps); }
            orow[64 * j] = ov; }
    }
}

constexpr int NPH = 11;
__global__ void __launch_bounds__(NTHR, 2) fwd(Args args) {
    extern __shared__ __attribute__((aligned(16))) unsigned char lds_raw[];
    Frame F;
    F.lds = (LAS unsigned char*)lds_raw; F.ws = args.ws; F.out = args.out;
    F.in.p = (const float* const*)__builtin_amdgcn_kernarg_segment_ptr();
    F.tid = threadIdx.x; F.lane = F.tid & 63; F.wave = __builtin_amdgcn_readfirstlane(F.tid >> 6);
    F.G = gridDim.x; F.vb = blockIdx.x;
    for (int u = F.tid; u < (LDS_BYTES - LDSCTL_OFF) / 4; u += NTHR) ((LAS unsigned*)(F.lds + LDSCTL_OFF))[u] = 0u;
    __syncthreads();
    unsigned* ctl = (unsigned*)(F.ws + WS_CTL);
    const int lo = args.ph_lo, hi = args.ph_hi;
    XcdBarrier bar; bar.bar = ctl + CW_BAR; bar.x = 0; bar.st = nullptr;
    if (hi - lo > 1) bar = xcd_barrier_post(ctl + CW_BAR, (volatile LAS unsigned*)(F.lds + L_MISC) + 8);
#ifndef REPMASK
#define REPMASK 0
#endif
#define NREP(k) (((REPMASK >> (k)) & 1) ? 2 : 1)
#ifndef P3MODE
#define P3MODE 0
#endif
#ifndef XBARS
#define XBARS 0
#endif
#ifndef PHMASK
#define PHMASK 0x7ff
#endif
#define IN(k) (((PHMASK >> (k)) & 1) && lo <= (k) && (k) < hi)
#define SEAM(k) do { if (IN(k) && IN((k) + 1)) xcd_barrier(bar); STAMP((k) + 1, 0); } while (0)
    STAMP(0, 0);

    if (IN(0)) _Pragma("unroll") for (int rep_ = 0; rep_ < NREP(0); ++rep_) { p0_prologue(F); } SEAM(0);
    if (IN(1)) _Pragma("unroll") for (int rep_ = 0; rep_ < NREP(1); ++rep_) { p1_norm1(F); } SEAM(1);
    if (IN(2)) _Pragma("unroll") for (int rep_ = 0; rep_ < NREP(2); ++rep_) {
        pg8::Gemm g{(const bf16*)(F.ws + WS_H), D}; pg8::DenseOrder S; S.init(T, NMAIN, D, (const bf16*)(F.ws + WS_BTIN), F.G, F.vb);
        EpiProj E{(bf16*)(F.ws + WS_PROJ), NMAIN};
        pg8::gemm_phase<EpiProj, pg8::DenseOrder, true, true>(F.lds, g, S, E);
    } SEAM(2);
    if (IN(3)) _Pragma("unroll") for (int rep_ = 0; rep_ < NREP(3); ++rep_) { for (int it = F.vb; it < 2048; it += F.G) { if (it < 1024) { dn_prep(F, it); if (P3MODE == 1) dn_prep(F, it); } else { ml_prep(F, it - 1024); if (P3MODE == 2) ml_prep(F, it - 1024); } } } SEAM(3);
    if (IN(4)) _Pragma("unroll") for (int rep_ = 0; rep_ < NREP(4); ++rep_) {
        for (int role = F.vb; role < 144; role += F.G) {
            if (role < 128) dn_scan<1>(F, (role & 7) + 8 * (role >> 6), (role >> 3) & 7);
            else ml_scan(F, role - 128);
        }
        convert_moe(F);
    } SEAM(4);
    if (IN(5)) _Pragma("unroll") for (int rep_ = 0; rep_ < NREP(5); ++rep_) {
        { DnOutRegs R; int it = F.vb; if (it < 1024) dn_out_load(F, it, R);
          for (; it < 1024; it += F.G) dn_out(F, it, R, it + F.G < 1024 ? it + F.G : -1); }
        for (int it = 1024 + (F.vb + F.G - 1024 % F.G) % F.G; it < 2048; it += F.G) ml_out(F, it - 1024);
    } SEAM(5);
    if (IN(6)) _Pragma("unroll") for (int rep_ = 0; rep_ < NREP(6); ++rep_) {
        pg8::Gemm g{(const bf16*)(F.ws + WS_MIX), D}; pg8::DenseOrder S; S.init(T, D, D, (const bf16*)(F.ws + WS_BTOUT), F.G, F.vb);
        EpiRes E{F.in[I_X], (bf16*)(F.ws + WS_X1), (const float*)(F.ws + WS_MOD)};
        pg8::gemm_phase<EpiRes, pg8::DenseOrder, false, true>(F.lds, g, S, E);
    } SEAM(6);
    if (IN(7)) _Pragma("unroll") for (int rep_ = 0; rep_ < NREP(7); ++rep_) { p6_router(F, rep_); } SEAM(7);
    if (IN(8)) _Pragma("unroll") for (int rep_ = 0; rep_ < NREP(8); ++rep_) {
        const int nmt = build_expert_tables(F);
        GroupedOrder<4, 8, true> S; S.G = F.G; S.c = F.vb; S.nmt = nmt; S.K = D; S.tileE = (const LAS int*)(F.lds + L_TILEE); S.tst = (const LAS int*)(F.lds + L_TST); S.cnt = (const LAS int*)(F.lds + L_CNT);
        S.slot_tok = (const int*)(F.ws + WS_SLOTTOK); S.Bt = (const bf16*)(F.ws + WS_BTGU); S.bexp = (size_t)2048 * D; S.tokbuf = (LAS unsigned*)(F.lds + L_EXTRA) + F.wave * 256;
        pg8::Gemm g{(const bf16*)(F.ws + WS_H), D};
        EpiGU E{(bf16*)(F.ws + WS_ACT), F.in[I_BGU]};
        pg8::gemm_phase<EpiGU, GroupedOrder<4, 8, true>, true, true>(F.lds, g, S, E);
    } SEAM(8);
    if (IN(9)) _Pragma("unroll") for (int rep_ = 0; rep_ < NREP(9); ++rep_) {
        const int nmt = build_expert_tables(F);
        GroupedOrder<8, 4, false> S; S.G = F.G; S.c = F.vb; S.nmt = nmt; S.K = D; S.tileE = (const LAS int*)(F.lds + L_TILEE); S.tst = (const LAS int*)(F.lds + L_TST); S.cnt = (const LAS int*)(F.lds + L_CNT);
        S.slot_tok = nullptr; S.Bt = (const bf16*)(F.ws + WS_BTDN); S.bexp = (size_t)D * D; S.tokbuf = nullptr;
        pg8::Gemm g{(const bf16*)(F.ws + WS_ACT), D};
        EpiDown E{(bf16*)(F.ws + WS_Y), F.in[I_BDN]};
        pg8::gemm_phase<EpiDown, GroupedOrder<8, 4, false>, true, true>(F.lds, g, S, E);
    } SEAM(9);
    for (int xb_ = 0; xb_ < XBARS; ++xb_) xcd_barrier(bar);
    if (IN(10)) _Pragma("unroll") for (int rep_ = 0; rep_ < NREP(10); ++rep_) { p9_final(F); }
#undef IN
#undef SEAM
}

extern "C" void kernel_launch(void* const* d_in, const int* in_sizes, int n_in, void* d_out, int out_size, void* d_ws, size_t ws_size, hipStream_t stream) {
    static int grid = 0;
    if (grid == 0) {
        if (n_in != 25 || in_sizes[0] != T * D || out_size != T * D || ws_size < WS_END) { fprintf(stderr, "kernel_launch: unexpected shapes (n_in %d, ws %zu)\n", n_in, ws_size); grid = -1; return; }
        int dev = 0, cus = 0, per_cu = 0;
        if (hipGetDevice(&dev) != hipSuccess || hipDeviceGetAttribute(&cus, hipDeviceAttributeMultiprocessorCount, dev) != hipSuccess) { grid = -1; return; }
        if (hipFuncSetAttribute((const void*)fwd, hipFuncAttributeMaxDynamicSharedMemorySize, LDS_BYTES) != hipSuccess) { fprintf(stderr, "kernel_launch: hipFuncSetAttribute failed\n"); grid = -1; return; }
        if (hipOccupancyMaxActiveBlocksPerMultiprocessor(&per_cu, (const void*)fwd, NTHR, LDS_BYTES) != hipSuccess || per_cu < 1) { fprintf(stderr, "kernel_launch: occupancy query says %d\n", per_cu); }
        (void)hipGetLastError();
        grid = cus;
    }
    if (grid < 0) return;
    hipMemsetAsync((char*)d_ws + WS_CTL, 0, CTL_ZERO_BYTES, stream);
    Args a{};
    for (int i = 0; i < 25; ++i) a.in[i] = (const float*)d_in[i];
    a.out = (float*)d_out; a.ws = (unsigned char*)d_ws;
#if MK_ONE_LAUNCH
    a.ph_lo = 0; a.ph_hi = NPH;
    hipLaunchKernelGGL(fwd, dim3(grid), dim3(NTHR), LDS_BYTES, stream, a);
#else
    for (int p = 0; p < NPH; ++p) { a.ph_lo = p; a.ph_hi = p + 1; hipLaunchKernelGGL(fwd, dim3(grid), dim3(NTHR), LDS_BYTES, stream, a); }
#endif
}
```
